# Optimizing an MI355X kernel written in HIP

```python
import math
import jax, jax.numpy as jnp
from jax import lax
import numpy as np

D_MODEL = 1024
BATCH = 4
SEQ = 4096
DEPTH = 2

PLE_DIM = 256
HEAD_DIM = 64
DIFF_HEADS = 4
DIFF_QK = 2 * HEAD_DIM
DIFF_V = 2 * HEAD_DIM
FOX_HEADS = 4
FOX_DIM = HEAD_DIM
RET_HEADS = 4
RET_DIM = HEAD_DIM
WA = DIFF_HEADS * DIFF_V
WB = FOX_HEADS * FOX_DIM
WC = RET_HEADS * RET_DIM
MIX_WIDTH = WA + WB + WC
IN_SIZES = (DIFF_HEADS * DIFF_QK, DIFF_HEADS * DIFF_QK, WA, WB, WB, WB, FOX_HEADS, WC, WC, WC, WC)
IN_COLS = sum(IN_SIZES)
Q_BLOCK = 128
RET_CHUNK = 128
RET_THETA = 10000.0
D_FF_DENSE = 2816
N_EXPERTS = 8
TOP_K = 2
D_FF_EXPERT = 3584
N_DENSE = (DEPTH + 1) // 2
N_MOE = DEPTH // 2
EPS = 1e-6
NEG_INF = -1e30

kernel_name = "hymba_diff_fox_retnet_moe_trunk"


def rmsnorm(x, g):
    xf = x.astype(jnp.float32)
    y = xf * lax.rsqrt(jnp.mean(xf * xf, axis=-1, keepdims=True) + EPS)
    return (y * g.astype(jnp.float32)).astype(x.dtype)


def head_groupnorm(x):
    xf = x.astype(jnp.float32)
    mu = jnp.mean(xf, axis=-1, keepdims=True)
    var = jnp.mean(jnp.square(xf - mu), axis=-1, keepdims=True)
    return ((xf - mu) * lax.rsqrt(var + EPS)).astype(x.dtype)


def split_heads(t, n_heads):
    B, S, _ = t.shape
    return t.reshape(B, S, n_heads, -1).transpose(0, 2, 1, 3)


def merge_heads(t):
    B, H, S, D = t.shape
    return t.transpose(0, 2, 1, 3).reshape(B, S, H * D)


def rotary(x):
    S, D = x.shape[2], x.shape[3]
    half = D // 2
    inv = RET_THETA ** (-jnp.arange(half, dtype=jnp.float32) / half)
    ang = jnp.arange(S, dtype=jnp.float32)[:, None] * inv[None, :]
    cos, sin = jnp.cos(ang).astype(x.dtype), jnp.sin(ang).astype(x.dtype)
    x1, x2 = x[..., :half], x[..., half:]
    return jnp.concatenate([x1 * cos - x2 * sin, x1 * sin + x2 * cos], axis=-1)


def causal_block_attention(q, k, v, scale, cum_logf=None):
    B, H, S, Dk = q.shape
    nb = S // Q_BLOCK
    q_blocks = q.reshape(B, H, nb, Q_BLOCK, Dk).transpose(2, 0, 1, 3, 4)
    k_pos = jnp.arange(S)
    xs = [jnp.arange(nb), q_blocks]
    if cum_logf is not None:
        xs.append(cum_logf.reshape(B, H, nb, Q_BLOCK).transpose(2, 0, 1, 3))

    def one_block(blk):
        i, q_i = blk[0], blk[1]
        s = jnp.einsum('bhqd,bhkd->bhqk', q_i, k).astype(jnp.float32) * scale
        if cum_logf is not None:
            s = s + blk[2][..., :, None] - cum_logf[:, :, None, :]
        q_pos = i * Q_BLOCK + jnp.arange(Q_BLOCK)
        s = jnp.where(k_pos[None, :] <= q_pos[:, None], s, NEG_INF)
        w = jax.nn.softmax(s, axis=-1).astype(v.dtype)
        return jnp.einsum('bhqk,bhkv->bhqv', w, v)

    o = lax.map(one_block, tuple(xs))
    return o.transpose(1, 2, 0, 3, 4).reshape(B, H, S, v.shape[-1])


def retention_chunkwise(q, k, v):
    B, H, S, Dk = q.shape
    Dv = v.shape[-1]
    nc = S // RET_CHUNK
    log_g = jnp.log1p(-jnp.exp2(-5.0 - jnp.arange(H, dtype=jnp.float32)))
    j = jnp.arange(RET_CHUNK, dtype=jnp.float32)
    diff = j[:, None] - j[None, :]
    inner = jnp.exp(jnp.where(diff[None] >= 0, diff[None] * log_g[:, None, None], -jnp.inf))
    q_dec = jnp.exp((j + 1.0)[None, :] * log_g[:, None])
    k_dec = jnp.exp((RET_CHUNK - 1.0 - j)[None, :] * log_g[:, None])
    c_dec = jnp.exp(RET_CHUNK * log_g)

    def to_chunks(t):
        return t.astype(jnp.float32).reshape(B, H, nc, RET_CHUNK, -1).transpose(2, 0, 1, 3, 4)

    def step(state, qkv):
        qc, kc, vc = qkv
        a = jnp.einsum('bhqd,bhkd->bhqk', qc, kc) * inner
        o = (jnp.einsum('bhqk,bhkv->bhqv', a, vc)
             + jnp.einsum('bhqd,bhdv->bhqv', qc * q_dec[:, :, None], state))
        state = state * c_dec[:, None, None] + jnp.einsum('bhkd,bhkv->bhdv', kc * k_dec[:, :, None], vc)
        return state, o

    state0 = jnp.zeros((B, H, Dk, Dv), jnp.float32)
    _, o = lax.scan(step, state0, (to_chunks(q), to_chunks(k), to_chunks(v)))
    return o.transpose(1, 2, 0, 3, 4).reshape(B, H, S, Dv).astype(v.dtype)


def hybrid_mixer(xn, w_in, b_forget, lq1, lk1, lq2, lk2, subln_g, ret_gn_g, w_out, layer_idx):
    B, S, _ = xn.shape
    proj = xn @ w_in
    qa, ka, va, qb, kb, vb, fb, qc, kc, vc, gc = jnp.split(proj, list(np.cumsum(IN_SIZES)[:-1]), axis=-1)

    qa = split_heads(qa, 2 * DIFF_HEADS)
    ka = split_heads(ka, 2 * DIFF_HEADS)
    va = jnp.repeat(split_heads(va, DIFF_HEADS), 2, axis=1)
    o = causal_block_attention(qa, ka, va, HEAD_DIM ** -0.5)
    o = o.reshape(B, DIFF_HEADS, 2, S, DIFF_V)
    lam_init = 0.8 - 0.6 * math.exp(-0.3 * layer_idx)
    lam = (jnp.exp(jnp.sum(lq1.astype(jnp.float32) * lk1.astype(jnp.float32)))
           - jnp.exp(jnp.sum(lq2.astype(jnp.float32) * lk2.astype(jnp.float32))) + lam_init)
    o_a = o[:, :, 0] - lam.astype(o.dtype) * o[:, :, 1]
    o_a = merge_heads(rmsnorm(o_a, subln_g) * (1.0 - lam_init))

    log_f = jax.nn.log_sigmoid((fb + b_forget).astype(jnp.float32))
    cum = jnp.cumsum(log_f, axis=1).transpose(0, 2, 1)
    o_b = causal_block_attention(split_heads(qb, FOX_HEADS), split_heads(kb, FOX_HEADS),
                                 split_heads(vb, FOX_HEADS), FOX_DIM ** -0.5, cum)
    o_b = merge_heads(o_b)

    qr = rotary(split_heads(qc, RET_HEADS))
    kr = rotary(split_heads(kc, RET_HEADS)) * (RET_DIM ** -0.5)
    o_c = retention_chunkwise(qr, kr, split_heads(vc, RET_HEADS))
    o_c = merge_heads(head_groupnorm(o_c)) * ret_gn_g
    o_c = jax.nn.silu(gc) * o_c

    return jnp.concatenate([o_a, o_b, o_c], axis=-1) @ w_out


def swiglu(x, wg, wu, wd):
    return (jax.nn.silu(x @ wg) * (x @ wu)) @ wd


def moe_swiglu(xn, router, wg, wu, wd):
    B, S, D = xn.shape
    t = xn.reshape(B * S, D)
    logits = (t @ router).astype(jnp.float32)
    top_val, top_idx = lax.top_k(logits, TOP_K)
    gates = jax.nn.softmax(top_val, axis=-1)
    combine = jnp.sum(jax.nn.one_hot(top_idx, N_EXPERTS, dtype=jnp.float32) * gates[..., None], axis=1)
    out = jnp.zeros_like(t)
    for e in range(N_EXPERTS):
        out = out + combine[:, e:e + 1].astype(t.dtype) * swiglu(t, wg[e], wu[e], wd[e])
    return out.reshape(B, S, D)


def setup_inputs(seed: int = 0) -> dict:
    key = jax.random.key(seed)
    ks = jax.random.split(key, 26)
    f32 = jnp.float32

    def nrm(k, shape, scale):
        return jax.random.normal(k, shape, f32) * scale

    def gain(k, shape):
        return 1.0 + 0.05 * jax.random.normal(k, shape, f32)

    return {
        "x": nrm(ks[0], (BATCH, SEQ, D_MODEL), 1.0),
        "p": nrm(ks[1], (DEPTH, BATCH, SEQ, PLE_DIM), 1.0),
        "norm_mix": gain(ks[2], (DEPTH, D_MODEL)),
        "w_in": nrm(ks[3], (DEPTH, D_MODEL, IN_COLS), D_MODEL ** -0.5),
        "b_forget": 3.0 + 0.5 * jax.random.normal(ks[4], (DEPTH, FOX_HEADS), f32),
        "lambda_q1": nrm(ks[5], (DEPTH, HEAD_DIM), 0.1),
        "lambda_k1": nrm(ks[6], (DEPTH, HEAD_DIM), 0.1),
        "lambda_q2": nrm(ks[7], (DEPTH, HEAD_DIM), 0.1),
        "lambda_k2": nrm(ks[8], (DEPTH, HEAD_DIM), 0.1),
        "diff_subln": gain(ks[9], (DEPTH, DIFF_V)),
        "ret_gn": gain(ks[10], (DEPTH, WC)),
        "w_out": nrm(ks[11], (DEPTH, MIX_WIDTH, D_MODEL), MIX_WIDTH ** -0.5),
        "norm_ffn": gain(ks[12], (DEPTH, D_MODEL)),
        "dense_w_gate": nrm(ks[13], (N_DENSE, D_MODEL, D_FF_DENSE), D_MODEL ** -0.5),
        "dense_w_up": nrm(ks[14], (N_DENSE, D_MODEL, D_FF_DENSE), D_MODEL ** -0.5),
        "dense_w_down": nrm(ks[15], (N_DENSE, D_FF_DENSE, D_MODEL), D_FF_DENSE ** -0.5),
        "router": nrm(ks[16], (N_MOE, D_MODEL, N_EXPERTS), D_MODEL ** -0.5),
        "moe_w_gate": nrm(ks[17], (N_MOE, N_EXPERTS, D_MODEL, D_FF_EXPERT), D_MODEL ** -0.5),
        "moe_w_up": nrm(ks[18], (N_MOE, N_EXPERTS, D_MODEL, D_FF_EXPERT), D_MODEL ** -0.5),
        "moe_w_down": nrm(ks[19], (N_MOE, N_EXPERTS, D_FF_EXPERT, D_MODEL), D_FF_EXPERT ** -0.5),
        "ple_norm": gain(ks[20], (DEPTH, D_MODEL)),
        "ple_gate": nrm(ks[21], (DEPTH, D_MODEL, D_MODEL), D_MODEL ** -0.5),
        "ple_proj": nrm(ks[22], (DEPTH, PLE_DIM, D_MODEL), PLE_DIM ** -0.5),
        "final_norm": gain(ks[23], (D_MODEL,)),
    }


def reference(x, p, norm_mix, w_in, b_forget, lambda_q1, lambda_k1, lambda_q2, lambda_k2,
              diff_subln, ret_gn, w_out, norm_ffn, dense_w_gate, dense_w_up, dense_w_down,
              router, moe_w_gate, moe_w_up, moe_w_down, ple_norm, ple_gate, ple_proj, final_norm):
    h = x
    for i in range(DEPTH):
        xn = rmsnorm(h, norm_mix[i])
        h = h + hybrid_mixer(xn, w_in[i], b_forget[i], lambda_q1[i], lambda_k1[i], lambda_q2[i],
                             lambda_k2[i], diff_subln[i], ret_gn[i], w_out[i], i)
        xn = rmsnorm(h, norm_ffn[i])
        j = i // 2
        if i % 2 == 0:
            h = h + swiglu(xn, dense_w_gate[j], dense_w_up[j], dense_w_down[j])
        else:
            h = h + moe_swiglu(xn, router[j], moe_w_gate[j], moe_w_up[j], moe_w_down[j])
        gate = jax.nn.sigmoid(rmsnorm(h, ple_norm[i]) @ ple_gate[i])
        h = h + gate * (p[i] @ ple_proj[i])
    return rmsnorm(h, final_norm)
```

```cpp
#include <hip/hip_runtime.h>
#include <cstdio>
#include <cstdint>
#include <cmath>

namespace gold {
constexpr int D = 1024, BATCH = 4, SEQ = 4096, NTOK = BATCH * SEQ, DEPTH = 2;
constexpr int PLE = 256, INC = 3332, FFD = 2816, NE = 8, FFE = 3584;
constexpr float EPS = 1e-6f;
constexpr int C_QA = 0, C_KA = 512, C_VA = 1024, C_QB = 1536, C_KB = 1792, C_VB = 2048, C_FB = 2304, C_QC = 2308, C_KC = 2564, C_VC = 2820, C_GC = 3076;

__device__ __forceinline__ float wsum(float v) {
#pragma unroll
    for (int o = 1; o < 64; o <<= 1) v += __shfl_xor(v, o);
    return v;
}
__device__ __forceinline__ float wmax(float v) {
#pragma unroll
    for (int o = 1; o < 64; o <<= 1) v = fmaxf(v, __shfl_xor(v, o));
    return v;
}
__device__ __forceinline__ float silu_f(float x) { return x / (1.f + expf(-x)); }
__device__ __forceinline__ float sigm_f(float x) { return 1.f / (1.f + expf(-x)); }

__global__ __launch_bounds__(256) void k_copy(const float* __restrict__ a, float* __restrict__ b, size_t n4) {
    size_t i = (size_t)blockIdx.x * 256 + threadIdx.x;
    for (; i < n4; i += (size_t)gridDim.x * 256) ((float4*)b)[i] = ((const float4*)a)[i];
}
__global__ __launch_bounds__(256) void k_rms(const float* x, const float* __restrict__ g, float* out, int nrows) {
    const int row = blockIdx.x * 4 + (threadIdx.x >> 6), lane = threadIdx.x & 63;
    if (row >= nrows) return;
    const float* xr = x + (size_t)row * D; float v[16]; float s = 0.f;
#pragma unroll
    for (int j = 0; j < 16; ++j) { v[j] = xr[lane + 64 * j]; s += v[j] * v[j]; }
    s = wsum(s); const float r = 1.f / sqrtf(s * (1.f / D) + EPS);
    float* o = out + (size_t)row * D;
#pragma unroll
    for (int j = 0; j < 16; ++j) o[lane + 64 * j] = v[j] * r * g[lane + 64 * j];
}

struct SG { const float* A; const float* B; float* C; const int* rows; const int* cnt; const float* G; const float* gate; int lda, ldb, ldc, M, N, K, mode, pad; };
__global__ __launch_bounds__(256) void k_sgemm(SG p) {
    __shared__ float As[16][68];
    __shared__ float Bs[16][68];
    const int M = p.cnt ? *p.cnt : p.M;
    const int bm = blockIdx.y * 64, bn = blockIdx.x * 64;
    if (bm >= M) return;
    const int tid = threadIdx.x, tx = tid & 15, ty = tid >> 4;
    const int ar = tid >> 2, ak = (tid & 3) * 4;
    const int arow = bm + ar; const bool aok = arow < M;
    const size_t asrc = aok ? (size_t)((p.rows && p.mode != 6) ? p.rows[arow] : arow) : 0;
    const float* ap = p.A + asrc * p.lda + ak;
    const int bk = tid >> 4, bc = (tid & 15) * 4; const bool bok = (bn + bc) < p.N;
    const float* bp = p.B + (size_t)bk * p.ldb + bn + bc;
    float acc[4][4];
#pragma unroll
    for (int i = 0; i < 4; ++i)
#pragma unroll
        for (int j = 0; j < 4; ++j) acc[i][j] = 0.f;
    for (int k0 = 0; k0 < p.K; k0 += 16) {
        float4 av = aok ? *(const float4*)(ap + k0) : make_float4(0.f, 0.f, 0.f, 0.f);
        float4 bv = bok ? *(const float4*)(bp + (size_t)k0 * p.ldb) : make_float4(0.f, 0.f, 0.f, 0.f);
        As[ak + 0][ar] = av.x; As[ak + 1][ar] = av.y; As[ak + 2][ar] = av.z; As[ak + 3][ar] = av.w;
        *(float4*)&Bs[bk][bc] = bv;
        __syncthreads();
#pragma unroll
        for (int kk = 0; kk < 16; ++kk) {
            const float4 a4 = *(const float4*)&As[kk][ty * 4]; const float4 b4 = *(const float4*)&Bs[kk][tx * 4];
            const float a[4] = {a4.x, a4.y, a4.z, a4.w}, b[4] = {b4.x, b4.y, b4.z, b4.w};
#pragma unroll
            for (int i = 0; i < 4; ++i)
#pragma unroll
                for (int j = 0; j < 4; ++j) acc[i][j] += a[i] * b[j];
        }
        __syncthreads();
    }
#pragma unroll
    for (int i = 0; i < 4; ++i) {
        const int row = bm + ty * 4 + i; if (row >= M) continue;
#pragma unroll
        for (int j = 0; j < 4; ++j) {
            const int col = bn + tx * 4 + j; if (col >= p.N) continue;
            const float v = acc[i][j];
            if (p.mode == 6) { float* c = p.C + (size_t)p.rows[row] * p.ldc + col; *c += p.gate[row] * v; continue; }
            float* c = p.C + (size_t)row * p.ldc + col;
            switch (p.mode) {
                case 0: *c = v; break;
                case 1: *c += v; break;
                case 2: *c = silu_f(v); break;
                case 3: *c *= v; break;
                case 4: *c = sigm_f(v); break;
                case 5: *c += p.G[(size_t)row * p.ldc + col] * v; break;
            }
        }
    }
}

__global__ void k_cum(const float* __restrict__ proj, const float* __restrict__ bfg, float* __restrict__ cum) {
    const int i = blockIdx.x * blockDim.x + threadIdx.x; if (i >= BATCH * 4) return;
    const int b = i >> 2, h = i & 3; double c = 0.0;
    for (int t = 0; t < SEQ; ++t) {
        const float x = proj[(size_t)(b * SEQ + t) * INC + C_FB + h] + bfg[h];
        const float ls = fminf(x, 0.f) - log1pf(expf(-fabsf(x)));
        c += (double)ls; cum[(size_t)i * SEQ + t] = (float)c;
    }
}
__global__ __launch_bounds__(256) void k_rotary(float* proj) {
    const size_t i = (size_t)blockIdx.x * 256 + threadIdx.x;
    if (i >= (size_t)NTOK * 2 * 4 * 32) return;
    const int d = (int)(i & 31), hh = (int)((i >> 5) & 3), qk = (int)((i >> 7) & 1); const size_t tok = i >> 8;
    const int pos = (int)(tok % SEQ);
    const float inv = powf(10000.f, -(float)d / 32.f); const float ang = (float)pos * inv;
    const float c = cosf(ang), s = sinf(ang);
    float* p = proj + tok * INC + (qk ? C_KC : C_QC) + hh * 64 + d;
    const float x1 = p[0], x2 = p[32]; const float sc = qk ? 0.125f : 1.f;
    p[0] = (x1 * c - x2 * s) * sc; p[32] = (x1 * s + x2 * c) * sc;
}

struct AT { const float* q; const float* k; const float* v; float* o; const float* cum; int ldq, ldk, ldv, ldo, dv, mode, vshare, pad; float scale, pad2; };
__global__ __launch_bounds__(256) void k_attn(AT p) {
    const int wave = threadIdx.x >> 6, lane = threadIdx.x & 63;
    const int t = blockIdx.x * 4 + wave, h = blockIdx.y, b = blockIdx.z;
    const size_t rb = (size_t)b * SEQ;
    const float qv = p.q[(rb + t) * p.ldq + h * 64 + lane];
    const float* kb = p.k + rb * p.ldk + h * 64;
    const float* vb = p.v + rb * p.ldv + (h / p.vshare) * p.dv;
    float logg = 0.f; if (p.mode == 2) logg = log1pf(-exp2f(-5.f - (float)h));
    const float* cum = p.cum ? p.cum + ((size_t)b * 4 + h) * SEQ : nullptr;
    const float cq = cum ? cum[t] : 0.f;
    float m = -INFINITY, l = 0.f, o0 = 0.f, o1 = 0.f;
    for (int s0 = 0; s0 <= t; s0 += 64) {
        const int s = s0 + lane; const bool valid = s <= t; const int sc_ = valid ? s : t;
        const float* kr = kb + (size_t)sc_ * p.ldk;
        float dot = 0.f;
#pragma unroll 8
        for (int d = 0; d < 64; ++d) dot += __shfl(qv, d) * kr[d];
        float pw;
        if (p.mode == 2) { pw = valid ? dot * expf((float)(t - s) * logg) : 0.f; }
        else {
            float sc = dot * p.scale; if (cum) sc += cq - cum[sc_];
            sc = valid ? sc : -INFINITY;
            const float mn = fmaxf(m, wmax(sc));
            pw = valid ? expf(sc - mn) : 0.f;
            const float alpha = expf(m - mn);
            l = l * alpha + wsum(pw); o0 *= alpha; o1 *= alpha; m = mn;
        }
        const int nv = min(64, t - s0 + 1);
        for (int j = 0; j < nv; ++j) {
            const float pj = __shfl(pw, j); const float* vr = vb + (size_t)(s0 + j) * p.ldv;
            o0 += pj * vr[lane]; if (p.dv == 128) o1 += pj * vr[lane + 64];
        }
    }
    if (p.mode != 2) { const float il = 1.f / l; o0 *= il; o1 *= il; }
    float* orow = p.o + (rb + t) * p.ldo + h * p.dv;
    orow[lane] = o0; if (p.dv == 128) orow[lane + 64] = o1;
}

__global__ __launch_bounds__(256) void k_mixpost(const float* __restrict__ oa, float* ocat, const float* __restrict__ proj,
        const float* lq1, const float* lk1, const float* lq2, const float* lk2, const float* __restrict__ subln, const float* __restrict__ retgn, int layer) {
    const int t = blockIdx.x * 4 + (threadIdx.x >> 6), lane = threadIdx.x & 63;
    const float lam_init = 0.8f - 0.6f * expf(-0.3f * (float)layer);
    const float lam = expf(wsum(lq1[lane] * lk1[lane])) - expf(wsum(lq2[lane] * lk2[lane])) + lam_init;
    const float* oar = oa + (size_t)t * 1024; float* oc = ocat + (size_t)t * 1024;
#pragma unroll
    for (int h = 0; h < 4; ++h) {
        const float d0 = oar[(2 * h) * 128 + lane] - lam * oar[(2 * h + 1) * 128 + lane];
        const float d1 = oar[(2 * h) * 128 + 64 + lane] - lam * oar[(2 * h + 1) * 128 + 64 + lane];
        const float ms = wsum(d0 * d0 + d1 * d1) * (1.f / 128.f); const float r = 1.f / sqrtf(ms + EPS);
        oc[h * 128 + lane] = d0 * r * subln[lane] * (1.f - lam_init);
        oc[h * 128 + 64 + lane] = d1 * r * subln[64 + lane] * (1.f - lam_init);
    }
#pragma unroll
    for (int h = 0; h < 4; ++h) {
        const float v = oc[768 + h * 64 + lane]; const float mu = wsum(v) * (1.f / 64.f); const float dv = v - mu;
        const float var = wsum(dv * dv) * (1.f / 64.f);
        const float g = proj[(size_t)t * INC + C_GC + h * 64 + lane];
        oc[768 + h * 64 + lane] = dv / sqrtf(var + EPS) * retgn[h * 64 + lane] * silu_f(g);
    }
}
__global__ __launch_bounds__(256) void k_router(const float* __restrict__ xn, const float* __restrict__ router, int* cnt, int* lists, float* gl) {
    const int t = blockIdx.x * 4 + (threadIdx.x >> 6), lane = threadIdx.x & 63;
    float lg[8];
#pragma unroll
    for (int e = 0; e < 8; ++e) lg[e] = 0.f;
    for (int j = 0; j < 16; ++j) { const int k = lane + 64 * j; const float x = xn[(size_t)t * D + k];
#pragma unroll
        for (int e = 0; e < 8; ++e) lg[e] += x * router[k * 8 + e]; }
#pragma unroll
    for (int e = 0; e < 8; ++e) lg[e] = wsum(lg[e]);
    int i1 = 0; float v1 = lg[0];
#pragma unroll
    for (int e = 1; e < 8; ++e) if (lg[e] > v1) { v1 = lg[e]; i1 = e; }
    int i2 = -1; float v2 = -INFINITY;
#pragma unroll
    for (int e = 0; e < 8; ++e) if (e != i1 && lg[e] > v2) { v2 = lg[e]; i2 = e; }
    const float g2 = 1.f / (1.f + expf(v1 - v2)), g1 = 1.f - g2;
    if (lane == 0) {
        int p1 = atomicAdd(&cnt[i1], 1); lists[i1 * NTOK + p1] = t; gl[i1 * NTOK + p1] = g1;
        int p2 = atomicAdd(&cnt[i2], 1); lists[i2 * NTOK + p2] = t; gl[i2 * NTOK + p2] = g2;
    }
}
}

static void gold_sgemm(hipStream_t st, const float* A, int lda, const float* B, int ldb, float* C, int ldc, int M, int N, int K, int mode,
                       const int* rows = nullptr, const int* cnt = nullptr, const float* G = nullptr, const float* gate = nullptr) {
    gold::SG p{}; p.A = A; p.B = B; p.C = C; p.rows = rows; p.cnt = cnt; p.G = G; p.gate = gate; p.lda = lda; p.ldb = ldb; p.ldc = ldc; p.M = M; p.N = N; p.K = K; p.mode = mode; p.pad = 0;
    dim3 grid((N + 63) / 64, (M + 63) / 64);
    hipLaunchKernelGGL(gold::k_sgemm, grid, dim3(256), 0, st, p);
}

extern "C" void kernel_launch(void* const* d_in, const int* in_sizes, int n_in, void* d_out, int out_size, void* d_ws, size_t ws_size, hipStream_t stream) {
    using namespace gold;
    const float* x = (const float*)d_in[0]; const float* pin = (const float*)d_in[1];
    const float* norm_mix = (const float*)d_in[2]; const float* w_in = (const float*)d_in[3]; const float* b_forget = (const float*)d_in[4];
    const float* lq1 = (const float*)d_in[5]; const float* lk1 = (const float*)d_in[6]; const float* lq2 = (const float*)d_in[7]; const float* lk2 = (const float*)d_in[8];
    const float* subln = (const float*)d_in[9]; const float* ret_gn = (const float*)d_in[10]; const float* w_out = (const float*)d_in[11];
    const float* norm_ffn = (const float*)d_in[12]; const float* dwg = (const float*)d_in[13]; const float* dwu = (const float*)d_in[14]; const float* dwd = (const float*)d_in[15];
    const float* router = (const float*)d_in[16]; const float* mwg = (const float*)d_in[17]; const float* mwu = (const float*)d_in[18]; const float* mwd = (const float*)d_in[19];
    const float* ple_norm = (const float*)d_in[20]; const float* ple_gate = (const float*)d_in[21]; const float* ple_proj = (const float*)d_in[22]; const float* final_norm = (const float*)d_in[23];
    float* h = (float*)d_out;
    char* ws = (char*)d_ws; const size_t MiB = 1u << 20;
    int* cnt = (int*)ws;
    float* cum = (float*)(ws + 1 * MiB);
    int* lists = (int*)(ws + 2 * MiB);
    float* gl = (float*)(ws + 3 * MiB);
    float* xn = (float*)(ws + 4 * MiB);
    float* ocat = (float*)(ws + 68 * MiB);
    float* oa = (float*)(ws + 132 * MiB);
    float* proj = (float*)(ws + 196 * MiB);
    float* act = proj;
    if (ws_size < 420 * MiB) { fprintf(stderr, "ws too small\n"); return; }

    hipLaunchKernelGGL(k_copy, dim3(2048), dim3(256), 0, stream, x, h, (size_t)NTOK * D / 4);
    for (int i = 0; i < DEPTH; ++i) {
        hipLaunchKernelGGL(k_rms, dim3(NTOK / 4), dim3(256), 0, stream, (const float*)h, norm_mix + i * D, xn, NTOK);
        gold_sgemm(stream, xn, D, w_in + (size_t)i * D * INC, INC, proj, INC, NTOK, INC, D, 0);
        hipLaunchKernelGGL(k_cum, dim3(1), dim3(64), 0, stream, (const float*)proj, b_forget + i * 4, cum);
        hipLaunchKernelGGL(k_rotary, dim3((NTOK * 256 + 255) / 256), dim3(256), 0, stream, proj);
        { AT a{}; a.q = proj + C_QA; a.k = proj + C_KA; a.v = proj + C_VA; a.o = oa; a.cum = nullptr; a.ldq = a.ldk = a.ldv = INC; a.ldo = 1024; a.dv = 128; a.mode = 0; a.vshare = 2; a.scale = 0.125f;
          hipLaunchKernelGGL(k_attn, dim3(SEQ / 4, 8, BATCH), dim3(256), 0, stream, a); }
        { AT a{}; a.q = proj + C_QB; a.k = proj + C_KB; a.v = proj + C_VB; a.o = ocat + 512; a.cum = cum; a.ldq = a.ldk = a.ldv = INC; a.ldo = 1024; a.dv = 64; a.mode = 1; a.vshare = 1; a.scale = 0.125f;
          hipLaunchKernelGGL(k_attn, dim3(SEQ / 4, 4, BATCH), dim3(256), 0, stream, a); }
        { AT a{}; a.q = proj + C_QC; a.k = proj + C_KC; a.v = proj + C_VC; a.o = ocat + 768; a.cum = nullptr; a.ldq = a.ldk = a.ldv = INC; a.ldo = 1024; a.dv = 64; a.mode = 2; a.vshare = 1; a.scale = 1.f;
          hipLaunchKernelGGL(k_attn, dim3(SEQ / 4, 4, BATCH), dim3(256), 0, stream, a); }
        hipLaunchKernelGGL(k_mixpost, dim3(NTOK / 4), dim3(256), 0, stream, (const float*)oa, ocat, (const float*)proj, lq1 + i * 64, lk1 + i * 64, lq2 + i * 64, lk2 + i * 64, subln + i * 128, ret_gn + i * 256, i);
        gold_sgemm(stream, ocat, D, w_out + (size_t)i * D * D, D, h, D, NTOK, D, D, 1);
        hipLaunchKernelGGL(k_rms, dim3(NTOK / 4), dim3(256), 0, stream, (const float*)h, norm_ffn + i * D, xn, NTOK);
        const int j = i / 2;
        if (i % 2 == 0) {
            gold_sgemm(stream, xn, D, dwg + (size_t)j * D * FFD, FFD, act, FFD, NTOK, FFD, D, 2);
            gold_sgemm(stream, xn, D, dwu + (size_t)j * D * FFD, FFD, act, FFD, NTOK, FFD, D, 3);
            gold_sgemm(stream, act, FFD, dwd + (size_t)j * FFD * D, D, h, D, NTOK, D, FFD, 1);
        } else {
            hipMemsetAsync(cnt, 0, 64, stream);
            hipLaunchKernelGGL(k_router, dim3(NTOK / 4), dim3(256), 0, stream, (const float*)xn, router + (size_t)j * D * NE, cnt, lists, gl);
            for (int e = 0; e < NE; ++e) {
                const size_t wo = ((size_t)j * NE + e) * D * FFE;
                gold_sgemm(stream, xn, D, mwg + wo, FFE, act, FFE, NTOK, FFE, D, 2, lists + e * NTOK, cnt + e);
                gold_sgemm(stream, xn, D, mwu + wo, FFE, act, FFE, NTOK, FFE, D, 3, lists + e * NTOK, cnt + e);
                SG p{}; p.A = act; p.B = mwd + wo; p.C = h; p.rows = nullptr; p.cnt = cnt + e; p.G = nullptr; p.gate = gl + e * NTOK; p.lda = FFE; p.ldb = D; p.ldc = D; p.M = NTOK; p.N = D; p.K = FFE; p.mode = 6;
                p.rows = lists + e * NTOK;
                hipLaunchKernelGGL(k_sgemm, dim3(D / 64, NTOK / 64), dim3(256), 0, stream, p);
            }
        }
        hipLaunchKernelGGL(k_rms, dim3(NTOK / 4), dim3(256), 0, stream, (const float*)h, ple_norm + i * D, xn, NTOK);
        gold_sgemm(stream, xn, D, ple_gate + (size_t)i * D * D, D, ocat, D, NTOK, D, D, 4);
        gold_sgemm(stream, pin + (size_t)i * NTOK * PLE, PLE, ple_proj + (size_t)i * PLE * D, D, h, D, NTOK, D, PLE, 5, nullptr, nullptr, ocat);
    }
    hipLaunchKernelGGL(k_rms, dim3(NTOK / 4), dim3(256), 0, stream, (const float*)h, final_norm, h, NTOK);
}
```

```cpp
#include <hip/hip_runtime.h>
#include <cstdio>
#include <cstdint>
namespace pg8 {
#define PG8_LAS __attribute__((address_space(3)))
typedef unsigned short bf16_t;
typedef short bf16x8 __attribute__((ext_vector_type(8)));
typedef float f32x4 __attribute__((ext_vector_type(4)));
typedef unsigned u32x4 __attribute__((ext_vector_type(4)));
constexpr int BM = 256, BK = 64, HALF = 128, HTB = HALF * BK * 2  , STAGE_BYTES = 8 * HTB, NXCD = 8, WGM = 8;

__host__ __device__ __forceinline__ int lds_byte(int r, int c) { const int st = (r >> 4) * 2 + (c >> 5), rr = r & 15, cc = c & 31, ob = rr * 64 + cc * 2; return st * 1024 + (ob ^ (((ob >> 9) & 1) << 5)); }
__host__ __device__ __forceinline__ void stage_rc(int b, int& R, int& C) { const int st = b / 1024, sb = b % 1024, swz = sb ^ (((sb >> 9) & 1) << 5); R = (st >> 1) * 16 + swz / 64; C = (st & 1) * 32 + (swz % 64) / 2; }
__host__ __device__ __forceinline__ int perm32(int rho) { const int n = rho >> 4, i = rho & 15; return 8 * (i >> 2) + 4 * n + (i & 3); }

struct Unit { int pm, pn, pe; };
struct Gemm { const bf16_t* A; const bf16_t* Bt; int M, N, K; size_t bstride; };

struct StaticOrder {
    int nM, nN, nwg, G, c;
    __host__ __device__ void init(int M, int N, int G_, int c_) { nM = M / BM; nN = N / BM; nwg = nM * nN; G = G_; c = c_; }
    __host__ __device__ bool next(int i, Unit& u) const {
        const long L = (long)i * G + c; if (L >= nwg) return false;
        int wgid = (int)L; { const int q = nwg / NXCD, r = nwg % NXCD, xcd = wgid % NXCD, off = wgid / NXCD; wgid = (xcd < r ? xcd * (q + 1) : r * (q + 1) + (xcd - r) * q) + off; }
        const int nig = WGM * nN, gid = wgid / nig, fm = gid * WGM, gsz = (nM - fm) < WGM ? (nM - fm) : WGM;
        u.pm = fm + ((wgid % nig) % gsz); u.pn = (wgid % nig) / gsz; u.pe = 0; return true;
    }
    __device__ __forceinline__ void a_ready(const Unit&) const {}
    __device__ __forceinline__ void done(const Unit&) const {}
};

__device__ __forceinline__ unsigned cvt_pk_bf16(float lo, float hi) { unsigned r; asm volatile("v_cvt_pk_bf16_f32 %0, %1, %2" : "=v"(r) : "v"(lo), "v"(hi)); return r; }
typedef float f32x2 __attribute__((ext_vector_type(2)));
__device__ __forceinline__ f32x2 gelu_pk(f32x2 v) {
    const f32x2 av = __builtin_elementwise_abs(v), d = av * 0.2316418882f + 1.0f;
    f32x2 t; t.x = __builtin_amdgcn_rcpf(d.x); t.y = __builtin_amdgcn_rcpf(d.y);
    f32x2 q = t * 0.5307027145f + (-0.7265760135f); q = q * t + 0.7107068705f; q = q * t + (-0.142248368f); q = q * t + 0.127414796f; q = q * t;
    const f32x2 s = (v * v) * (-0.72134752044f);
    f32x2 e; e.x = __builtin_amdgcn_exp2f(s.x); e.y = __builtin_amdgcn_exp2f(s.y);
    const f32x2 m = v * (q * e), r = v - m;
    f32x2 o; o.x = v.x < 0.f ? m.x : r.x; o.y = v.y < 0.f ? m.y : r.y; return o;
}

template <int ACT  > struct EpiBf16 {
    static constexpr bool PERM = true, AFTER_DRAIN = false; static_assert(ACT == 0 || ACT == 1, "EpiBf16: ACT is 0 (none) or 1 (gelu_pk)");
    bf16_t* O; int ldc; const float* bias; int split_cols; size_t split_stride; float scale0;
    __device__ __forceinline__ void operator()(const f32x4 (&acc)[2][2][4][2], const Unit& u, int wr, int wc, int fr, int fq) const {
        const int row0 = u.pm * BM + wr * 64 + fr; int colt = u.pn * BM; bf16_t* base = O;
        float sc = 1.f; if (split_cols) { const int t = colt / split_cols; base += (size_t)t * split_stride; colt -= t * split_cols; if (t == 0) sc = scale0; }
        const int col0 = colt + wc * 32 + 8 * fq, bcol0 = u.pn * BM + wc * 32 + 8 * fq;
        f32x4 bv[2][2];
#pragma unroll
        for (int bj = 0; bj < 2; ++bj)
#pragma unroll
            for (int n = 0; n < 2; ++n) bv[bj][n] = bias ? *(const f32x4*)(bias + bcol0 + bj * HALF + 4 * n) : (f32x4){0.f, 0.f, 0.f, 0.f};
#pragma unroll
        for (int ai = 0; ai < 2; ++ai)
#pragma unroll
            for (int m = 0; m < 4; ++m) { bf16_t* rowp = base + (size_t)(row0 + ai * HALF + m * 16) * ldc + col0;
#pragma unroll
                for (int bj = 0; bj < 2; ++bj) { f32x4 v0 = acc[ai][bj][m][0] + bv[bj][0], v1 = acc[ai][bj][m][1] + bv[bj][1];
                    if (ACT == 1) { f32x2 a = gelu_pk((f32x2){v0[0], v0[1]}), b = gelu_pk((f32x2){v0[2], v0[3]}), c = gelu_pk((f32x2){v1[0], v1[1]}), d = gelu_pk((f32x2){v1[2], v1[3]});
                        v0 = (f32x4){a.x, a.y, b.x, b.y}; v1 = (f32x4){c.x, c.y, d.x, d.y}; }
                    v0 = v0 * sc; v1 = v1 * sc; u32x4 w; w.x = cvt_pk_bf16(v0[0], v0[1]); w.y = cvt_pk_bf16(v0[2], v0[3]); w.z = cvt_pk_bf16(v1[0], v1[1]); w.w = cvt_pk_bf16(v1[2], v1[3]);
                    *(u32x4*)(rowp + bj * HALF) = w; } }
    }
};

typedef int v8i32 __attribute__((ext_vector_type(8))); typedef short s16x16 __attribute__((ext_vector_type(16)));
__device__ __forceinline__ v8i32 cat8(bf16x8 lo, bf16x8 hi) { return __builtin_bit_cast(v8i32, __builtin_shufflevector(lo, hi, 0, 1, 2, 3, 4, 5, 6, 7, 8, 9, 10, 11, 12, 13, 14, 15)); }
__device__ __forceinline__ unsigned long long pack8_fp8(const f32x4 v0, const f32x4 v1) {
    unsigned lo = 0, hi = 0; lo = __builtin_amdgcn_cvt_pk_fp8_f32(v0[0], v0[1], lo, false); lo = __builtin_amdgcn_cvt_pk_fp8_f32(v0[2], v0[3], lo, true);
    hi = __builtin_amdgcn_cvt_pk_fp8_f32(v1[0], v1[1], hi, false); hi = __builtin_amdgcn_cvt_pk_fp8_f32(v1[2], v1[3], hi, true); return (unsigned long long)lo | ((unsigned long long)hi << 32); }
constexpr float RMS_EPS = 1e-6f;
constexpr float LOG2E = 1.4426950408889634f;
__device__ __forceinline__ float fast_sigmoid(float x) { return __builtin_amdgcn_rcpf(1.f + __builtin_amdgcn_exp2f(-x * LOG2E)); }
__device__ __forceinline__ float row_rstd(const float* st, int row) {
    const f32x4 a = *(const f32x4*)(st + (size_t)row * 4);
    return __builtin_amdgcn_rsqf(((a[0] + a[1]) + (a[2] + a[3])) * (1.f / 1024.f) + RMS_EPS);
}
__device__ __forceinline__ u32x4 pack8(const f32x4 v0, const f32x4 v1) { u32x4 w; w.x = cvt_pk_bf16(v0[0], v0[1]); w.y = cvt_pk_bf16(v0[2], v0[3]); w.z = cvt_pk_bf16(v1[0], v1[1]); w.w = cvt_pk_bf16(v1[2], v1[3]); return w; }
__device__ __forceinline__ float bf_lo(unsigned w) { return __builtin_bit_cast(float, w << 16); }
__device__ __forceinline__ float bf_hi(unsigned w) { return __builtin_bit_cast(float, w & 0xffff0000u); }

struct EpiIn {
    static constexpr bool PERM = true, AFTER_DRAIN = false;
    bf16_t* proj; float* logf; const float* stats; const float* rcos; const float* rsin; const float* bfg; float c2;
    __device__ __forceinline__ void operator()(const f32x4 (&acc)[2][2][4][2], const Unit& u, int wr, int wc, int fr, int fq) const {
        const int pn = u.pn; const int row0 = u.pm * BM + wr * 64 + fr;
        float rr[8];
#pragma unroll
        for (int k = 0; k < 8; ++k) rr[k] = row_rstd(stats, row0 + (k >> 2) * HALF + (k & 3) * 16);
#pragma unroll
        for (int ai = 0; ai < 2; ++ai)
#pragma unroll
            for (int m = 0; m < 4; ++m) {
                const int row = row0 + ai * HALF + m * 16; const float r = rr[ai * 4 + m];
                if (pn == 13) {
                    if (wc == 0 && fq == 0) { const f32x4 b = *(const f32x4*)bfg; f32x4 x = acc[ai][0][m][0] * r + b, o;
#pragma unroll
                        for (int i = 0; i < 4; ++i) o[i] = fminf(x[i], 0.f) - log1pf(__expf(-fabsf(x[i])));
                        *(f32x4*)(logf + (size_t)row * 4) = o; }
                } else if (pn == 9 || pn == 10) {
                    const float sc = (pn == 10) ? 0.125f * r : r; const int pos = row & 4095;
                    const f32x4* cp = (const f32x4*)(rcos + pos * 32 + 8 * fq); const f32x4* sp = (const f32x4*)(rsin + pos * 32 + 8 * fq);
                    f32x4 o1[2], o2[2];
#pragma unroll
                    for (int n = 0; n < 2; ++n) { const f32x4 c = cp[n], s = sp[n], x1 = acc[ai][0][m][n] * sc, x2 = acc[ai][1][m][n] * sc; o1[n] = x1 * c - x2 * s; o2[n] = x1 * s + x2 * c; }
                    bf16_t* dst = proj + (size_t)row * 3328 + 256 * pn + 64 * wc + 8 * fq;
                    *(u32x4*)dst = pack8(o1[0], o1[1]); *(u32x4*)(dst + 32) = pack8(o2[0], o2[1]);
                } else {
                    const float sc = (pn <= 1 || pn == 6) ? r * c2 : r;
                    bf16_t* dst = proj + (size_t)row * 3328 + 256 * pn + 32 * wc + 8 * fq;
#pragma unroll
                    for (int bj = 0; bj < 2; ++bj) *(u32x4*)(dst + bj * HALF) = pack8(acc[ai][bj][m][0] * sc, acc[ai][bj][m][1] * sc);
                }
            }
    }
};

template <int MODE> struct EpiRes {
    static constexpr bool PERM = true, AFTER_DRAIN = false;
    const bf16_t* hin; bf16_t* hb; float* stats_out; const float* stats_in; const bf16_t* pp; unsigned char* h8; float asc; PG8_LAS float* red;
    __device__ __forceinline__ void operator()(const f32x4 (&acc)[2][2][4][2], const Unit& u, int wr, int wc, int fr, int fq) const {
        const int row0 = u.pm * BM + wr * 64 + fr; const int col0 = u.pn * BM + wc * 32 + 8 * fq;
#pragma unroll
        for (int ai = 0; ai < 2; ++ai)
#pragma unroll
        for (int mp = 0; mp < 4; mp += 2) {
            u32x4 hw[4][2], pw[4][2]; float rr[4];
#pragma unroll
            for (int m = mp; m < mp + 2; ++m) { const int row = row0 + ai * HALF + m * 16;
#pragma unroll
                for (int bj = 0; bj < 2; ++bj) { hw[m][bj] = *(const u32x4*)(hin + (size_t)row * 1024 + col0 + bj * HALF); if (MODE == 1) pw[m][bj] = *(const u32x4*)(pp + (size_t)row * 1024 + col0 + bj * HALF); }
                rr[m] = (MODE == 1) ? row_rstd(stats_in, row) : 1.f; }
#pragma unroll
            for (int m = mp; m < mp + 2; ++m) {
                const int row = row0 + ai * HALF + m * 16; const float r = rr[m];
                float ss = 0.f;
#pragma unroll
                for (int bj = 0; bj < 2; ++bj) {
                    bf16_t* hp = hb + (size_t)row * 1024 + col0 + bj * HALF; const u32x4 hwv = hw[m][bj];
                    f32x4 h0 = (f32x4){bf_lo(hwv.x), bf_hi(hwv.x), bf_lo(hwv.y), bf_hi(hwv.y)}, h1 = (f32x4){bf_lo(hwv.z), bf_hi(hwv.z), bf_lo(hwv.w), bf_hi(hwv.w)};
                    f32x4 a0 = acc[ai][bj][m][0] * asc, a1 = acc[ai][bj][m][1] * asc;
                    if (MODE == 1) { const u32x4 pwv = pw[m][bj];
                        a0[0] = fast_sigmoid(a0[0] * r) * bf_lo(pwv.x); a0[1] = fast_sigmoid(a0[1] * r) * bf_hi(pwv.x); a0[2] = fast_sigmoid(a0[2] * r) * bf_lo(pwv.y); a0[3] = fast_sigmoid(a0[3] * r) * bf_hi(pwv.y);
                        a1[0] = fast_sigmoid(a1[0] * r) * bf_lo(pwv.z); a1[1] = fast_sigmoid(a1[1] * r) * bf_hi(pwv.z); a1[2] = fast_sigmoid(a1[2] * r) * bf_lo(pwv.w); a1[3] = fast_sigmoid(a1[3] * r) * bf_hi(pwv.w); }
                    h0 = h0 + a0; h1 = h1 + a1;
                    const u32x4 ow = pack8(h0, h1); *(u32x4*)hp = ow;
                    if (h8) *(unsigned long long*)(h8 + (size_t)row * 1024 + col0 + bj * HALF) = pack8_fp8(h0, h1);
                    const float q0 = bf_lo(ow.x), q1 = bf_hi(ow.x), q2 = bf_lo(ow.y), q3 = bf_hi(ow.y), q4 = bf_lo(ow.z), q5 = bf_hi(ow.z), q6 = bf_lo(ow.w), q7 = bf_hi(ow.w);
                    ss += ((q0 * q0 + q1 * q1) + (q2 * q2 + q3 * q3)) + ((q4 * q4 + q5 * q5) + (q6 * q6 + q7 * q7));
                }
                ss += __shfl_xor(ss, 16); ss += __shfl_xor(ss, 32);
                if (fq == 0) red[(wr * 64 + ai * HALF + m * 16 + fr) * 4 + wc] = ss;
            }
        }
        asm volatile("s_waitcnt lgkmcnt(0)" ::: "memory"); __builtin_amdgcn_s_barrier();
        { const int t = (wr * 4 + wc) * 64 + fq * 16 + fr; if (t < 256) { const f32x4 v = *(const PG8_LAS f32x4*)(red + 4 * t); stats_out[(size_t)(u.pm * BM + t) * 4 + u.pn] = (v[0] + v[1]) + (v[2] + v[3]); } }
        asm volatile("s_waitcnt lgkmcnt(0)" ::: "memory"); __builtin_amdgcn_s_barrier();
    }
};

template <bool SCALED, bool F8 = false> struct EpiGU {
    static constexpr bool PERM = true, AFTER_DRAIN = false;
    bf16_t* act; int ldact; const float* stats; float isc, osc;
    __device__ __forceinline__ void operator()(const f32x4 (&acc)[2][2][4][2], const Unit& u, int wr, int wc, int fr, int fq) const {
        const int row0 = u.pm * BM + wr * 64 + fr; const int col0 = u.pn * HALF + wc * 32 + 8 * fq;
        float rr[8];
#pragma unroll
        for (int k = 0; k < 8; ++k) rr[k] = SCALED ? row_rstd(stats, row0 + (k >> 2) * HALF + (k & 3) * 16) : 1.f;
#pragma unroll
        for (int ai = 0; ai < 2; ++ai)
#pragma unroll
            for (int m = 0; m < 4; ++m) {
                const int row = row0 + ai * HALF + m * 16; float r = F8 ? isc : 1.f; if (SCALED) r *= rr[ai * 4 + m];
                f32x4 o[2];
#pragma unroll
                for (int n = 0; n < 2; ++n) { const f32x4 g = acc[ai][0][m][n] * r, up = acc[ai][1][m][n] * r;
#pragma unroll
                    for (int i = 0; i < 4; ++i) o[n][i] = g[i] * fast_sigmoid(g[i]) * up[i]; }
                if (F8) *(unsigned long long*)((unsigned char*)act + (size_t)row * ldact + col0) = pack8_fp8(o[0] * osc, o[1] * osc);
                else *(u32x4*)(act + (size_t)row * ldact + col0) = pack8(o[0], o[1]);
            }
    }
};

struct EpiMoeDown {
    static constexpr bool PERM = true, AFTER_DRAIN = false;
    bf16_t* y; const int* dst; const float* gsort; float sc;
    __device__ __forceinline__ void operator()(const f32x4 (&acc)[2][2][4][2], const Unit& u, int wr, int wc, int fr, int fq) const {
        const int row0 = u.pm * BM + wr * 64 + fr; const int col0 = u.pn * BM + wc * 32 + 8 * fq;
        int dd[8]; float gg[8];
#pragma unroll
        for (int k = 0; k < 8; ++k) { const int row = row0 + (k >> 2) * HALF + (k & 3) * 16; dd[k] = dst[row]; gg[k] = gsort[row]; }
#pragma unroll
        for (int ai = 0; ai < 2; ++ai)
#pragma unroll
            for (int m = 0; m < 4; ++m) {
                const int d = dd[ai * 4 + m]; if (d < 0) continue; const float g = gg[ai * 4 + m] * sc;
#pragma unroll
                for (int bj = 0; bj < 2; ++bj) *(u32x4*)(y + (size_t)d * 1024 + col0 + bj * HALF) = pack8(acc[ai][bj][m][0] * g, acc[ai][bj][m][1] * g);
            }
    }
};

struct MoeOrder {
    int nM, nN, nwg, G, c; int tb[9];
    __device__ __forceinline__ bool next(int i, Unit& u) const {
        const long L = (long)i * G + c; if (L >= nwg) return false;
        int wgid = (int)L; { const int q = nwg / NXCD, r = nwg % NXCD, xcd = wgid % NXCD, off = wgid / NXCD; wgid = (xcd < r ? xcd * (q + 1) : r * (q + 1) + (xcd - r) * q) + off; }
        const int nig = WGM * nN, gid = wgid / nig, fm = gid * WGM, gsz = (nM - fm) < WGM ? (nM - fm) : WGM;
        u.pm = fm + ((wgid % nig) % gsz); u.pn = (wgid % nig) / gsz;
        int e = 0;
#pragma unroll
        for (int k = 1; k < 8; ++k) e += (u.pm >= tb[k]) ? 1 : 0;
        u.pe = e; return true;
    }
    __device__ __forceinline__ void a_ready(const Unit&) const {}
    __device__ __forceinline__ void done(const Unit&) const {}
};
template <class Epi, class Sched, bool ALIGN_EPI = false, bool SP2 = false, bool FP8 = false>
__device__ __forceinline__ void gemm_phase(PG8_LAS unsigned char* lds, const Gemm g, const Sched& S, const Epi& E, const int tid) {
    const int wid = __builtin_amdgcn_readfirstlane(tid >> 6), lane = tid & 63, wr = wid >> 2, wc = wid & 3, fr = lane & 15, fq = lane >> 4;
    const int K = g.K, KB = FP8 ? K : 2 * K  , nt = KB / (2 * BK);
    unsigned voffA[2], voffB[2];
#pragma unroll
    for (int i = 0; i < 2; ++i) { int R, C; stage_rc(tid * 16 + i * 8192, R, C); const int Rb = Epi::PERM ? ((R & ~31) + perm32(R & 31)) : R;
        voffA[i] = (unsigned)(R * KB + 2 * C); voffB[i] = (unsigned)(Rb * KB + 2 * C); }
    const size_t kstep = (size_t)(BK * 2);
    const size_t hstep = (size_t)HALF * KB;
    const size_t tstep = 2 * hstep;
    const unsigned ldsw = (unsigned)wid * 1024u;
    const int aoff = lds_byte(wr * 64 + fr, FP8 ? fq * 16 : fq * 8), boff = lds_byte(wc * 32 + fr, FP8 ? fq * 16 : fq * 8); constexpr int KPIECE = FP8 ? 16 : 1024;
#define PG8_SA(b, h) (((b) * 2 + (h)) * HTB)
#define PG8_SB(b, h) ((4 + (b) * 2 + (h)) * HTB)
#define PG8_STAGE(bufoff, gbase, voff) do { _Pragma("unroll") for (int _i = 0; _i < 2; ++_i) \
        __builtin_amdgcn_global_load_lds((const unsigned*)((const char*)(gbase) + (voff)[_i]), (PG8_LAS unsigned*)(lds + (bufoff) + ldsw + _i * 8192), 16, 0, 0); } while (0)
#define PG8_LDA(dst, b, h) do { if constexpr (FP8) { _Pragma("unroll") for (int m = 0; m < 4; ++m) dst##8[m] = *(const PG8_LAS v8i32*)(lds + PG8_SA(b, h) + aoff + m * 2048); } else _Pragma("unroll") for (int m = 0; m < 4; ++m) _Pragma("unroll") for (int k = 0; k < 2; ++k) dst[m][k] = *(const PG8_LAS bf16x8*)(lds + PG8_SA(b, h) + aoff + m * 2048 + k * 1024); } while (0)
#define PG8_LDB(dst, b, h) do { if constexpr (FP8) { _Pragma("unroll") for (int n = 0; n < 2; ++n) dst##8[n] = *(const PG8_LAS v8i32*)(lds + PG8_SB(b, h) + boff + n * 2048); } else _Pragma("unroll") for (int n = 0; n < 2; ++n) _Pragma("unroll") for (int k = 0; k < 2; ++k) dst[n][k] = *(const PG8_LAS bf16x8*)(lds + PG8_SB(b, h) + boff + n * 2048 + k * 1024); } while (0)
#define PG8_MMA(ai, bj, At, Bt) do { __builtin_amdgcn_s_setprio(1); _Pragma("unroll") for (int m = 0; m < 4; ++m) _Pragma("unroll") for (int n = 0; n < 2; ++n) { \
        if constexpr (FP8) { asm volatile("v_mfma_scale_f32_16x16x128_f8f6f4 %0, %1, %2, %0, %3, %3 op_sel_hi:[0,0,0]" : "+v"(acc[ai][bj][m][n]) : "v"(Bt##8[n]), "v"(At##8[m]), "v"(f8one)); } \
        else { _Pragma("unroll") for (int k = 0; k < 2; ++k) acc[ai][bj][m][n] = __builtin_amdgcn_mfma_f32_16x16x32_bf16(Bt[n][k], At[m][k], acc[ai][bj][m][n], 0, 0, 0); } } __builtin_amdgcn_s_setprio(0); } while (0)
#define PG8_WAIT_V(n) asm volatile("s_waitcnt vmcnt(" #n ")" ::: "memory")
#define PG8_WAIT_L(n) asm volatile("s_waitcnt lgkmcnt(" #n ")" ::: "memory")
#define PG8_BAR __builtin_amdgcn_s_barrier()
#define PG8_SCHED __builtin_amdgcn_sched_barrier(0)
    Unit cur, nxt; int ui = 0;
    if (!S.next(0, cur)) return;
    f32x4 acc[2][2][4][2];
#pragma unroll
    for (int a = 0; a < 2; ++a)
#pragma unroll
        for (int b = 0; b < 2; ++b)
#pragma unroll
            for (int m = 0; m < 4; ++m)
#pragma unroll
                for (int n = 0; n < 2; ++n) acc[a][b][m][n] = (f32x4){0.f, 0.f, 0.f, 0.f};
    bf16x8 At[4][2], B0[2][2], B1[2][2]; v8i32 At8[4], B08[2], B18[2]; const int f8one = 0x7f7f7f7f;
    const char* cA = (const char*)g.A + (size_t)cur.pm * tstep; const char* cB = (const char*)g.Bt + (size_t)cur.pn * tstep + (size_t)cur.pe * g.bstride;
    S.a_ready(cur);
    if constexpr (SP2) {
        PG8_STAGE(PG8_SB(0, 0), cB, voffB); PG8_STAGE(PG8_SB(0, 1), cB + hstep, voffB); PG8_STAGE(PG8_SA(0, 0), cA, voffA); PG8_STAGE(PG8_SA(0, 1), cA + hstep, voffA);
        if (wr == 1) PG8_BAR;
        PG8_WAIT_V(2); PG8_BAR;
        PG8_STAGE(PG8_SB(1, 0), cB + kstep, voffB); PG8_STAGE(PG8_SA(1, 0), cA + kstep, voffA); PG8_STAGE(PG8_SB(1, 1), cB + hstep + kstep, voffB);
        PG8_WAIT_V(6); PG8_BAR;
    } else {
        PG8_STAGE(PG8_SB(0, 0), cB, voffB); PG8_STAGE(PG8_SA(0, 0), cA, voffA); PG8_STAGE(PG8_SB(0, 1), cB + hstep, voffB); PG8_STAGE(PG8_SA(0, 1), cA + hstep, voffA);
        if (wr == 1) PG8_BAR;
        PG8_WAIT_V(4); PG8_BAR;
        PG8_STAGE(PG8_SB(1, 0), cB + kstep, voffB); PG8_STAGE(PG8_SA(1, 0), cA + kstep, voffA); PG8_STAGE(PG8_SB(1, 1), cB + hstep + kstep, voffB);
        PG8_WAIT_V(6); PG8_BAR;
    }
    for (;;) {
        const bool has_next = S.next(ui + 1, nxt);
        const char* nA = has_next ? (const char*)g.A + (size_t)nxt.pm * tstep : cA; const char* nB = has_next ? (const char*)g.Bt + (size_t)nxt.pn * tstep + (size_t)nxt.pe * g.bstride : cB;
#pragma unroll 1
        for (int t = 0; t < nt; t += 2) {
            const bool last = (t == nt - 2);
            const char* a1 = cA + (size_t)(t + 1) * kstep;
            const char* a2 = last ? nA : cA + (size_t)(t + 2) * kstep; const char* b2 = last ? nB : cB + (size_t)(t + 2) * kstep;
            const char* a3 = a2 + kstep; const char* b3 = b2 + kstep;
            if (last && has_next) S.a_ready(nxt);
            if constexpr (SP2) {
            PG8_LDB(B0, 0, 0); PG8_LDB(B1, 0, 1); PG8_SCHED; PG8_LDA(At, 0, 0); PG8_STAGE(PG8_SA(1, 1), a1 + hstep, voffA);
            PG8_WAIT_V(8); PG8_WAIT_L(0); PG8_BAR; PG8_MMA(0, 0, At, B0); PG8_MMA(0, 1, At, B1); PG8_BAR; PG8_SCHED;
            PG8_LDA(At, 0, 1); PG8_STAGE(PG8_SB(0, 0), b2, voffB); PG8_STAGE(PG8_SB(0, 1), b2 + hstep, voffB); PG8_STAGE(PG8_SA(0, 0), a2, voffA);
            PG8_WAIT_V(8); PG8_WAIT_L(0); PG8_BAR; PG8_MMA(1, 0, At, B0); PG8_MMA(1, 1, At, B1); PG8_BAR; PG8_SCHED;
            PG8_LDB(B0, 1, 0); PG8_LDB(B1, 1, 1); PG8_SCHED; PG8_LDA(At, 1, 0); PG8_STAGE(PG8_SA(0, 1), a2 + hstep, voffA);
            PG8_WAIT_V(8); PG8_WAIT_L(0); PG8_BAR; PG8_MMA(0, 0, At, B0); PG8_MMA(0, 1, At, B1); PG8_BAR; PG8_SCHED;
            PG8_LDA(At, 1, 1); PG8_STAGE(PG8_SB(1, 0), b3, voffB); PG8_STAGE(PG8_SB(1, 1), b3 + hstep, voffB); PG8_STAGE(PG8_SA(1, 0), a3, voffA);
            PG8_WAIT_V(8); PG8_WAIT_L(0); PG8_BAR; PG8_MMA(1, 0, At, B0); PG8_MMA(1, 1, At, B1); PG8_BAR; PG8_SCHED;
            } else {
            PG8_LDB(B0, 0, 0); PG8_SCHED; PG8_LDA(At, 0, 0); PG8_STAGE(PG8_SA(1, 1), a1 + hstep, voffA);
            PG8_WAIT_L(8); PG8_BAR; PG8_WAIT_L(0); PG8_MMA(0, 0, At, B0); PG8_BAR; PG8_SCHED;
            PG8_LDB(B1, 0, 1); PG8_STAGE(PG8_SB(0, 0), b2, voffB);
            PG8_BAR; PG8_WAIT_L(0); PG8_MMA(0, 1, At, B1); PG8_BAR;
            PG8_LDA(At, 0, 1); PG8_STAGE(PG8_SA(0, 0), a2, voffA);
            PG8_BAR; PG8_WAIT_L(0); PG8_MMA(1, 0, At, B0); PG8_BAR; PG8_SCHED;
            PG8_STAGE(PG8_SB(0, 1), b2 + hstep, voffB);
            PG8_WAIT_V(6); PG8_BAR; PG8_MMA(1, 1, At, B1); PG8_BAR;
            PG8_LDB(B0, 1, 0); PG8_SCHED; PG8_LDA(At, 1, 0); PG8_STAGE(PG8_SA(0, 1), a2 + hstep, voffA);
            PG8_WAIT_L(8); PG8_BAR; PG8_WAIT_L(0); PG8_MMA(0, 0, At, B0); PG8_BAR; PG8_SCHED;
            PG8_LDB(B1, 1, 1); PG8_STAGE(PG8_SB(1, 0), b3, voffB);
            PG8_BAR; PG8_WAIT_L(0); PG8_MMA(0, 1, At, B1); PG8_BAR;
            PG8_LDA(At, 1, 1); PG8_STAGE(PG8_SA(1, 0), a3, voffA);
            PG8_BAR; PG8_WAIT_L(0); PG8_MMA(1, 0, At, B0); PG8_BAR; PG8_SCHED;
            PG8_STAGE(PG8_SB(1, 1), b3 + hstep, voffB);
            PG8_WAIT_V(6); PG8_BAR; PG8_MMA(1, 1, At, B1); PG8_BAR;
            }
        }
        if constexpr (ALIGN_EPI) { if (wr == 0) PG8_BAR; }
        if constexpr (!Epi::AFTER_DRAIN) { if constexpr (FP8) asm volatile("s_nop 15\n\ts_nop 15" ::: "memory"); int t2_ = tid; asm volatile("" : "+v"(t2_)); const int l2_ = t2_ & 63; E(acc, cur, wr, wc, l2_ & 15, l2_ >> 4); S.done(cur); }
        if (!has_next) break;
#pragma unroll
        for (int a = 0; a < 2; ++a)
#pragma unroll
            for (int b = 0; b < 2; ++b)
#pragma unroll
                for (int m = 0; m < 4; ++m)
#pragma unroll
                    for (int n = 0; n < 2; ++n) acc[a][b][m][n] = (f32x4){0.f, 0.f, 0.f, 0.f};
        cur = nxt; cA = nA; cB = nB; ++ui;
        if constexpr (ALIGN_EPI) { if (wr == 1) PG8_BAR; }
    }
    PG8_WAIT_V(0);
    if constexpr (!ALIGN_EPI) { if (wr == 0) PG8_BAR; }
    PG8_BAR;
    if constexpr (Epi::AFTER_DRAIN) { E.fused(acc, cur, wr, wc, fr, fq, lds, wid, lane); S.done(cur); }
#undef PG8_SA
#undef PG8_SB
#undef PG8_STAGE
#undef PG8_LDA
#undef PG8_LDB
#undef PG8_MMA
#undef PG8_WAIT_V
#undef PG8_WAIT_L
#undef PG8_BAR
#undef PG8_SCHED
}
}
#include <hip/hip_bf16.h>
#include <cmath>
namespace attn_body {
using bf16=__hip_bfloat16;
using bf16x8=__attribute__((ext_vector_type(8)))short;
using s16x4=__attribute__((ext_vector_type(4)))short;
using f32x16=__attribute__((ext_vector_type(16)))float;
using u32x4=__attribute__((ext_vector_type(4)))unsigned;
constexpr int BATCH=4,SEQ=4096,D=64,PQ=3328,PKV=3328,PO=1024;
constexpr int NW=8,QBLK=32,QB=QBLK*NW,KVBLK=64,NQB=SEQ/QB;
constexpr int ATTN_UNIT_ROWS=QB; typedef float f32x4_t __attribute__((ext_vector_type(4)));
__device__ __forceinline__ int crow(int r,int hi){return (r&3)+8*(r>>2)+4*hi;}
#define SBAR() __builtin_amdgcn_sched_barrier(0)
__device__ __forceinline__ void cmask(f32x16&p0,f32x16&p1,int jb,int qrel,int hi){
  const float NEG=-INFINITY; int kb=64*jb+4*hi;
  #pragma unroll
  for(int r=0;r<16;++r){int kv=kb+(r&3)+8*(r>>2); if(kv>qrel)p0[r]=NEG; if(kv+32>qrel)p1[r]=NEG;}
}

constexpr int NSLOT=3, SLOTB=8192;
constexpr int VSLOTB=2*SLOTB; constexpr int LDS_K=0, LDS_V=NSLOT*SLOTB, LDS_WS=NSLOT*SLOTB+NSLOT*VSLOTB, LDS_OST=LDS_WS+NW*64*4, LDS_BYTES=LDS_OST+NW*4096;
constexpr float C2=0.125f*1.4426950408889634f;
__device__ __forceinline__ void glds16(const void*gsrc,unsigned lds_dst){unsigned keep;
  asm volatile("s_mov_b32 %0, m0\n\ts_mov_b32 m0, %2\n\ts_nop 0\n\tglobal_load_lds_dwordx4 %1, off\n\ts_mov_b32 m0, %0":"=&s"(keep):"v"(gsrc),"s"(lds_dst):"memory");}
__device__ __forceinline__ float max3f(float a,float b,float c){float r;asm("v_max3_f32 %0, %1, %2, %3":"=v"(r):"v"(a),"v"(b),"v"(c));return r;}
__device__ __forceinline__ float max2f(float a,float b){float r;asm("v_max_f32_e32 %0, %1, %2":"=v"(r):"v"(a),"v"(b));return r;}
__device__ __forceinline__ float fadd_s(float a,float b){float r;asm("v_add_f32_e32 %0, %1, %2":"=v"(r):"v"(a),"v"(b));return r;}
__device__ __forceinline__ float fsub_s(float a,float b){float r;asm("v_sub_f32_e32 %0, %1, %2":"=v"(r):"v"(a),"v"(b));return r;}
typedef float f32x2_t __attribute__((ext_vector_type(2))); typedef __bf16 bf16x2_t __attribute__((ext_vector_type(2)));
__device__ __forceinline__ unsigned cvtpk_s(float lo,float hi){f32x2_t v={lo,hi};bf16x2_t b=__builtin_convertvector(v,bf16x2_t);return __builtin_bit_cast(unsigned,b);}
#define WAIT_BAR(N) asm volatile("s_waitcnt vmcnt(" #N ") lgkmcnt(0)\n\ts_barrier":::"memory")

__device__ __forceinline__ void qkt(f32x16&p0,f32x16&p1,const char*Kslot,const bf16x8*qr,const f32x16&negm,int r32,int hi){
  const char*kb=Kslot+hi*1024+r32*16;
  #pragma unroll
  for(int d0=0;d0<4;++d0){
    const bf16x8 b0=*reinterpret_cast<const bf16x8*>(kb+d0*2048);
    const bf16x8 b1=*reinterpret_cast<const bf16x8*>(kb+d0*2048+512);
    if(d0==0){p0=__builtin_amdgcn_mfma_f32_32x32x16_bf16(b0,qr[0],negm,0,0,0);p1=__builtin_amdgcn_mfma_f32_32x32x16_bf16(b1,qr[0],negm,0,0,0);}
    else{p0=__builtin_amdgcn_mfma_f32_32x32x16_bf16(b0,qr[d0],p0,0,0,0);p1=__builtin_amdgcn_mfma_f32_32x32x16_bf16(b1,qr[d0],p1,0,0,0);}}
}
typedef __attribute__((address_space(3))) const char* lds_cptr;
typedef short v4i16_t __attribute__((ext_vector_type(4)));
__device__ __forceinline__ void kload8(bf16x8*kf,lds_cptr kp){
  kf[0]=*(const __attribute__((address_space(3))) bf16x8*)(kp);      kf[1]=*(const __attribute__((address_space(3))) bf16x8*)(kp+512);
  kf[2]=*(const __attribute__((address_space(3))) bf16x8*)(kp+2048); kf[3]=*(const __attribute__((address_space(3))) bf16x8*)(kp+2560);
  kf[4]=*(const __attribute__((address_space(3))) bf16x8*)(kp+4096); kf[5]=*(const __attribute__((address_space(3))) bf16x8*)(kp+4608);
  kf[6]=*(const __attribute__((address_space(3))) bf16x8*)(kp+6144); kf[7]=*(const __attribute__((address_space(3))) bf16x8*)(kp+6656);
}
__device__ __forceinline__ void kload2(bf16x8*kf,lds_cptr kp,int j){ kf[2*j]=*(const __attribute__((address_space(3))) bf16x8*)(kp+j*2048); kf[2*j+1]=*(const __attribute__((address_space(3))) bf16x8*)(kp+j*2048+512); }
__device__ __forceinline__ s16x4 vtr(lds_cptr p){ return __builtin_bit_cast(s16x4,__builtin_amdgcn_ds_read_tr16_b64_v4i16((__attribute__((address_space(3))) v4i16_t*)p)); }
__device__ __forceinline__ float rowmax(const f32x16&p0,const f32x16&p1){
  float a=max3f(p0[0],p0[1],p1[0]),b=max3f(p0[2],p0[3],p1[1]);a=max3f(a,p1[2],p1[3]);
  #pragma unroll
  for(int r=4;r<16;r+=4){a=max3f(a,p0[r],p0[r+1]);b=max3f(b,p0[r+2],p0[r+3]);a=max3f(a,p1[r],p1[r+1]);b=max3f(b,p1[r+2],p1[r+3]);}
  const float m=max2f(a,b);
  auto rr=__builtin_amdgcn_permlane32_swap(__float_as_uint(m),__float_as_uint(m),false,false);
  return max2f(__uint_as_float(rr[0]),__uint_as_float(rr[1]));
}
__device__ __forceinline__ void pv(f32x16*o,int vb,bf16x8 pa0,bf16x8 pa1,bf16x8 pa2,bf16x8 pa3){
  #pragma unroll
  for(int d0=0;d0<2;++d0){s16x4 lo[4],hi[4];
    #pragma unroll
    for(int ks=0;ks<4;++ks){
      asm volatile("ds_read_b64_tr_b16 %0,%1 offset:%c2":"=&v"(lo[ks]):"v"(vb),"i"(d0*4096+ks*1024):"memory");
      asm volatile("ds_read_b64_tr_b16 %0,%1 offset:%c2":"=&v"(hi[ks]):"v"(vb),"i"(d0*4096+ks*1024+512):"memory");}
    asm volatile("s_waitcnt lgkmcnt(0)":::"memory");SBAR();
    #define PK(k) (bf16x8){lo[k][0],lo[k][1],lo[k][2],lo[k][3],hi[k][0],hi[k][1],hi[k][2],hi[k][3]}
    o[d0]=__builtin_amdgcn_mfma_f32_32x32x16_bf16(pa0,PK(0),o[d0],0,0,0);
    o[d0]=__builtin_amdgcn_mfma_f32_32x32x16_bf16(pa1,PK(1),o[d0],0,0,0);
    o[d0]=__builtin_amdgcn_mfma_f32_32x32x16_bf16(pa2,PK(2),o[d0],0,0,0);
    o[d0]=__builtin_amdgcn_mfma_f32_32x32x16_bf16(pa3,PK(3),o[d0],0,0,0);
    #undef PK
  }
}

#ifndef ATTN_STORE16
#define ATTN_STORE16(p,v) (*(u32x4*)(p)=(v))
#endif
template<int THRL,bool BIAS,bool DV2> __device__ __forceinline__ void attn_unit(int b,int qb,const bf16*Q,const bf16*__restrict__ K,const bf16*__restrict__ V,bf16*O,char*shm,const __attribute__((address_space(3))) float*kbias,const int tid){
  const int lane=tid&63,r32=lane&31,hi=lane>>5; const int wid=__builtin_amdgcn_readfirstlane(tid>>6);
  const long rowbase=(long)b*SEQ; const int q0=qb*QB;
  const bf16*Qw=Q+(rowbase+q0+wid*QBLK)*PQ;
  const bf16*Kh=K+rowbase*PKV,*Vh=V+rowbase*PKV;
  const unsigned lds0=(unsigned)(uintptr_t)shm;
  float*wsf=(float*)(shm+LDS_WS)+wid*64;
  const bf16*ksrc=Kh+(long)lane*PKV+wid*8;
  const bf16*vsrc=Vh+(long)(16*(wid&3)+(lane>>2))*PKV+(wid>>2)*32+(lane&3)*8;
  const unsigned kdst=lds0+LDS_K+wid*1024, vdst=lds0+LDS_V+wid*1024;
  #define DMA_K(t,slot) glds16(ksrc+(long)(t)*KVBLK*PKV,(unsigned)__builtin_amdgcn_readfirstlane(kdst+(slot)))
  #define DMA_V(t,slot) do{ glds16(vsrc+(long)(t)*KVBLK*PKV,(unsigned)__builtin_amdgcn_readfirstlane(vdst+2*(slot))); if(DV2) glds16(vsrc+64+(long)(t)*KVBLK*PKV,(unsigned)__builtin_amdgcn_readfirstlane(vdst+2*(slot)+8192)); }while(0)
  const int vb0=(int)(lds0+LDS_V)+((lane>>4)&1)*32+(lane&3)*8+(4*hi+((lane&15)>>2))*64;
  const char*Kbase=shm+LDS_K; bf16x8 kf[8];
  const lds_cptr shm3=(lds_cptr)shm; const lds_cptr kp0=shm3+LDS_K+hi*1024+r32*16; const lds_cptr vp0=shm3+LDS_V+((lane>>4)&1)*32+(lane&3)*8+(4*hi+((lane&15)>>2))*64;
  const int NT=(q0+QB)/KVBLK;
  DMA_K(0,0);DMA_V(0,0);DMA_K(1,SLOTB);
  bf16x8 qr[4];
  #pragma unroll
  for(int d0=0;d0<4;++d0)qr[d0]=*reinterpret_cast<const bf16x8*>(&Qw[(long)r32*PQ+d0*16+hi*8]);
  const __attribute__((address_space(3))) char* qst_=(const __attribute__((address_space(3))) char*)((lds_cptr)shm+LDS_OST+wid*4096+lane*16);
  if(DV2){ _Pragma("unroll") for(int d0=0;d0<4;++d0)*(__attribute__((address_space(3))) bf16x8*)(qst_+d0*1024)=qr[d0]; }
  #define QF(j) (DV2?*(const __attribute__((address_space(3))) bf16x8*)(qst_+(j)*1024):qr[j])
  float mhat=0.f,l_reg=0.f;f32x16 o[4];o[0]=f32x16{};o[1]=f32x16{};o[2]=f32x16{};o[3]=f32x16{};const f32x16 negm=f32x16{}; const float kbq=BIAS?kbias[q0+wid*QBLK+r32]:0.f;
  const int qrel=wid*QBLK+r32;
  #define CMASK(P0,P1,t) do{int jb_=(t)-(NT-4); if(jb_>=0)cmask(P0,P1,jb_,qrel,hi);}while(0)
  bool resc=false;
  #define START(P0,P1) do{ const float rm=rowmax(P0,P1); resc=false; \
    mhat=rm; const float mo_=BIAS?mhat+kbq:mhat; \
    _Pragma("unroll") for(int r=0;r<16;++r)P0[r]=__builtin_amdgcn_exp2f((BIAS?P0[r]+kbias[crow(r,hi)]:P0[r])-mo_); \
    _Pragma("unroll") for(int r=0;r<16;++r)P1[r]=__builtin_amdgcn_exp2f((BIAS?P1[r]+kbias[32+crow(r,hi)]:P1[r])-mo_); }while(0)
  #define RESC() do{ if(resc){ asm volatile("s_waitcnt lgkmcnt(0)":::"memory"); \
      _Pragma("unroll") for(int d_=0;d_<(DV2?4:2);++d_) _Pragma("unroll") for(int r=0;r<16;++r)o[d_][r]*=wsf[crow(r,hi)]; } }while(0)
  f32x16 pA0,pA1,pB0,pB1;
  int sl_prev=0,sl_cur=0,sl_next=SLOTB;
  #define ROT() do{sl_prev=sl_cur;sl_cur=sl_next;sl_next=(sl_next==(NSLOT-1)*SLOTB)?0:sl_next+SLOTB;}while(0)
  DMA_K(2,2*SLOTB);
  if(DV2){WAIT_BAR(4);}else{WAIT_BAR(3);}
  qkt(pA0,pA1,Kbase,qr,negm,r32,hi);asm volatile("s_nop 15\n\ts_nop 7":"+v"(pA0),"+v"(pA1));CMASK(pA0,pA1,0);
  START(pA0,pA1);
  WAIT_BAR(0);
  DMA_K(3,0);DMA_V(1,SLOTB);
  ROT();
  kload8(kf,kp0+sl_cur);
  if(DV2){WAIT_BAR(3);}else{WAIT_BAR(2);}
  s16x4 vlo[8],vhi[8]; u32x4 pw0,pw1,pw2,pw3;
  #define PKW(P,B) cvtpk_s(P[B],P[B+1])
  #define PAF(k) __builtin_bit_cast(bf16x8,pw##k)
  #define VFR(i) (bf16x8){vlo[i][0],vlo[i][1],vlo[i][2],vlo[i][3],vhi[i][0],vhi[i][1],vhi[i][2],vhi[i][3]}
  #define PIN(x) asm volatile("":"+v"(x))
  #define MX3(a,b,c) __builtin_fmaxf(__builtin_fmaxf((a),(b)),(c))
  #define GAPA(MF,A0,A1,A2,A3,W0,W1,PW) do{ MF; sacc+=A0; sacc+=A1; sacc+=A2; sacc+=A3; PIN(sacc); W0; W1; PIN(PW); SBAR(); }while(0)
  #define EX(v) __builtin_amdgcn_exp2f(v)
  #define GAPB(MF,X,B,IDX) do{ f32x4_t bq_; if(BIAS)bq_=bp_[IDX]; MF; if(BIAS){ X[B]=EX((X[B]+bq_[0])-mo_); X[B+1]=EX((X[B+1]+bq_[1])-mo_); X[B+2]=EX((X[B+2]+bq_[2])-mo_); X[B+3]=EX((X[B+3]+bq_[3])-mo_); } else { X[B]=EX(X[B]-mo_); X[B+1]=EX(X[B+1]-mo_); X[B+2]=EX(X[B+2]-mo_); X[B+3]=EX(X[B+3]-mo_); } PIN(X); SBAR(); }while(0)
  #define VRD(i) do{ vlo[i]=vtr(vp_+(((i)>>2)*4096+((i)&3)*1024)); vhi[i]=vtr(vp_+(((i)>>2)*4096+((i)&3)*1024+512)); }while(0)
  #define VRD2(i) do{ if(DV2){ vlo[i]=vtr(vp_+8192+(((i)>>2)*4096+((i)&3)*1024)); vhi[i]=vtr(vp_+8192+(((i)>>2)*4096+((i)&3)*1024+512)); SBAR(); } }while(0)
  #define GAPX(MF,X,B,IDX,I,XE) do{ if(DV2){ MF; XE[2*(I)]=EX(XE[2*(I)]-mo_); XE[2*(I)+1]=EX(XE[2*(I)+1]-mo_); PIN(XE); SBAR(); } else { GAPB(MF,X,B,IDX); } }while(0)
  #define KRD(G,j) do{ if(G){ kload2(kf,kp0+sl_next,j); SBAR(); } }while(0)
  #define STEP(C0,C1,P0,P1,t,GK,GV,GL) do{ SBAR(); \
    const lds_cptr vp_=vp0+2*sl_prev; const __attribute__((address_space(3))) f32x4_t* bp_=(const __attribute__((address_space(3))) f32x4_t*)(kbias+64*(t))+hi; \
    VRD(0); SBAR(); float sacc=(P0[0]+P0[1]); \
    GAPA(C0=__builtin_amdgcn_mfma_f32_32x32x16_bf16(kf[0],QF(0),negm,0,0,0), P0[2],P0[3],P0[4],P0[5],     pw0[0]=PKW(P0,0), pw0[1]=PKW(P0,2), pw0); \
    VRD(4); SBAR(); GAPA(C1=__builtin_amdgcn_mfma_f32_32x32x16_bf16(kf[1],QF(0),negm,0,0,0), P0[6],P0[7],P0[8],P0[9],     pw0[2]=PKW(P0,4), pw0[3]=PKW(P0,6), pw0); \
    VRD(1); SBAR(); GAPA(C0=__builtin_amdgcn_mfma_f32_32x32x16_bf16(kf[2],QF(1),C0,0,0,0),   P0[10],P0[11],P0[12],P0[13], pw1[0]=PKW(P0,8), pw1[1]=PKW(P0,10), pw1); \
    VRD(5); SBAR(); GAPA(C1=__builtin_amdgcn_mfma_f32_32x32x16_bf16(kf[3],QF(1),C1,0,0,0),   P0[14],P0[15],P1[0],P1[1],   pw1[2]=PKW(P0,12),pw1[3]=PKW(P0,14), pw1); \
    VRD(2); SBAR(); GAPA(C0=__builtin_amdgcn_mfma_f32_32x32x16_bf16(kf[4],QF(2),C0,0,0,0),   P1[2],P1[3],P1[4],P1[5],     pw2[0]=PKW(P1,0), pw2[1]=PKW(P1,2), pw2); \
    VRD(6); SBAR(); GAPA(C1=__builtin_amdgcn_mfma_f32_32x32x16_bf16(kf[5],QF(2),C1,0,0,0),   P1[6],P1[7],P1[8],P1[9],     pw2[2]=PKW(P1,4), pw2[3]=PKW(P1,6), pw2); \
    VRD(3); SBAR(); GAPA(C0=__builtin_amdgcn_mfma_f32_32x32x16_bf16(kf[6],QF(3),C0,0,0,0),   P1[10],P1[11],P1[12],P1[13], pw3[0]=PKW(P1,8), pw3[1]=PKW(P1,10), pw3); \
    VRD(7); SBAR(); GAPA(C1=__builtin_amdgcn_mfma_f32_32x32x16_bf16(kf[7],QF(3),C1,0,0,0),   P1[14],P1[15],0.f,0.f,       pw3[2]=PKW(P1,12),pw3[3]=PKW(P1,14), pw3); \
    l_reg+=sacc; \
    if(GK){DMA_K((t)+3,sl_cur);} if(GV){DMA_V((t)+1,sl_next);} \
    CMASK(C0,C1,t); \
    { float a=MX3(C0[0],C0[1],C1[0]),b=MX3(C0[2],C0[3],C1[1]); a=MX3(a,C1[2],C1[3]); \
      _Pragma("unroll") for(int r=4;r<16;r+=4){a=MX3(a,C0[r],C0[r+1]);b=MX3(b,C0[r+2],C0[r+3]);a=MX3(a,C1[r],C1[r+1]);b=MX3(b,C1[r+2],C1[r+3]);} \
      float rm=__builtin_fmaxf(a,b); { auto rr=__builtin_amdgcn_permlane32_swap(__float_as_uint(rm),__float_as_uint(rm),false,false); rm=__builtin_fmaxf(__uint_as_float(rr[0]),__uint_as_float(rr[1])); } rm-=mhat; \
      resc=false; \
      if(__builtin_expect(__any(rm>(float)THRL),0)){ const float dl=__builtin_fmaxf(rm,0.f); mhat+=dl; \
        const float f=__builtin_amdgcn_exp2f(-dl); l_reg*=f; if(hi==0)wsf[r32]=f; resc=true; } } const float mo_=BIAS?mhat+kbq:mhat; \
    SBAR(); \
    GAPX(o[0]=__builtin_amdgcn_mfma_f32_32x32x16_bf16(PAF(0),VFR(0),o[0],0,0,0), C0,0,0,0,C0); VRD2(0); \
    GAPX(o[1]=__builtin_amdgcn_mfma_f32_32x32x16_bf16(PAF(0),VFR(4),o[1],0,0,0), C0,4,2,1,C0); VRD2(4); \
    KRD(GL,0); GAPX(o[0]=__builtin_amdgcn_mfma_f32_32x32x16_bf16(PAF(1),VFR(1),o[0],0,0,0), C0,8,4,2,C0); VRD2(1); \
    KRD(GL,1); GAPX(o[1]=__builtin_amdgcn_mfma_f32_32x32x16_bf16(PAF(1),VFR(5),o[1],0,0,0), C0,12,6,3,C0); VRD2(5); \
    KRD(GL,2); GAPX(o[0]=__builtin_amdgcn_mfma_f32_32x32x16_bf16(PAF(2),VFR(2),o[0],0,0,0), C1,0,8,4,C0); VRD2(2); \
    KRD(GL,3); GAPX(o[1]=__builtin_amdgcn_mfma_f32_32x32x16_bf16(PAF(2),VFR(6),o[1],0,0,0), C1,4,10,5,C0); VRD2(6); \
    GAPX(o[0]=__builtin_amdgcn_mfma_f32_32x32x16_bf16(PAF(3),VFR(3),o[0],0,0,0), C1,8,12,6,C0); VRD2(3); \
    GAPX(o[1]=__builtin_amdgcn_mfma_f32_32x32x16_bf16(PAF(3),VFR(7),o[1],0,0,0), C1,12,14,7,C0); VRD2(7); \
    if(DV2){ o[2]=__builtin_amdgcn_mfma_f32_32x32x16_bf16(PAF(0),VFR(0),o[2],0,0,0); C1[0]=EX(C1[0]-mo_); C1[1]=EX(C1[1]-mo_); PIN(C1); SBAR(); o[3]=__builtin_amdgcn_mfma_f32_32x32x16_bf16(PAF(0),VFR(4),o[3],0,0,0); C1[2]=EX(C1[2]-mo_); C1[3]=EX(C1[3]-mo_); PIN(C1); SBAR(); o[2]=__builtin_amdgcn_mfma_f32_32x32x16_bf16(PAF(1),VFR(1),o[2],0,0,0); C1[4]=EX(C1[4]-mo_); C1[5]=EX(C1[5]-mo_); PIN(C1); SBAR(); o[3]=__builtin_amdgcn_mfma_f32_32x32x16_bf16(PAF(1),VFR(5),o[3],0,0,0); C1[6]=EX(C1[6]-mo_); C1[7]=EX(C1[7]-mo_); PIN(C1); SBAR(); \
      o[2]=__builtin_amdgcn_mfma_f32_32x32x16_bf16(PAF(2),VFR(2),o[2],0,0,0); C1[8]=EX(C1[8]-mo_); C1[9]=EX(C1[9]-mo_); PIN(C1); SBAR(); o[3]=__builtin_amdgcn_mfma_f32_32x32x16_bf16(PAF(2),VFR(6),o[3],0,0,0); C1[10]=EX(C1[10]-mo_); C1[11]=EX(C1[11]-mo_); PIN(C1); SBAR(); o[2]=__builtin_amdgcn_mfma_f32_32x32x16_bf16(PAF(3),VFR(3),o[2],0,0,0); C1[12]=EX(C1[12]-mo_); C1[13]=EX(C1[13]-mo_); PIN(C1); SBAR(); o[3]=__builtin_amdgcn_mfma_f32_32x32x16_bf16(PAF(3),VFR(7),o[3],0,0,0); C1[14]=EX(C1[14]-mo_); C1[15]=EX(C1[15]-mo_); PIN(C1); SBAR(); } \
    }while(0)
  int t=1;
  #undef CMASK
  #define CMASK(P0,P1,t) do{}while(0)
  for(;t+5<NT;t+=2){
    STEP(pB0,pB1,pA0,pA1,t,true,true,true);     if(DV2){WAIT_BAR(3);}else{WAIT_BAR(2);} RESC(); ROT();
    STEP(pA0,pA1,pB0,pB1,t+1,true,true,true);   if(DV2){WAIT_BAR(3);}else{WAIT_BAR(2);} RESC(); ROT();
  }
  #undef CMASK
  #define CMASK(P0,P1,t) do{int jb_=(t)-(NT-4); if(jb_>=0)cmask(P0,P1,jb_,qrel,hi);}while(0)
  #define ENDW(tt) do{ if((tt)+3<NT){ if(DV2){WAIT_BAR(3);}else{WAIT_BAR(2);} } else if((tt)+2<NT){ if(DV2){WAIT_BAR(2);}else{WAIT_BAR(1);} } else {WAIT_BAR(0);} }while(0)
  for(;t+1<NT;t+=2){
    STEP(pB0,pB1,pA0,pA1,t,(t+3<NT),(t+1<NT),(t+1<NT));       ENDW(t);   RESC(); ROT();
    STEP(pA0,pA1,pB0,pB1,t+1,(t+4<NT),(t+2<NT),(t+2<NT));     ENDW(t+1); RESC(); ROT();
  }
  STEP(pB0,pB1,pA0,pA1,NT-1,false,false,false); RESC();
  { float sacc=pB0[0]+pB0[1]; _Pragma("unroll") for(int r=2;r<16;++r)sacc+=pB0[r]; _Pragma("unroll") for(int r=0;r<16;++r)sacc+=pB1[r]; l_reg+=sacc;
    pw0=(u32x4){PKW(pB0,0),PKW(pB0,2),PKW(pB0,4),PKW(pB0,6)};pw1=(u32x4){PKW(pB0,8),PKW(pB0,10),PKW(pB0,12),PKW(pB0,14)};pw2=(u32x4){PKW(pB1,0),PKW(pB1,2),PKW(pB1,4),PKW(pB1,6)};pw3=(u32x4){PKW(pB1,8),PKW(pB1,10),PKW(pB1,12),PKW(pB1,14)};
    SBAR(); pv(o,vb0+2*sl_cur,PAF(0),PAF(1),PAF(2),PAF(3)); if(DV2){ SBAR(); pv(o+2,vb0+2*sl_cur+8192,PAF(0),PAF(1),PAF(2),PAF(3)); } }
  #undef PKW
  #undef PAF
  #undef VFR
  #undef PIN
  #undef MX3
  #undef GAPA
  #undef GAPB
  #undef EX
  #undef VRD
  #undef KRD
  #undef VRD2
  #undef GAPX
  #undef STEP
  #undef ENDW
  {auto rr=__builtin_amdgcn_permlane32_swap(__float_as_uint(l_reg),__float_as_uint(l_reg),false,false);l_reg=__uint_as_float(rr[0])+__uint_as_float(rr[1]);}
  if(hi==0)wsf[32+r32]=l_reg;asm volatile("s_waitcnt lgkmcnt(0)":::"memory");
  float rli[16];
  #pragma unroll
  for(int r=0;r<16;++r)rli[r]=__builtin_amdgcn_rcpf(wsf[32+crow(r,hi)]);
  bf16*Ow=O+(rowbase+q0+wid*QBLK)*PO;
  { bf16*stg=(bf16*)(shm+LDS_OST)+wid*2048;
    #pragma unroll
    for(int h2=0;h2<(DV2?2:1);++h2){
    #pragma unroll
    for(int r=0;r<16;++r){const int orow=crow(r,hi);
      #pragma unroll
      for(int d0=0;d0<2;++d0)stg[orow*64+d0*32+r32]=__float2bfloat16(o[2*h2+d0][r]*rli[r]);}
    asm volatile("s_waitcnt lgkmcnt(0)":::"memory");
    #pragma unroll
    for(int i=0;i<4;++i){const int row=i*8+(lane>>3),ch=lane&7; const u32x4 v=*(const u32x4*)(stg+row*64+ch*8); ATTN_STORE16(Ow+(long)row*PO+64*h2+ch*8,v);}
    asm volatile("s_waitcnt lgkmcnt(0)":::"memory"); } }
  asm volatile("s_waitcnt lgkmcnt(0)\n\ts_barrier":::"memory");
  #undef DMA_K
  #undef QF
  #undef DMA_V
  #undef CMASK
  #undef START
  #undef RESC
  #undef ROT
}
constexpr int ATTN_LDS_BYTES=LDS_BYTES;
#undef SBAR
#undef WAIT_BAR
}

constexpr int NWAVES = 8;
constexpr int BATCH = 4, SEQ = 4096, NTOK = BATCH * SEQ, D = 1024, DEPTH = 2;
constexpr int INC = 3332, PROJ_P = 3328, NIN = 3584;
constexpr int FFD = 2816, NGUD = 2 * FFD, NE = 8, FFE = 3584, NGUE = 2 * FFE, PLE = 256;
constexpr int MP_MAX = 2 * NTOK + NE * 256;
constexpr float EPS = 1e-6f;
constexpr int C_QA = 0, C_KA = 512, C_VA = 1024, C_QB = 1536, C_KB = 1792, C_VB = 2048, C_QC = 2304, C_KC = 2560, C_VC = 2816, C_GC = 3072;

constexpr size_t MiB = 1u << 20, KiB = 1u << 10;
constexpr size_t WS_CTL = 0, CTL_ZERO_BYTES = 32 * KiB;
constexpr size_t WS_STATS0 = 1 * MiB, WS_STATS1 = 2 * MiB;
constexpr size_t WS_LOGF = 3 * MiB;
constexpr size_t WS_RCOS = 3 * MiB + 256 * KiB, WS_RSIN = 3 * MiB + 768 * KiB;
constexpr size_t WS_E12 = 4 * MiB + 256 * KiB, WS_G12 = WS_E12 + 128 * KiB, WS_POS = WS_G12 + 128 * KiB;
constexpr size_t WS_DST = WS_POS + 128 * KiB, WS_GSORT = WS_DST + 256 * KiB;
static_assert(WS_GSORT + 256 * KiB <= 6 * MiB, "small region");
constexpr size_t WS_WIN1 = 6 * MiB, WS_WOUT1 = WS_WIN1 + 7 * MiB, WS_PG1 = WS_WOUT1 + 2 * MiB, WS_PPW1 = WS_PG1 + 2 * MiB, WS_P1 = WS_PPW1 + 512 * KiB;
constexpr size_t WS_MGU = WS_P1 + 8 * MiB, WS_MD = WS_MGU + 112 * MiB, WS_HB = WS_MD + 56 * MiB;
constexpr size_t WS_PROJ = WS_HB + 32 * MiB, WS_OA = WS_PROJ + 104 * MiB, WS_OCAT = WS_OA + 32 * MiB;
constexpr size_t WS_ACTD = WS_PROJ, WS_PP = WS_OA;
constexpr size_t WS_WIN0 = WS_OCAT + 32 * MiB, WS_WOUT0 = WS_WIN0 + 7 * MiB, WS_DGU = WS_WOUT0 + 2 * MiB, WS_DD = WS_DGU + 11 * MiB, WS_PG0 = WS_DD + 5632 * KiB, WS_PPW0 = WS_PG0 + 2 * MiB, WS_P0 = WS_PPW0 + 512 * KiB;
constexpr size_t WS_H8 = WS_MD + 28 * MiB;
constexpr size_t WS_ACTE = WS_HB;
constexpr size_t WS_XS = WS_ACTE + (size_t)MP_MAX * FFE * 2;
constexpr size_t WS_END = WS_XS + (size_t)MP_MAX * D * 2;
static_assert(WS_P0 + 8 * MiB <= WS_XS && WS_MD + 56 * MiB == WS_HB && (size_t)NTOK * PROJ_P * 2 == 104 * MiB && (size_t)NIN * D * 2 == 7 * MiB, "d_ws map");
static_assert((size_t)NGUD * D * 2 == 11 * MiB && (size_t)D * FFD * 2 == 5632 * KiB && (size_t)NE * NGUE * D * 2 == 112 * MiB && (size_t)NE * D * FFE * 2 == 56 * MiB, "d_ws map 2");
static_assert((4096 + 3456) * 4 <= (int)CTL_ZERO_BYTES, "barrier words inside the per-call memset");
constexpr int CW_TMO = 0, CW_Q = 64  , CW_CNT = 1024  , CW_BAR = 4096, CW_TS = 2048  ;

constexpr int RING_OFF = 0, RING_BYTES = 131072;
constexpr int LDSCTL_OFF = RING_BYTES, MISC_OFF = LDSCTL_OFF + 320, PT_OFF = LDSCTL_OFF + 512, RED_OFF = LDSCTL_OFF + 1024  ;
constexpr int LDS_BYTES = 147456;
static_assert(MISC_OFF + 128 <= LDS_BYTES, "LDS map");
#define GAS __attribute__((address_space(1)))
#define LAS __attribute__((address_space(3)))
typedef unsigned short bf16;
typedef unsigned v4u __attribute__((ext_vector_type(4)));
typedef float f32x4 __attribute__((ext_vector_type(4)));
typedef short bf16x8 __attribute__((ext_vector_type(8)));
typedef GAS unsigned gu32;
typedef GAS unsigned long long gu64;
#define RLX_AGENT __ATOMIC_RELAXED, __HIP_MEMORY_SCOPE_AGENT
#define LDS_WAIT() asm volatile("s_waitcnt lgkmcnt(0)" ::: "memory")
#define VM_WAIT() asm volatile("s_waitcnt vmcnt(0)" ::: "memory")
__device__ __forceinline__ unsigned long long rt() { return __builtin_amdgcn_s_memrealtime(); }
__device__ __forceinline__ unsigned f2bf(float f) { unsigned u = __builtin_bit_cast(unsigned, f); return (u + 0x7fffu + ((u >> 16) & 1u)) >> 16; }
__device__ __forceinline__ unsigned pk2(float lo, float hi) { return f2bf(lo) | (f2bf(hi) << 16); }

#define XB_TMO      128
#define XB_XCNT(j)  (256  + 64 * (j))
#define XB_XSUB(j)  (1280 + 64 * (j))
#define XB_XGEN(j)  (2304 + 64 * (j))
#define XB_TOP      3328
#define XB_TOPGEN   3392
#define XCD_BAR_WORDS 3456
#define XB_SPIN_CAP (1u << 18)

__device__ __forceinline__ unsigned xb_ld(unsigned* p)              { return __hip_atomic_load(p, __ATOMIC_RELAXED, __HIP_MEMORY_SCOPE_AGENT); }
__device__ __forceinline__ unsigned xb_add(unsigned* p, unsigned v) { return __hip_atomic_fetch_add(p, v, __ATOMIC_RELAXED, __HIP_MEMORY_SCOPE_AGENT); }
__device__ __forceinline__ unsigned xb_xcc_id() { return (unsigned)__builtin_amdgcn_s_getreg((3 << 11) | 20) & 0xFu; }
#define XB_SPIN(cond, bar) do { unsigned _sp = 0; while (cond) { __builtin_amdgcn_s_sleep(1); \
    if ((++_sp & 255u) == 0u) { if (xb_ld(&(bar)[XB_TMO])) break; if (_sp > XB_SPIN_CAP) { atomicAdd(&(bar)[XB_TMO], 1u); break; } } } } while (0)

struct XcdBarrier {
    unsigned* bar; unsigned x;
    volatile LAS unsigned* st;
};

__device__ __forceinline__ XcdBarrier xcd_barrier_post(unsigned* bar, volatile LAS unsigned* st) {
    XcdBarrier b; b.bar = bar; b.x = xb_xcc_id(); b.st = st;
    if (threadIdx.x == 0) (void)xb_add(&bar[XB_XCNT(b.x)], 1u);
    return b;
}
__device__ __forceinline__ void xcd_barrier_complete(unsigned* bar, unsigned x, unsigned& nloc, unsigned& nx) {
    const unsigned G = gridDim.x * gridDim.y * gridDim.z;
    unsigned sum, cnt, mine, sp = 0u;
    for (;;) {
        sum = 0u; cnt = 0u; mine = 0u;
#pragma unroll 1
        for (unsigned j = 0; j < 16; ++j) { const unsigned c = xb_ld(&bar[XB_XCNT(j)]); sum += c; cnt += (c > 0u) ? 1u : 0u; mine = (j == x) ? c : mine; }
        if (sum == G) break;
        __builtin_amdgcn_s_sleep(1);
        if ((++sp & 255u) == 0u) { if (xb_ld(&bar[XB_TMO])) break; if (sp > XB_SPIN_CAP) { atomicAdd(&bar[XB_TMO], 1u); break; } }
    }
    nloc = mine > 0u ? mine : 1u; nx = cnt > 0u ? cnt : 1u;
}

__device__ __attribute__((noinline)) void xcd_barrier(const XcdBarrier b, const int tid_) {
    asm volatile("s_waitcnt vmcnt(0)" ::: "memory");
    __syncthreads();
    if (tid_ == 0) {
        unsigned* bar = b.bar;
        __builtin_amdgcn_s_waitcnt(0);
        unsigned nloc = b.st[0], nx = b.st[1];
        if (nloc == 0u) { xcd_barrier_complete(bar, b.x, nloc, nx); b.st[0] = nloc; b.st[1] = nx; }
        const unsigned old = xb_add(&bar[XB_XSUB(b.x)], 1u);
        const unsigned gen = old / nloc;
        if (old + 1u == (gen + 1u) * nloc) {
            __builtin_amdgcn_fence(__ATOMIC_RELEASE, "agent");
            asm volatile("s_waitcnt vmcnt(0)" ::: "memory");
            const unsigned og = xb_add(&bar[XB_TOP], 1u);
            const unsigned tg = og / nx;
            if (og + 1u == (tg + 1u) * nx) xb_add(&bar[XB_TOPGEN], 1u);
            else XB_SPIN(xb_ld(&bar[XB_TOPGEN]) == tg, bar);
            __builtin_amdgcn_fence(__ATOMIC_ACQUIRE, "agent");
            xb_add(&bar[XB_XGEN(b.x)], 1u);
            asm volatile("s_waitcnt vmcnt(0)" ::: "memory");
        } else {
            XB_SPIN(xb_ld(&bar[XB_XGEN(b.x)]) == gen, bar);
            __builtin_amdgcn_fence(__ATOMIC_ACQUIRE, "agent");
            asm volatile("s_waitcnt vmcnt(0)" ::: "memory");
        }
    }
    __syncthreads();
}

using pg8::bf_lo; using pg8::bf_hi;
struct Frame {
    LAS unsigned char* lds; char* ldsg;
    volatile LAS unsigned* MISC;
    gu32* ctl; unsigned char* ws; float* out;
    int tid, lane, wave;
    int vcu, G;
};
__device__ __forceinline__ const float* in_ptr(const Frame& F, int k) {
    const volatile LAS unsigned* pt = (const volatile LAS unsigned*)(F.lds + PT_OFF); const unsigned lo = __builtin_amdgcn_readfirstlane(pt[2 * k]), hi = __builtin_amdgcn_readfirstlane(pt[2 * k + 1]);
    return (const float*)(((unsigned long long)hi << 32) | lo);
}
__device__ __forceinline__ float wave_sum(float v) {
#pragma unroll
    for (int o = 1; o < 64; o <<= 1) v += __shfl_xor(v, o);
    return v;
}
struct TrDesc { const float* src; const float* gain; bf16* dst; int Nsrc, K; float f8scale; };
__device__ __forceinline__ void tr_load(const TrDesc& t, f32x4 (&v)[8], int lane) {
#pragma unroll
    for (int i = 0; i < 8; ++i) v[i] = *(const GAS f32x4*)(t.src + (size_t)(8 * i + (lane >> 3)) * t.Nsrc + 4 * (lane & 7));
}
__device__ __forceinline__ void tr_store(const TrDesc& t, const f32x4 (&v)[8], LAS float* scr, int lane) {
#pragma unroll
    for (int i = 0; i < 8; ++i) { const int kk = 8 * i + (lane >> 3); f32x4 x = v[i]; if (t.gain) x = x * t.gain[kk]; LAS float* s = scr + kk * 33 + 4 * (lane & 7); s[0] = x[0]; s[1] = x[1]; s[2] = x[2]; s[3] = x[3]; }
    LDS_WAIT(); asm volatile("" ::: "memory");
    const int c = lane & 7;
    if (t.f8scale != 0.f) {
#pragma unroll
        for (int j = 0; j < 4; ++j) { const int n = (lane >> 3) + 8 * j; const LAS float* s = scr + (8 * c) * 33 + n; const float q = t.f8scale;
            const f32x4 a0 = (f32x4){s[0 * 33] * q, s[1 * 33] * q, s[2 * 33] * q, s[3 * 33] * q}, a1 = (f32x4){s[4 * 33] * q, s[5 * 33] * q, s[6 * 33] * q, s[7 * 33] * q};
            *(GAS unsigned long long*)((unsigned char*)t.dst + (size_t)n * t.K + 8 * c) = pg8::pack8_fp8(a0, a1); }
    } else {
#pragma unroll
        for (int j = 0; j < 4; ++j) { const int n = (lane >> 3) + 8 * j; const LAS float* s = scr + (8 * c) * 33 + n;
            v4u o; o.x = pk2(s[0 * 33], s[1 * 33]); o.y = pk2(s[2 * 33], s[3 * 33]); o.z = pk2(s[4 * 33], s[5 * 33]); o.w = pk2(s[6 * 33], s[7 * 33]);
            *(GAS v4u*)(t.dst + (size_t)n * t.K + 8 * c) = o; }
    }
    LDS_WAIT(); asm volatile("" ::: "memory");
}
struct Args { const float* in[24]; float* out; unsigned char* ws; int ph_lo, ph_hi; };

__device__ __forceinline__ void convert_items(Frame& F, const int it0, const int stride, const int itEnd) {
    LAS float* scr = (LAS float*)(F.lds + RING_OFF + F.wave * 16384);
    unsigned char* ws = F.ws;
    const float* norm_mix = in_ptr(F, 2); const float* w_in = in_ptr(F, 3); const float* w_out = in_ptr(F, 11); const float* norm_ffn = in_ptr(F, 12);
    const float* dwg = in_ptr(F, 13); const float* dwu = in_ptr(F, 14); const float* dwd = in_ptr(F, 15);
    const float* mwg = in_ptr(F, 17); const float* mwu = in_ptr(F, 18); const float* mwd = in_ptr(F, 19);
    const float* ple_norm = in_ptr(F, 20); const float* ple_gate = in_ptr(F, 21); const float* ple_proj = in_ptr(F, 22);
    constexpr int I_IN = (NIN / 32) * (D / 64), I_OUT = (D / 32) * (D / 64), I_DGU = (NGUD / 32) * (D / 64), I_DD = (D / 32) * (FFD / 64), I_PG = I_OUT, I_PP = (D / 32) * (PLE / 64);
    constexpr int I_MGU1 = (NGUE / 32) * (D / 64), I_MD1 = (D / 32) * (FFE / 64);
    constexpr int NITEMS = 2 * I_IN + 2 * I_OUT + I_DGU + I_DD + 2 * I_PG + 2 * I_PP + NE * I_MGU1 + NE * I_MD1;
    auto desc = [&](int it) -> TrDesc {
        int r = it; TrDesc t; t.f8scale = 0.f;
        if (r < 2 * I_IN) { const int L = r / I_IN; r -= L * I_IN; const int ng = NIN / 32, kb = r / ng, grp = r % ng, pn = grp >> 3, gi = grp & 7;
            int sc; if (pn <= 8) sc = 32 * grp; else if (pn == 9 || pn == 10) sc = (pn == 9 ? 2308 : 2564) + 64 * (gi & 3) + 32 * (gi >> 2); else if (pn <= 12) sc = 32 * grp + 4; else sc = 2304;
            t.Nsrc = INC; t.K = D; t.src = w_in + (size_t)L * D * INC + (size_t)(64 * kb) * INC + sc; t.gain = norm_mix + L * D + 64 * kb; t.dst = (bf16*)(ws + (L ? WS_WIN1 : WS_WIN0)) + (size_t)(32 * grp) * D + 64 * kb; return t; } r -= 2 * I_IN;
        if (r < 2 * I_OUT) { const int L = r / I_OUT; r -= L * I_OUT; const int ng = D / 32, kb = r / ng, grp = r % ng;
            t.Nsrc = D; t.K = D; t.src = w_out + (size_t)L * D * D + (size_t)(64 * kb) * D + 32 * grp; t.gain = nullptr; t.dst = (bf16*)(ws + (L ? WS_WOUT1 : WS_WOUT0)) + (size_t)(32 * grp) * D + 64 * kb; return t; } r -= 2 * I_OUT;
        if (r < I_DGU) { const int ng = NGUD / 32, kb = r / ng, grp = r % ng, pn = grp >> 3, gi = grp & 7;
            t.Nsrc = FFD; t.K = D; t.src = ((gi >> 2) ? dwu : dwg) + (size_t)(64 * kb) * FFD + 128 * pn + 32 * (gi & 3); t.gain = norm_ffn + 64 * kb; t.dst = (bf16*)(ws + WS_DGU) + (size_t)(32 * grp) * D + 64 * kb; return t; } r -= I_DGU;
        if (r < I_DD) { const int ng = D / 32, kb = r / ng, grp = r % ng;
            t.Nsrc = D; t.K = FFD; t.src = dwd + (size_t)(64 * kb) * D + 32 * grp; t.gain = nullptr; t.dst = (bf16*)(ws + WS_DD) + (size_t)(32 * grp) * FFD + 64 * kb; return t; } r -= I_DD;
        if (r < 2 * I_PG) { const int L = r / I_PG; r -= L * I_PG; const int ng = D / 32, kb = r / ng, grp = r % ng;
            t.Nsrc = D; t.K = D; t.src = ple_gate + (size_t)L * D * D + (size_t)(64 * kb) * D + 32 * grp; t.gain = ple_norm + L * D + 64 * kb; t.dst = (bf16*)(ws + (L ? WS_PG1 : WS_PG0)) + (size_t)(32 * grp) * D + 64 * kb; return t; } r -= 2 * I_PG;
        if (r < 2 * I_PP) { const int L = r / I_PP; r -= L * I_PP; const int ng = D / 32, kb = r / ng, grp = r % ng;
            t.Nsrc = D; t.K = PLE; t.src = ple_proj + (size_t)L * PLE * D + (size_t)(64 * kb) * D + 32 * grp; t.gain = nullptr; t.dst = (bf16*)(ws + (L ? WS_PPW1 : WS_PPW0)) + (size_t)(32 * grp) * PLE + 64 * kb; return t; } r -= 2 * I_PP;
        if (r < NE * I_MGU1) { const int e = r / I_MGU1; r -= e * I_MGU1; const int ng = NGUE / 32, kb = r / ng, grp = r % ng, pn = grp >> 3, gi = grp & 7;
            t.Nsrc = FFE; t.K = D; t.src = ((gi >> 2) ? mwu : mwg) + (size_t)e * D * FFE + (size_t)(64 * kb) * FFE + 128 * pn + 32 * (gi & 3); t.gain = nullptr; t.f8scale = 32.f; t.dst = (bf16*)(ws + WS_MGU + (size_t)e * NGUE * D + (size_t)(32 * grp) * D + 64 * kb); return t; } r -= NE * I_MGU1;
        { const int e = r / I_MD1; r -= e * I_MD1; const int ng = D / 32, kb = r / ng, grp = r % ng;
            t.Nsrc = D; t.K = FFE; t.src = mwd + (size_t)e * FFE * D + (size_t)(64 * kb) * D + 32 * grp; t.gain = nullptr; t.f8scale = 64.f; t.dst = (bf16*)(ws + WS_MD + (size_t)e * D * FFE + (size_t)(32 * grp) * FFE + 64 * kb); return t; }
    };
    {
        f32x4 va[8], vb[8]; int it = it0; TrDesc ta, tb;
        if (it < itEnd) { ta = desc(it); tr_load(ta, va, F.lane); }
        while (it < itEnd) {
            const int i2 = it + stride; if (i2 < itEnd) { tb = desc(i2); tr_load(tb, vb, F.lane); }
            tr_store(ta, va, scr, F.lane);
            if (i2 >= itEnd) break;
            const int i3 = i2 + stride; if (i3 < itEnd) { ta = desc(i3); tr_load(ta, va, F.lane); }
            tr_store(tb, vb, scr, F.lane);
            it = i3;
        }
    }
}
constexpr int CV_SMALL = 2 * ((NIN / 32) * (D / 64)) + 2 * ((D / 32) * (D / 64)) + (NGUD / 32) * (D / 64) + (D / 32) * (FFD / 64) + 2 * ((D / 32) * (D / 64)) + 2 * ((D / 32) * (PLE / 64));
constexpr int CV_MOE = NE * ((NGUE / 32) * (D / 64)) + NE * ((D / 32) * (FFE / 64));
#ifndef MK_CV_PER_WAVE
#define MK_CV_PER_WAVE 14
#endif
constexpr int CV_SLOTS = 3, CV_BLOCKS = 128, CV_PER_WAVE = MK_CV_PER_WAVE, CV_INSLOTS = CV_SLOTS * CV_BLOCKS * NWAVES * CV_PER_WAVE;
static_assert(CV_INSLOTS <= CV_MOE, "expert weight items: the first CV_INSLOTS in the slots, the rest in the prologue");
__device__ __forceinline__ void convert_slot(Frame& F, int slot, int bid) {
    if (bid < 256 - CV_BLOCKS) return;
    const int first = CV_SMALL + ((slot * CV_BLOCKS + (bid - (256 - CV_BLOCKS))) * NWAVES + F.wave) * CV_PER_WAVE;
    convert_items(F, first, 1, first + CV_PER_WAVE);
    __syncthreads();
}
__device__ __forceinline__ void p0_prologue(Frame& F, const Args& a) {
    const int gw = F.vcu * NWAVES + F.wave, NGW = F.G * NWAVES;
    unsigned char* ws = F.ws;
#ifdef MK_CONV_IN_PROLOGUE
    convert_items(F, gw, NGW, CV_SMALL + CV_MOE);
#else
    convert_items(F, gw, NGW, CV_SMALL);
    convert_items(F, CV_SMALL + (F.G == 256 ? CV_INSLOTS : 0) + gw, NGW, CV_SMALL + CV_MOE);
#endif
    for (int i = gw * 64 + F.lane; i < SEQ * 32; i += NGW * 64) { const int pos = i >> 5, d = i & 31;
        const double inv = exp2((double)d * (-13.287712379549449 / 32.0)); double ang = (double)pos * inv; ang -= 6.283185307179586 * rint(ang * 0.15915494309189535);
        ((float*)(ws + WS_RCOS))[i] = __cosf((float)ang); ((float*)(ws + WS_RSIN))[i] = __sinf((float)ang); }
    { const float* p = in_ptr(F, 1); const size_t n8 = (size_t)DEPTH * NTOK * PLE / 8, half8 = (size_t)NTOK * PLE / 8;
      for (size_t i = (size_t)gw * 64 + F.lane; i < n8; i += (size_t)NGW * 64) { const f32x4 v0 = ((const f32x4*)p)[2 * i], v1 = ((const f32x4*)p)[2 * i + 1];
          v4u o; o.x = pk2(v0[0], v0[1]); o.y = pk2(v0[2], v0[3]); o.z = pk2(v1[0], v1[1]); o.w = pk2(v1[2], v1[3]);
          if (i < half8) ((v4u*)(ws + WS_P0))[i] = o; else ((v4u*)(ws + WS_P1))[i - half8] = o; } }
    { const float* x = in_ptr(F, 0); bf16* hb = (bf16*)(ws + WS_HB); float* st = (float*)(ws + WS_STATS0);
      for (int m0 = gw; m0 < NTOK; m0 += 2 * NGW) {
          f32x4 xv[2][4];
#pragma unroll
          for (int u = 0; u < 2; ++u) { if (m0 + u * NGW >= NTOK) continue; const GAS f32x4* xr = (const GAS f32x4*)(x + (size_t)(m0 + u * NGW) * D) + F.lane;
#pragma unroll
              for (int j = 0; j < 4; ++j) xv[u][j] = xr[64 * j]; }
#pragma unroll
          for (int u = 0; u < 2; ++u) { const int m = m0 + u * NGW; if (m >= NTOK) continue; GAS unsigned long long* o8 = (GAS unsigned long long*)(hb + (size_t)m * D) + F.lane; float s = 0.f;
#pragma unroll
              for (int j = 0; j < 4; ++j) { const f32x4 v = xv[u][j]; const unsigned w0 = pk2(v[0], v[1]), w1 = pk2(v[2], v[3]);
                  const float q0 = bf_lo(w0), q1 = bf_hi(w0), q2 = bf_lo(w1), q3 = bf_hi(w1); s += (q0 * q0 + q1 * q1) + (q2 * q2 + q3 * q3);
                  o8[64 * j] = (unsigned long long)w0 | ((unsigned long long)w1 << 32); }
              s = wave_sum(s); if (F.lane < 4) st[(size_t)m * 4 + F.lane] = (F.lane == 0) ? s : 0.f; } } }
}

namespace ret {
constexpr int QP = 72, VP = 136;
constexpr int OFF_Q = 0, OFF_K = OFF_Q + 128 * QP * 2, OFF_VT = OFF_K + 128 * QP * 2, OFF_KD = OFF_VT + 64 * VP * 2, OFF_AS = OFF_KD + 64 * VP * 2, OFF_ST = OFF_AS + 128 * VP * 2, BYTES = OFF_ST + 2 * 64 * QP * 2;
static_assert(BYTES <= RING_BYTES, "retention LDS");
typedef LAS unsigned short lbf;
__device__ __forceinline__ bf16x8 ld8(const lbf* p) { return *(const LAS bf16x8*)p; }
__device__ __forceinline__ void unit(Frame& F, const int tid, int b, int h, int seg, const bf16* proj, bf16* ocat, const float* ret_gn) {
    const int lane = tid & 63, w = __builtin_amdgcn_readfirstlane(tid >> 6), l15 = lane & 15, q4 = lane >> 4;
    lbf* Qs = (lbf*)(F.lds + OFF_Q); lbf* Ks = (lbf*)(F.lds + OFF_K); lbf* Vt = (lbf*)(F.lds + OFF_VT); lbf* Kd = (lbf*)(F.lds + OFF_KD); lbf* As = (lbf*)(F.lds + OFF_AS); lbf* St = (lbf*)(F.lds + OFF_ST);
    const float l2g = log2f(1.f - exp2f(-5.f - (float)h));
    const float cdec = exp2f(128.f * l2g);
    const size_t rowb = (size_t)b * SEQ;
    const bf16* qg = proj + C_QC + 64 * h; const bf16* kg = proj + C_KC + 64 * h; const bf16* vg = proj + C_VC + 64 * h; const bf16* gg = proj + C_GC + 64 * h;
    v4u rq[2], rk[2], rv[2];
#define RET_LOAD(c) do { _Pragma("unroll") for (int i = 0; i < 2; ++i) { const int p = tid + 512 * i, row = p >> 3, c8 = p & 7; const size_t go = (rowb + (size_t)(c) * 128 + row) * PROJ_P + 8 * c8; \
        if ((c) >= c0) rq[i] = *(const GAS v4u*)(qg + go); rk[i] = *(const GAS v4u*)(kg + go); rv[i] = *(const GAS v4u*)(vg + go); } } while (0)
    const int c0 = 16 * seg, c1 = c0 + 16;
    rq[0] = rq[1] = (v4u){0u, 0u, 0u, 0u};
    RET_LOAD(0);
    f32x4 st[2];
    st[0] = (f32x4){0.f, 0.f, 0.f, 0.f}; st[1] = st[0];
    for (int i = tid; i < 64 * QP / 2; i += 512) ((LAS unsigned*)St)[i] = 0u;
#pragma unroll 1
    for (int c = 0; c < c1; ++c) {
        const bool full = c >= c0;
        __syncthreads();
#pragma unroll
        for (int i = 0; i < 2; ++i) { const int p = tid + 512 * i, row = p >> 3, c8 = p & 7;
            if (full) { *(LAS v4u*)(Qs + row * QP + 8 * c8) = rq[i]; *(LAS v4u*)(Ks + row * QP + 8 * c8) = rk[i]; }
            const float kd = __builtin_amdgcn_exp2f((float)(127 - row) * l2g);
            const unsigned kw[4] = {rk[i].x, rk[i].y, rk[i].z, rk[i].w}, vw[4] = {rv[i].x, rv[i].y, rv[i].z, rv[i].w};
#pragma unroll
            for (int e = 0; e < 4; ++e) { Vt[(8 * c8 + 2 * e) * VP + row] = (unsigned short)(vw[e] & 0xffffu); Vt[(8 * c8 + 2 * e + 1) * VP + row] = (unsigned short)(vw[e] >> 16);
                Kd[(8 * c8 + 2 * e) * VP + row] = (unsigned short)f2bf(bf_lo(kw[e]) * kd); Kd[(8 * c8 + 2 * e + 1) * VP + row] = (unsigned short)f2bf(bf_hi(kw[e]) * kd); } }
        if (c + 1 < c1) RET_LOAD(c + 1);
        __syncthreads();
        const lbf* Stc = St + (c & 1) * 64 * QP; lbf* Stn = St + ((c + 1) & 1) * 64 * QP;
        f32x4 o1[4], o2[4];
        if (full) {
        bf16x8 qa[2]; qa[0] = ld8(Qs + (16 * w + l15) * QP + 8 * q4); qa[1] = ld8(Qs + (16 * w + l15) * QP + 32 + 8 * q4);
#pragma unroll 1
        for (int nt = 0; nt <= w; ++nt) {
            f32x4 s = (f32x4){0.f, 0.f, 0.f, 0.f};
            s = __builtin_amdgcn_mfma_f32_16x16x32_bf16(qa[0], ld8(Ks + (16 * nt + l15) * QP + 8 * q4), s, 0, 0, 0);
            s = __builtin_amdgcn_mfma_f32_16x16x32_bf16(qa[1], ld8(Ks + (16 * nt + l15) * QP + 32 + 8 * q4), s, 0, 0, 0);
#pragma unroll
            for (int i = 0; i < 4; ++i) { const int dt = (16 * w + 4 * q4 + i) - (16 * nt + l15); const float v = dt >= 0 ? s[i] * __builtin_amdgcn_exp2f((float)dt * l2g) : 0.f;
                As[(16 * w + 4 * q4 + i) * VP + 16 * nt + l15] = (unsigned short)f2bf(v); } }
        if ((w & 1) == 0) {
#pragma unroll
            for (int i = 0; i < 4; ++i) As[(16 * w + 4 * q4 + i) * VP + 16 * (w + 1) + l15] = 0; }
        LDS_WAIT();
#pragma unroll
        for (int nv = 0; nv < 4; ++nv) { o1[nv] = (f32x4){0.f, 0.f, 0.f, 0.f}; o2[nv] = o1[nv]; }
#pragma unroll 1
        for (int ks = 0; ks <= (w >> 1); ++ks) { const bf16x8 af = ld8(As + (16 * w + l15) * VP + 32 * ks + 8 * q4);
#pragma unroll
            for (int nv = 0; nv < 4; ++nv) o1[nv] = __builtin_amdgcn_mfma_f32_16x16x32_bf16(af, ld8(Vt + (16 * nv + l15) * VP + 32 * ks + 8 * q4), o1[nv], 0, 0, 0); }
#pragma unroll
        for (int ks = 0; ks < 2; ++ks)
#pragma unroll
            for (int nv = 0; nv < 4; ++nv) o2[nv] = __builtin_amdgcn_mfma_f32_16x16x32_bf16(qa[ks], ld8(Stc + (16 * nv + l15) * QP + 32 * ks + 8 * q4), o2[nv], 0, 0, 0);
        }
#pragma unroll
        for (int i = 0; i < 2; ++i) { const int j = 2 * w + i, tv = j >> 2, td = j & 3; f32x4 u = (f32x4){0.f, 0.f, 0.f, 0.f};
#pragma unroll
            for (int ks = 0; ks < 4; ++ks) u = __builtin_amdgcn_mfma_f32_16x16x32_bf16(ld8(Vt + (16 * tv + l15) * VP + 32 * ks + 8 * q4), ld8(Kd + (16 * td + l15) * VP + 32 * ks + 8 * q4), u, 0, 0, 0);
            st[i] = st[i] * cdec + u;
#pragma unroll
            for (int e = 0; e < 4; ++e) Stn[(16 * tv + 4 * q4 + e) * QP + 16 * td + l15] = (unsigned short)f2bf(st[i][e]); }
        if (full) {
#pragma unroll
        for (int i = 0; i < 4; ++i) { const int j = 16 * w + 4 * q4 + i; const float qd = __builtin_amdgcn_exp2f((float)(j + 1) * l2g);
            float v[4], s = 0.f;
#pragma unroll
            for (int nv = 0; nv < 4; ++nv) { v[nv] = o1[nv][i] + qd * o2[nv][i]; s += v[nv]; }
            s += __shfl_xor(s, 1); s += __shfl_xor(s, 2); s += __shfl_xor(s, 4); s += __shfl_xor(s, 8);
            const float mu = s * (1.f / 64.f); float s2 = 0.f;
#pragma unroll
            for (int nv = 0; nv < 4; ++nv) { v[nv] -= mu; s2 += v[nv] * v[nv]; }
            s2 += __shfl_xor(s2, 1); s2 += __shfl_xor(s2, 2); s2 += __shfl_xor(s2, 4); s2 += __shfl_xor(s2, 8);
            const float rs = __builtin_amdgcn_rsqf(s2 * (1.f / 64.f) + EPS);
            const size_t tok = rowb + (size_t)c * 128 + j;
#pragma unroll
            for (int nv = 0; nv < 4; ++nv) { const int ch = 16 * nv + l15; const float g = bf_lo((unsigned)gg[tok * PROJ_P + ch]);
                ocat[tok * D + 768 + 64 * h + ch] = (bf16)f2bf(v[nv] * rs * ret_gn[64 * h + ch] * g * pg8::fast_sigmoid(g)); } }
        }
    }
    __syncthreads();
#undef RET_LOAD
}
}

__device__ __forceinline__ void fox_bias(Frame& F, const float* logf, int b, int h, int n, LAS float* kb) {
    LAS float* red = (LAS float*)(F.lds + LDSCTL_OFF);
    const int t0 = 8 * F.tid; float p[8]; float run = 0.f;
#pragma unroll
    for (int i = 0; i < 8; ++i) { const float v = (t0 + i < n) ? logf[((size_t)b * SEQ + t0 + i) * 4 + h] : 0.f; run += v; p[i] = run; }
    float inc = run;
#pragma unroll
    for (int o = 1; o < 64; o <<= 1) { const float y = __shfl_up(inc, o); if (F.lane >= o) inc += y; }
    if (F.lane == 63) red[F.wave] = inc;
    __syncthreads();
    float woff = 0.f, tot = 0.f;
#pragma unroll
    for (int k = 0; k < 8; ++k) { const float x = red[k]; if (k < F.wave) woff += x; tot += x; }
    const float base = woff + inc - run;
    if (t0 < n) {
#pragma unroll
        for (int i = 0; i < 8; ++i) kb[t0 + i] = (tot - (base + p[i])) * pg8::LOG2E;
    }
    __syncthreads();
}
constexpr int MIX_UNITS = 16 + 16 * 80;
constexpr int KB_OFF = attn_body::ATTN_LDS_BYTES;
static_assert(KB_OFF + 16384 <= RING_BYTES && KB_OFF % 16 == 0, "attention LDS + bias array");
__device__ __forceinline__ int mixer_grab(Frame& F, int word) {
    if (F.tid == 0) F.MISC[0] = __hip_atomic_fetch_add((unsigned*)(F.ctl + word), 1u, __ATOMIC_RELAXED, __HIP_MEMORY_SCOPE_AGENT);
    __syncthreads();
    const int u = __builtin_amdgcn_readfirstlane((int)F.MISC[0]);
    __syncthreads();
    return u;
}
__device__ __forceinline__ void mixer_phase(Frame& F, const Args& a, int layer) {
    unsigned char* ws = F.ws; const bf16* proj = (const bf16*)(ws + WS_PROJ); bf16* oa = (bf16*)(ws + WS_OA); bf16* ocat = (bf16*)(ws + WS_OCAT);
    const float* logf = (const float*)(ws + WS_LOGF); const float* ret_gn = in_ptr(F, 10) + layer * 256;
    char* lds = F.ldsg;
#ifndef MIXSEL
#define MIXSEL 7
#endif
#ifndef MIXDUP
#define MIXDUP 0
#endif
#define LOOP_RET(QW) { asm volatile("" : "+v"(F.tid)); const int t1 = F.tid; for (;;) { const int u = mixer_grab(F, (QW)); if (u >= 32) break; ret::unit(F, t1, (u >> 2) & 3, u & 3, 1 - (u >> 4), proj, ocat, ret_gn); } }
#define LOOP_A(QW) { asm volatile("" : "+v"(F.tid)); const int t2 = F.tid; for (;;) { const int u = mixer_grab(F, (QW)); if (u >= 512) break; \
        const int qb = 15 - (u >> 5), w = u & 31, b = w >> 3, j = w & 7;     \
        attn_body::attn_unit<8, false, true>(b, qb, (const attn_body::bf16*)(proj + C_QA + 64 * j), (const attn_body::bf16*)(proj + C_KA + 64 * j), (const attn_body::bf16*)(proj + C_VA + 128 * (j >> 1)), \
                                       (attn_body::bf16*)(oa + 128 * j), lds, (const LAS float*)nullptr, t2); } }
#define LOOP_B(QW) { asm volatile("" : "+v"(F.tid)); const int t3 = F.tid; for (;;) { const int u = mixer_grab(F, (QW)); if (u >= 256) break; \
        const int qb = 15 - (u >> 4), w = u & 15, b = w >> 2, h = w & 3; \
        LAS float* kb = (LAS float*)(F.lds + KB_OFF); \
        fox_bias(F, logf, b, h, 256 * qb + 256, kb); \
        attn_body::attn_unit<8, true, false>(b, qb, (const attn_body::bf16*)(proj + C_QB + 64 * h), (const attn_body::bf16*)(proj + C_KB + 64 * h), (const attn_body::bf16*)(proj + C_VB + 64 * h), \
                                      (attn_body::bf16*)(ocat + 512 + 64 * h), lds, (const LAS float*)kb, t3); } }
    const int qw = CW_Q + 64 * (3 * layer);
    if (MIXSEL & 1) LOOP_RET(qw)
    if (MIXSEL & 4) LOOP_B(qw + 128)
    if (MIXSEL & 2) LOOP_A(qw + 64)
#if MIXDUP & 1
    LOOP_RET(qw + 64 * 6)
#endif
#if MIXDUP & 2
    LOOP_A(qw + 64 * 7)
#endif
#if MIXDUP & 4
    LOOP_B(qw + 64 * 8)
#endif
#undef LOOP_RET
#undef LOOP_A
#undef LOOP_B
}
__device__ __forceinline__ void combine_phase(Frame& F, const Args& a, int layer) {
    unsigned char* ws = F.ws; const bf16* oa = (const bf16*)(ws + WS_OA); bf16* ocat = (bf16*)(ws + WS_OCAT);
    const int gw = F.vcu * NWAVES + F.wave, NGW = F.G * NWAVES;
    const float lam_init = 0.8f - 0.6f * expf(-0.3f * (float)layer);
    const float lam = expf(wave_sum(in_ptr(F, 5)[layer * 64 + F.lane] * in_ptr(F, 6)[layer * 64 + F.lane])) - expf(wave_sum(in_ptr(F, 7)[layer * 64 + F.lane] * in_ptr(F, 8)[layer * 64 + F.lane])) + lam_init;
    const int hd = F.lane >> 4, i16 = F.lane & 15;
    const float* sg = in_ptr(F, 9) + layer * 128 + 8 * i16; float g[8];
#pragma unroll
    for (int e = 0; e < 8; ++e) g[e] = sg[e] * (1.f - lam_init);
    for (int m0 = gw; m0 < NTOK; m0 += 2 * NGW) {
        v4u w1[2], w2[2];
#pragma unroll
        for (int u = 0; u < 2; ++u) { const int m = m0 + u * NGW; if (m >= NTOK) continue; w1[u] = *(const GAS v4u*)(oa + (size_t)m * D + 256 * hd + 8 * i16); w2[u] = *(const GAS v4u*)(oa + (size_t)m * D + 256 * hd + 128 + 8 * i16); }
#pragma unroll
        for (int u = 0; u < 2; ++u) { const int m = m0 + u * NGW; if (m >= NTOK) continue;
            const unsigned a1[4] = {w1[u].x, w1[u].y, w1[u].z, w1[u].w}, a2[4] = {w2[u].x, w2[u].y, w2[u].z, w2[u].w}; float d[8], ss = 0.f;
#pragma unroll
            for (int e = 0; e < 4; ++e) { d[2 * e] = bf_lo(a1[e]) - lam * bf_lo(a2[e]); d[2 * e + 1] = bf_hi(a1[e]) - lam * bf_hi(a2[e]); ss += d[2 * e] * d[2 * e] + d[2 * e + 1] * d[2 * e + 1]; }
            ss += __shfl_xor(ss, 1); ss += __shfl_xor(ss, 2); ss += __shfl_xor(ss, 4); ss += __shfl_xor(ss, 8);
            const float r = __builtin_amdgcn_rsqf(ss * (1.f / 128.f) + EPS);
            v4u o; o.x = pk2(d[0] * r * g[0], d[1] * r * g[1]); o.y = pk2(d[2] * r * g[2], d[3] * r * g[3]); o.z = pk2(d[4] * r * g[4], d[5] * r * g[5]); o.w = pk2(d[6] * r * g[6], d[7] * r * g[7]);
            *(GAS v4u*)(ocat + (size_t)m * D + 128 * hd + 8 * i16) = o; }
    }
}
__device__ __forceinline__ void router_phase(Frame& F, const Args& a, const bf16* h) {
    unsigned char* ws = F.ws; const float* gain = in_ptr(F, 12) + D; const float* router = in_ptr(F, 16);
    LAS float* R = (LAS float*)(F.lds + RING_OFF);
    LAS int* lcnt = (LAS int*)(F.lds + RING_OFF + 32768); LAS int* gbase = lcnt + 8; LAS int* rowe = lcnt + 16; LAS int* rowp = rowe + 128; LAS float* rowg = (LAS float*)(rowp + 128);
    for (int i = F.tid; i < D * NE; i += 512) R[(i & 7) * D + (i >> 3)] = gain[i >> 3] * router[i];
    const int nblk = NTOK / 64;
    for (int blk = F.vcu; blk < nblk; blk += F.G) {
        if (F.tid < 8) lcnt[F.tid] = 0;
        __syncthreads();
#pragma unroll 1
        for (int rr = 0; rr < 8; ++rr) { const int lr = F.wave * 8 + rr, m = blk * 64 + lr;
            const GAS unsigned long long* xr = (const GAS unsigned long long*)(h + (size_t)m * D) + F.lane; float lg[8]; float ss = 0.f;
#pragma unroll
            for (int e = 0; e < 8; ++e) lg[e] = 0.f;
#pragma unroll
            for (int j = 0; j < 4; ++j) { const unsigned long long pw = xr[64 * j]; const f32x4 v = (f32x4){bf_lo((unsigned)pw), bf_hi((unsigned)pw), bf_lo((unsigned)(pw >> 32)), bf_hi((unsigned)(pw >> 32))}; ss += (v[0] * v[0] + v[1] * v[1]) + (v[2] * v[2] + v[3] * v[3]);
#pragma unroll
                for (int e = 0; e < 8; ++e) { const f32x4 rr = *(const LAS f32x4*)(R + e * D + 256 * j + 4 * F.lane); lg[e] += (v[0] * rr[0] + v[1] * rr[1]) + (v[2] * rr[2] + v[3] * rr[3]); } }
            ss = wave_sum(ss); const float rs = 1.f / sqrtf(ss * (1.f / D) + EPS);
#pragma unroll
            for (int e = 0; e < 8; ++e) lg[e] = wave_sum(lg[e]) * rs;
            int i1 = 0; float v1 = lg[0];
#pragma unroll
            for (int e = 1; e < 8; ++e) if (lg[e] > v1) { v1 = lg[e]; i1 = e; }
            int i2 = -1; float v2 = -INFINITY;
#pragma unroll
            for (int e = 0; e < 8; ++e) if (e != i1 && lg[e] > v2) { v2 = lg[e]; i2 = e; }
            const float g2 = 1.f / (1.f + expf(v1 - v2)), g1 = 1.f - g2;
            if (F.lane == 0) { rowe[2 * lr] = i1; rowe[2 * lr + 1] = i2; rowg[2 * lr] = g1; rowg[2 * lr + 1] = g2;
                rowp[2 * lr] = __hip_atomic_fetch_add(lcnt + i1, 1, __ATOMIC_RELAXED, __HIP_MEMORY_SCOPE_WORKGROUP); rowp[2 * lr + 1] = __hip_atomic_fetch_add(lcnt + i2, 1, __ATOMIC_RELAXED, __HIP_MEMORY_SCOPE_WORKGROUP); }
        }
        __syncthreads();
        if (F.tid < 8) gbase[F.tid] = (int)__hip_atomic_fetch_add((unsigned*)(F.ctl + CW_CNT + 64 * F.tid), (unsigned)lcnt[F.tid], __ATOMIC_RELAXED, __HIP_MEMORY_SCOPE_AGENT);
        __syncthreads();
        if (F.tid < 128) { const int m2 = blk * 128 + F.tid; const int e = rowe[F.tid];
            ((int*)(ws + WS_E12))[m2] = e; ((float*)(ws + WS_G12))[m2] = rowg[F.tid]; ((int*)(ws + WS_POS))[m2] = gbase[e] + rowp[F.tid]; }
        __syncthreads();
    }
}
__device__ __forceinline__ void moe_tiles(Frame& F, int (&tb)[9]) {
    int acc = 0;
#pragma unroll
    for (int e = 0; e < 8; ++e) { tb[e] = acc; const int c = __builtin_amdgcn_readfirstlane((int)__hip_atomic_load((unsigned*)(F.ctl + CW_CNT + 64 * e), __ATOMIC_RELAXED, __HIP_MEMORY_SCOPE_AGENT)); acc += (c + 255) >> 8; }
    tb[8] = acc;
}
__device__ __forceinline__ void gather_phase(Frame& F, const Args& a, const bf16* h) {
    unsigned char* ws = F.ws; const float* gain = in_ptr(F, 12) + D;
    bf16* xs = (bf16*)(ws + WS_XS); int* dst = (int*)(ws + WS_DST); float* gsort = (float*)(ws + WS_GSORT);
    const int* e12 = (const int*)(ws + WS_E12); const float* g12 = (const float*)(ws + WS_G12); const int* pos = (const int*)(ws + WS_POS);
    int tb[9]; moe_tiles(F, tb);
    const int gw = F.vcu * NWAVES + F.wave, NGW = F.G * NWAVES;
#pragma unroll
    for (int e = 0; e < 8; ++e) { const int c = (int)__hip_atomic_load((unsigned*)(F.ctl + CW_CNT + 64 * e), __ATOMIC_RELAXED, __HIP_MEMORY_SCOPE_AGENT);
        const int lo = tb[e] * 256 + c, hi = tb[e + 1] * 256; for (int r = lo + gw * 64 + F.lane; r < hi; r += NGW * 64) { dst[r] = -1; gsort[r] = 0.f; } }
    f32x4 gv[4];
#pragma unroll
    for (int j = 0; j < 4; ++j) gv[j] = ((const GAS f32x4*)gain)[F.lane + 64 * j];
    for (int m = gw; m < NTOK; m += NGW) {
        const GAS unsigned long long* xr = (const GAS unsigned long long*)(h + (size_t)m * D) + F.lane; f32x4 v[4]; float ss = 0.f;
#pragma unroll
        for (int j = 0; j < 4; ++j) { const unsigned long long pw = xr[64 * j]; v[j] = (f32x4){bf_lo((unsigned)pw), bf_hi((unsigned)pw), bf_lo((unsigned)(pw >> 32)), bf_hi((unsigned)(pw >> 32))}; ss += (v[j][0] * v[j][0] + v[j][1] * v[j][1]) + (v[j][2] * v[j][2] + v[j][3] * v[j][3]); }
        ss = wave_sum(ss); const float rs = 1.f / sqrtf(ss * (1.f / D) + EPS);
        const int e1 = e12[2 * m], e2 = e12[2 * m + 1];
        int r1 = 0, r2 = 0;
#pragma unroll
        for (int e = 0; e < 8; ++e) { if (e == e1) r1 = tb[e] * 256; if (e == e2) r2 = tb[e] * 256; }
        r1 += pos[2 * m]; r2 += pos[2 * m + 1];
        GAS unsigned* o1 = (GAS unsigned*)((unsigned char*)xs + (size_t)r1 * D) + F.lane; GAS unsigned* o2 = (GAS unsigned*)((unsigned char*)xs + (size_t)r2 * D) + F.lane;
#pragma unroll
        for (int j = 0; j < 4; ++j) { const f32x4 y = v[j] * rs * gv[j]; unsigned pk = 0; pk = __builtin_amdgcn_cvt_pk_fp8_f32(y[0], y[1], pk, false); pk = __builtin_amdgcn_cvt_pk_fp8_f32(y[2], y[3], pk, true); o1[64 * j] = pk; o2[64 * j] = pk; }
        if (F.lane == 0) { dst[r1] = 2 * m; dst[r2] = 2 * m + 1; gsort[r1] = g12[2 * m]; gsort[r2] = g12[2 * m + 1]; }
    }
}
__device__ __forceinline__ void moe_combine_phase(Frame& F, const Args& a, float* stats_out, bf16* hb) {
    unsigned char* ws = F.ws; const bf16* y = (const bf16*)(ws + WS_XS);
    const int gw = F.vcu * NWAVES + F.wave, NGW = F.G * NWAVES;
    for (int m0 = gw; m0 < NTOK; m0 += 2 * NGW) {
        unsigned long long p0[2][4], p1[2][4], p2[2][4];
#pragma unroll
        for (int u = 0; u < 2; ++u) { const int m = m0 + u * NGW; if (m >= NTOK) continue; const GAS unsigned long long* y1 = (const GAS unsigned long long*)(y + (size_t)(2 * m) * D) + F.lane; const GAS unsigned long long* y2 = y1 + D / 4;
            const GAS unsigned long long* h8 = (const GAS unsigned long long*)(hb + (size_t)m * D) + F.lane;
#pragma unroll
            for (int j = 0; j < 4; ++j) { p0[u][j] = h8[64 * j]; p1[u][j] = y1[64 * j]; p2[u][j] = y2[64 * j]; } }
#pragma unroll
        for (int u = 0; u < 2; ++u) { const int m = m0 + u * NGW; if (m >= NTOK) continue; GAS unsigned long long* o8 = (GAS unsigned long long*)(hb + (size_t)m * D) + F.lane; float s = 0.f;
#pragma unroll
            for (int j = 0; j < 4; ++j) { const unsigned long long q0_ = p0[u][j], q1_ = p1[u][j], q2_ = p2[u][j]; f32x4 v;
                v[0] = bf_lo((unsigned)q0_) + (bf_lo((unsigned)q1_) + bf_lo((unsigned)q2_)); v[1] = bf_hi((unsigned)q0_) + (bf_hi((unsigned)q1_) + bf_hi((unsigned)q2_));
                v[2] = bf_lo((unsigned)(q0_ >> 32)) + (bf_lo((unsigned)(q1_ >> 32)) + bf_lo((unsigned)(q2_ >> 32))); v[3] = bf_hi((unsigned)(q0_ >> 32)) + (bf_hi((unsigned)(q1_ >> 32)) + bf_hi((unsigned)(q2_ >> 32)));
                const unsigned w0 = pk2(v[0], v[1]), w1 = pk2(v[2], v[3]); const float q0 = bf_lo(w0), q1 = bf_hi(w0), q2 = bf_lo(w1), q3 = bf_hi(w1);
                s += (q0 * q0 + q1 * q1) + (q2 * q2 + q3 * q3);
                o8[64 * j] = (unsigned long long)w0 | ((unsigned long long)w1 << 32); }
            s = wave_sum(s); if (F.lane < 4) stats_out[(size_t)m * 4 + F.lane] = (F.lane == 0) ? s : 0.f; }
    }
}
__device__ __forceinline__ void final_phase(Frame& F, const Args& a) {
    float* h = F.out; const bf16* hbp = (const bf16*)(F.ws + WS_HB); const float* gain = in_ptr(F, 23);
    const int gw = F.vcu * NWAVES + F.wave, NGW = F.G * NWAVES;
    float dscale = 1.f;
#ifdef TSDIAG
    { const unsigned long long* ts = (const unsigned long long*)(F.ctl + CW_TS); dscale = 1.f + (float)(ts[TS_A1] - ts[TS_A0]) * (0.01f / 3000.f); }
#endif
    f32x4 gv[4];
#pragma unroll
    for (int j = 0; j < 4; ++j) gv[j] = ((const GAS f32x4*)gain)[F.lane + 64 * j];
    for (int m0 = gw; m0 < NTOK; m0 += 2 * NGW) {
        unsigned long long pw[2][4];
#pragma unroll
        for (int u = 0; u < 2; ++u) { if (m0 + u * NGW >= NTOK) continue; const GAS unsigned long long* xr = (const GAS unsigned long long*)(hbp + (size_t)(m0 + u * NGW) * D) + F.lane;
#pragma unroll
            for (int j = 0; j < 4; ++j) pw[u][j] = xr[64 * j]; }
#pragma unroll
        for (int u = 0; u < 2; ++u) { if (m0 + u * NGW >= NTOK) continue; GAS f32x4* hr = (GAS f32x4*)(h + (size_t)(m0 + u * NGW) * D) + F.lane; f32x4 v[4]; float ss = 0.f;
#pragma unroll
            for (int j = 0; j < 4; ++j) { const unsigned long long q = pw[u][j]; v[j] = (f32x4){bf_lo((unsigned)q), bf_hi((unsigned)q), bf_lo((unsigned)(q >> 32)), bf_hi((unsigned)(q >> 32))}; ss += (v[j][0] * v[j][0] + v[j][1] * v[j][1]) + (v[j][2] * v[j][2] + v[j][3] * v[j][3]); }
            ss = wave_sum(ss); const float rs = 1.f / sqrtf(ss * (1.f / D) + EPS);
#pragma unroll
            for (int j = 0; j < 4; ++j) hr[64 * j] = v[j] * rs * gv[j] * dscale; }
    }
#ifdef TSDIAG
    if (gw == 0 && F.lane == 0) { const unsigned long long* ts = (const unsigned long long*)(F.ctl + CW_TS); h[0] = (float)(ts[TS_B1] - ts[TS_B0]) * (0.01f / 30.f); }
#endif
}

__device__ __forceinline__ int launder2() { int n = 2; asm volatile("" : "+s"(n)); return n; }
constexpr int N_PHASES = 26;
__global__ void __launch_bounds__(NWAVES * 64, 2) mega_fwd(Args args) {
    extern __shared__ __attribute__((aligned(16))) unsigned char lds[];
    Frame F;
    F.lds = (LAS unsigned char*)lds; F.ldsg = (char*)lds;
    F.MISC = (volatile LAS unsigned*)(F.lds + MISC_OFF);
    F.tid = threadIdx.x; F.lane = F.tid & 63; F.wave = __builtin_amdgcn_readfirstlane(F.tid >> 6);
    F.G = gridDim.x; { const int bx = blockIdx.x; F.vcu = (F.G % 8 == 0) ? (bx % 8) * (F.G / 8) + bx / 8 : bx; }
    F.ws = args.ws; F.out = F.out;
    F.ctl = (gu32*)(F.ws + WS_CTL);
    for (int u = F.tid; u < (LDS_BYTES - LDSCTL_OFF) / 4; u += NWAVES * 64) ((LAS unsigned*)(F.lds + LDSCTL_OFF))[u] = 0u;
    __syncthreads();
    if (F.tid == 0) {
#pragma unroll
        for (int i = 0; i < 24; ++i) ((LAS unsigned long long*)(F.lds + PT_OFF))[i] = (unsigned long long)args.in[i]; }
    __syncthreads();
    int lo = args.ph_lo, hi = args.ph_hi, bid = (int)blockIdx.x; size_t zoff = 0; int nst = 0;
#define one (lo == 0 && hi == N_PHASES)
    XcdBarrier bar; bar.bar = (unsigned*)(F.ctl + CW_BAR); bar.x = 0; bar.st = nullptr;
    if (one) bar = xcd_barrier_post((unsigned*)(F.ctl + CW_BAR), F.MISC + 8);
#define IN(k) (lo <= (k) && (k) < hi)
#ifndef MK_PHMASK
#define MK_PHMASK 0xffffffffu
#endif
#define EN(n) (((MK_PHMASK) >> (n)) & 1u)
#ifndef DUPK
#define DUPK -1
#endif
#define NREP(k) ((DUPK) == (k) ? launder2() : 1)
#ifndef DUPBAR
#define DUPBAR 1
#endif
#ifdef TSDIAG
#define STAMP() do { if (bid == 0 && F.tid == 0) ((unsigned long long*)(F.ctl + CW_TS))[nst] = __builtin_amdgcn_s_memrealtime(); ++nst; } while (0)
#else
#define STAMP() do {} while (0)
#endif
#define SEAM() do { if (one) { for (int b_ = 0; b_ < DUPBAR; ++b_) xcd_barrier(bar, F.tid); } STAMP(); } while (0)
#define FRESH() do { asm volatile("" : "+v"(F.tid)); asm volatile("" : "+s"(zoff), "+s"(lo), "+s"(hi), "+s"(bid), "+s"(F.G), "+s"(F.vcu)); F.ws = args.ws + zoff; F.out = (float*)((char*)args.out + zoff); F.lane = F.tid & 63; F.wave = __builtin_amdgcn_readfirstlane(F.tid >> 6); F.ctl = (gu32*)(F.ws + WS_CTL); } while (0)
#define hb ((bf16*)(L == 0 ? (void*)(F.ws + WS_HB) : (void*)F.out))
#define hbn ((bf16*)(L == 0 ? (void*)F.out : (void*)(F.ws + WS_HB)))
#define st0 ((float*)(F.ws + WS_STATS0))
#define st1 ((float*)(F.ws + WS_STATS1))
#define ST_CUR (sb ? st1 : st0)
#define ST_NXT (sb ? st0 : st1)

    STAMP();
    FRESH(); if (EN(0) && IN(0)) { for (int r_ = 0; r_ < NREP(0); ++r_) p0_prologue(F, args); SEAM(); }
    int sb = 0;
#pragma unroll
    for (int L = 0; L < DEPTH; ++L) {
        const int pb = 1 + 12 * L;
        FRESH(); if (EN(1) && IN(pb + 0)) {
            pg8::Gemm g{hb, (const pg8::bf16_t*)(F.ws + (L ? WS_WIN1 : WS_WIN0)), NTOK, NIN, D, 0}; pg8::StaticOrder S; S.init(NTOK, NIN, F.G, bid);
            pg8::EpiIn E{(pg8::bf16_t*)(F.ws + WS_PROJ), (float*)(F.ws + WS_LOGF), ST_CUR, (const float*)(F.ws + WS_RCOS), (const float*)(F.ws + WS_RSIN), in_ptr(F, 4) + 4 * L, attn_body::C2};
            if (DUPK == 1) { pg8::EpiBf16<0> EJ{(pg8::bf16_t*)(F.ws + WS_PROJ), PROJ_P, nullptr, 0, 0, 1.f}; pg8::gemm_phase<pg8::EpiBf16<0>, pg8::StaticOrder, true, true>(F.lds + RING_OFF, g, S, EJ, F.tid); }
            pg8::gemm_phase<pg8::EpiIn, pg8::StaticOrder, true, true>(F.lds + RING_OFF, g, S, E, F.tid);
#ifndef MK_CONV_IN_PROLOGUE
            if (F.G == 256) convert_slot(F, L == 0 ? 0 : 2, bid);
#endif
            SEAM(); }
        FRESH(); if (EN(2) && IN(pb + 1)) { mixer_phase(F, args, L); SEAM(); }
        FRESH(); if (EN(3) && IN(pb + 2)) { for (int r_ = 0; r_ < NREP(3); ++r_) combine_phase(F, args, L); SEAM(); }
        FRESH(); if (EN(4) && IN(pb + 3)) {
            pg8::Gemm g{(const pg8::bf16_t*)(F.ws + WS_OCAT), (const pg8::bf16_t*)(F.ws + (L ? WS_WOUT1 : WS_WOUT0)), NTOK, D, D, 0}; pg8::StaticOrder S; S.init(NTOK, D, F.G, bid);
            pg8::EpiRes<0> E{hb, hb, ST_NXT, nullptr, nullptr, nullptr, 1.f, (LAS float*)(F.lds + RED_OFF)};
            pg8::gemm_phase<pg8::EpiRes<0>, pg8::StaticOrder, true, true>(F.lds + RING_OFF, g, S, E, F.tid);
            if (DUPK == 4) { pg8::EpiBf16<0> EJ{(pg8::bf16_t*)(F.ws + WS_OA), D, nullptr, 0, 0, 1.f}; pg8::gemm_phase<pg8::EpiBf16<0>, pg8::StaticOrder, false, true>(F.lds + RING_OFF, g, S, EJ, F.tid); }
            SEAM(); }
        sb ^= 1;
        if (L == 0) {
            FRESH(); if (EN(5) && IN(pb + 4)) {
                pg8::Gemm g{hb, (const pg8::bf16_t*)(F.ws + WS_DGU), NTOK, NGUD, D, 0}; pg8::StaticOrder S; S.init(NTOK, NGUD, F.G, bid);
                pg8::EpiGU<true> E{(pg8::bf16_t*)(F.ws + WS_ACTD), FFD, ST_CUR, 1.f, 1.f};
                for (int r_ = 0; r_ < NREP(5); ++r_) pg8::gemm_phase<pg8::EpiGU<true>, pg8::StaticOrder, true, true>(F.lds + RING_OFF, g, S, E, F.tid);
#ifndef MK_CONV_IN_PROLOGUE
                if (F.G == 256) convert_slot(F, 1, bid);
#endif
                SEAM(); }
            FRESH(); if (EN(6) && IN(pb + 5)) {
                pg8::Gemm g{(const pg8::bf16_t*)(F.ws + WS_ACTD), (const pg8::bf16_t*)(F.ws + WS_DD), NTOK, D, FFD, 0}; pg8::StaticOrder S; S.init(NTOK, D, F.G, bid);
                pg8::EpiRes<0> E{hb, hb, ST_NXT, nullptr, nullptr, nullptr, 1.f, (LAS float*)(F.lds + RED_OFF)};
                pg8::gemm_phase<pg8::EpiRes<0>, pg8::StaticOrder, true, true>(F.lds + RING_OFF, g, S, E, F.tid);
                if (DUPK == 6) { pg8::EpiBf16<0> EJ{(pg8::bf16_t*)(F.ws + WS_OA), D, nullptr, 0, 0, 1.f}; pg8::gemm_phase<pg8::EpiBf16<0>, pg8::StaticOrder, false, true>(F.lds + RING_OFF, g, S, EJ, F.tid); }
                SEAM(); }
        } else {
            FRESH(); if (EN(7) && IN(pb + 4)) { router_phase(F, args, hb); SEAM(); }
            FRESH(); if (EN(8) && IN(pb + 5)) { for (int r_ = 0; r_ < NREP(8); ++r_) gather_phase(F, args, hb); SEAM(); }
            FRESH(); if (EN(9) && IN(pb + 6)) {
                pg8::MoeOrder S; moe_tiles(F, S.tb); S.nM = S.tb[8]; S.nN = NGUE / 256; S.nwg = S.nM * S.nN; S.G = F.G; S.c = bid;
                pg8::Gemm g{(const pg8::bf16_t*)(F.ws + WS_XS), (const pg8::bf16_t*)(F.ws + WS_MGU), MP_MAX, NGUE, D, (size_t)NGUE * D};
                pg8::EpiGU<false, true> E{(pg8::bf16_t*)(F.ws + WS_ACTE), FFE, nullptr, 1.f / 32.f, 4.f};
                if (DUPK == 9) { pg8::gemm_phase<pg8::EpiGU<false, true>, pg8::MoeOrder, true, true, true>(F.lds + RING_OFF, g, S, E, F.tid); SEAM(); }
                pg8::gemm_phase<pg8::EpiGU<false, true>, pg8::MoeOrder, true, true, true>(F.lds + RING_OFF, g, S, E, F.tid);
                SEAM(); }
            FRESH(); if (EN(10) && IN(pb + 7)) {
                pg8::MoeOrder S; moe_tiles(F, S.tb); S.nM = S.tb[8]; S.nN = D / 256; S.nwg = S.nM * S.nN; S.G = F.G; S.c = bid;
                pg8::Gemm g{(const pg8::bf16_t*)(F.ws + WS_ACTE), (const pg8::bf16_t*)(F.ws + WS_MD), MP_MAX, D, FFE, (size_t)D * FFE};
                pg8::EpiMoeDown E{(pg8::bf16_t*)(F.ws + WS_XS), (const int*)(F.ws + WS_DST), (const float*)(F.ws + WS_GSORT), 1.f / 256.f};
                for (int r_ = 0; r_ < NREP(10); ++r_) pg8::gemm_phase<pg8::EpiMoeDown, pg8::MoeOrder, true, true, true>(F.lds + RING_OFF, g, S, E, F.tid);
                SEAM(); }
            FRESH(); if (EN(11) && IN(pb + 8)) { moe_combine_phase(F, args, ST_NXT, hb); SEAM(); }
        }
        sb ^= 1;
        FRESH(); if (EN(12) && IN(pb + 9)) {
            pg8::Gemm g{(const pg8::bf16_t*)(F.ws + (L ? WS_P1 : WS_P0)), (const pg8::bf16_t*)(F.ws + (L ? WS_PPW1 : WS_PPW0)), NTOK, D, PLE, 0}; pg8::StaticOrder S; S.init(NTOK, D, F.G, bid);
            pg8::EpiBf16<0> E{(pg8::bf16_t*)(F.ws + WS_PP), D, nullptr, 0, 0, 1.f};
            for (int r_ = 0; r_ < NREP(12); ++r_) pg8::gemm_phase<pg8::EpiBf16<0>, pg8::StaticOrder, true, true>(F.lds + RING_OFF, g, S, E, F.tid);
            if (!one) {   } }
        FRESH(); if (EN(13) && IN(pb + 10)) {
            pg8::Gemm g{hb, (const pg8::bf16_t*)(F.ws + (L ? WS_PG1 : WS_PG0)), NTOK, D, D, 0}; pg8::StaticOrder S; S.init(NTOK, D, F.G, bid);
            pg8::EpiRes<1> E{hb, hbn, ST_NXT, ST_CUR, (const pg8::bf16_t*)(F.ws + WS_PP), nullptr, 1.f, (LAS float*)(F.lds + RED_OFF)};
            pg8::gemm_phase<pg8::EpiRes<1>, pg8::StaticOrder, true, true>(F.lds + RING_OFF, g, S, E, F.tid);
            if (DUPK == 13) { pg8::EpiBf16<0> EJ{(pg8::bf16_t*)(F.ws + WS_OCAT), D, nullptr, 0, 0, 1.f}; pg8::gemm_phase<pg8::EpiBf16<0>, pg8::StaticOrder, false, true>(F.lds + RING_OFF, g, S, EJ, F.tid); }
            SEAM(); }
        sb ^= 1;
    }
    FRESH(); if (EN(14) && IN(25)) final_phase(F, args);
#undef IN
#undef SEAM
#undef FRESH
#undef one
#undef hb
#undef hbn
#undef st0
#undef st1
}

#ifndef MK_PER_PHASE
#define MK_PER_PHASE 0
#endif
extern "C" void kernel_launch(void* const* d_in, const int* in_sizes, int n_in, void* d_out, int out_size, void* d_ws, size_t ws_size, hipStream_t stream) {
    static int grid = 0;
    if (grid == 0) {
        if (n_in != 24 || in_sizes[0] != NTOK * D || out_size != NTOK * D || ws_size < WS_END) { fprintf(stderr, "kernel_launch: unexpected shapes or workspace (%zu < %zu)\n", ws_size, (size_t)WS_END); grid = -1; return; }
        int dev = 0, cus = 0, per_cu = 0;
        if (hipGetDevice(&dev) != hipSuccess || hipDeviceGetAttribute(&cus, hipDeviceAttributeMultiprocessorCount, dev) != hipSuccess) { grid = -1; return; }
        if (hipFuncSetAttribute((const void*)mega_fwd, hipFuncAttributeMaxDynamicSharedMemorySize, LDS_BYTES) != hipSuccess) { fprintf(stderr, "kernel_launch: hipFuncSetAttribute failed\n"); grid = -1; return; }
        if (hipOccupancyMaxActiveBlocksPerMultiprocessor(&per_cu, (const void*)mega_fwd, NWAVES * 64, LDS_BYTES) != hipSuccess || per_cu < 1) { fprintf(stderr, "kernel_launch: occupancy query says %d\n", per_cu); }
        (void)hipGetLastError();
        grid = cus;
    }
    if (grid < 0) return;
    if (hipMemsetAsync((char*)d_ws + WS_CTL, 0, CTL_ZERO_BYTES, stream) != hipSuccess) return;
    Args a{};
    for (int i = 0; i < 24; ++i) a.in[i] = (const float*)d_in[i];
    a.out = (float*)d_out; a.ws = (unsigned char*)d_ws;
#if MK_PER_PHASE
    for (int p = 0; p < N_PHASES; ++p) { a.ph_lo = p; a.ph_hi = p + 1; hipLaunchKernelGGL(mega_fwd, dim3(grid), dim3(NWAVES * 64), LDS_BYTES, stream, a); }
#else
    a.ph_lo = 0; a.ph_hi = N_PHASES; hipLaunchKernelGGL(mega_fwd, dim3(grid), dim3(NWAVES * 64), LDS_BYTES, stream, a);
#endif
}
```

```cpp
#include <hip/hip_runtime.h>
#include <cstdio>
#include <cstdint>
namespace pg8 {
#define PG8_LAS __attribute__((address_space(3)))
typedef unsigned short bf16_t;
typedef short bf16x8 __attribute__((ext_vector_type(8)));
typedef float f32x4 __attribute__((ext_vector_type(4)));
typedef unsigned u32x4 __attribute__((ext_vector_type(4)));
constexpr int BM = 256, BK = 64, HALF = 128, HTB = HALF * BK * 2  , STAGE_BYTES = 8 * HTB, NXCD = 8, WGM = 8;

__host__ __device__ __forceinline__ int lds_byte(int r, int c) { const int st = (r >> 4) * 2 + (c >> 5), rr = r & 15, cc = c & 31, ob = rr * 64 + cc * 2; return st * 1024 + (ob ^ (((ob >> 9) & 1) << 5)); }
__host__ __device__ __forceinline__ void stage_rc(int b, int& R, int& C) { const int st = b / 1024, sb = b % 1024, swz = sb ^ (((sb >> 9) & 1) << 5); R = (st >> 1) * 16 + swz / 64; C = (st & 1) * 32 + (swz % 64) / 2; }
__host__ __device__ __forceinline__ int perm32(int rho) { const int n = rho >> 4, i = rho & 15; return 8 * (i >> 2) + 4 * n + (i & 3); }

struct Unit { int pm, pn, pe; };
struct Gemm { const bf16_t* A; const bf16_t* Bt; int M, N, K; size_t bstride; };

struct StaticOrder {
    int nM, nN, nwg, G, c;
    __host__ __device__ void init(int M, int N, int G_, int c_) { nM = M / BM; nN = N / BM; nwg = nM * nN; G = G_; c = c_; }
    __host__ __device__ bool next(int i, Unit& u) const {
        const long L = (long)i * G + c; if (L >= nwg) return false;
        int wgid = (int)L; { const int q = nwg / NXCD, r = nwg % NXCD, xcd = wgid % NXCD, off = wgid / NXCD; wgid = (xcd < r ? xcd * (q + 1) : r * (q + 1) + (xcd - r) * q) + off; }
        const int nig = WGM * nN, gid = wgid / nig, fm = gid * WGM, gsz = (nM - fm) < WGM ? (nM - fm) : WGM;
        u.pm = fm + ((wgid % nig) % gsz); u.pn = (wgid % nig) / gsz; u.pe = 0; return true;
    }
    __device__ __forceinline__ void a_ready(const Unit&) const {}
    __device__ __forceinline__ void done(const Unit&) const {}
};

__device__ __forceinline__ unsigned cvt_pk_bf16(float lo, float hi) { unsigned r; asm volatile("v_cvt_pk_bf16_f32 %0, %1, %2" : "=v"(r) : "v"(lo), "v"(hi)); return r; }
typedef float f32x2 __attribute__((ext_vector_type(2)));
__device__ __forceinline__ f32x2 gelu_pk(f32x2 v) {
    const f32x2 av = __builtin_elementwise_abs(v), d = av * 0.2316418882f + 1.0f;
    f32x2 t; t.x = __builtin_amdgcn_rcpf(d.x); t.y = __builtin_amdgcn_rcpf(d.y);
    f32x2 q = t * 0.5307027145f + (-0.7265760135f); q = q * t + 0.7107068705f; q = q * t + (-0.142248368f); q = q * t + 0.127414796f; q = q * t;
    const f32x2 s = (v * v) * (-0.72134752044f);
    f32x2 e; e.x = __builtin_amdgcn_exp2f(s.x); e.y = __builtin_amdgcn_exp2f(s.y);
    const f32x2 m = v * (q * e), r = v - m;
    f32x2 o; o.x = v.x < 0.f ? m.x : r.x; o.y = v.y < 0.f ? m.y : r.y; return o;
}

template <int ACT  > struct EpiBf16 {
    static constexpr bool PERM = true, AFTER_DRAIN = false; static_assert(ACT == 0 || ACT == 1, "EpiBf16: ACT is 0 (none) or 1 (gelu_pk)");
    bf16_t* O; int ldc; const float* bias; int split_cols; size_t split_stride; float scale0;
    __device__ __forceinline__ void operator()(const f32x4 (&acc)[2][2][4][2], const Unit& u, int wr, int wc, int fr, int fq) const {
        const int row0 = u.pm * BM + wr * 64 + fr; int colt = u.pn * BM; bf16_t* base = O;
        float sc = 1.f; if (split_cols) { const int t = colt / split_cols; base += (size_t)t * split_stride; colt -= t * split_cols; if (t == 0) sc = scale0; }
        const int col0 = colt + wc * 32 + 8 * fq, bcol0 = u.pn * BM + wc * 32 + 8 * fq;
        f32x4 bv[2][2];
#pragma unroll
        for (int bj = 0; bj < 2; ++bj)
#pragma unroll
            for (int n = 0; n < 2; ++n) bv[bj][n] = bias ? *(const f32x4*)(bias + bcol0 + bj * HALF + 4 * n) : (f32x4){0.f, 0.f, 0.f, 0.f};
#pragma unroll
        for (int ai = 0; ai < 2; ++ai)
#pragma unroll
            for (int m = 0; m < 4; ++m) { bf16_t* rowp = base + (size_t)(row0 + ai * HALF + m * 16) * ldc + col0;
#pragma unroll
                for (int bj = 0; bj < 2; ++bj) { f32x4 v0 = acc[ai][bj][m][0] + bv[bj][0], v1 = acc[ai][bj][m][1] + bv[bj][1];
                    if (ACT == 1) { f32x2 a = gelu_pk((f32x2){v0[0], v0[1]}), b = gelu_pk((f32x2){v0[2], v0[3]}), c = gelu_pk((f32x2){v1[0], v1[1]}), d = gelu_pk((f32x2){v1[2], v1[3]});
                        v0 = (f32x4){a.x, a.y, b.x, b.y}; v1 = (f32x4){c.x, c.y, d.x, d.y}; }
                    v0 = v0 * sc; v1 = v1 * sc; u32x4 w; w.x = cvt_pk_bf16(v0[0], v0[1]); w.y = cvt_pk_bf16(v0[2], v0[3]); w.z = cvt_pk_bf16(v1[0], v1[1]); w.w = cvt_pk_bf16(v1[2], v1[3]);
                    *(u32x4*)(rowp + bj * HALF) = w; } }
    }
};

typedef int v8i32 __attribute__((ext_vector_type(8))); typedef short s16x16 __attribute__((ext_vector_type(16)));
__device__ __forceinline__ v8i32 cat8(bf16x8 lo, bf16x8 hi) { return __builtin_bit_cast(v8i32, __builtin_shufflevector(lo, hi, 0, 1, 2, 3, 4, 5, 6, 7, 8, 9, 10, 11, 12, 13, 14, 15)); }
__device__ __forceinline__ unsigned long long pack8_fp8(const f32x4 v0, const f32x4 v1) {
    unsigned lo = 0, hi = 0; lo = __builtin_amdgcn_cvt_pk_fp8_f32(v0[0], v0[1], lo, false); lo = __builtin_amdgcn_cvt_pk_fp8_f32(v0[2], v0[3], lo, true);
    hi = __builtin_amdgcn_cvt_pk_fp8_f32(v1[0], v1[1], hi, false); hi = __builtin_amdgcn_cvt_pk_fp8_f32(v1[2], v1[3], hi, true); return (unsigned long long)lo | ((unsigned long long)hi << 32); }
constexpr float RMS_EPS = 1e-6f;
constexpr float LOG2E = 1.4426950408889634f;
__device__ __forceinline__ float fast_sigmoid(float x) { return __builtin_amdgcn_rcpf(1.f + __builtin_amdgcn_exp2f(-x * LOG2E)); }
__device__ __forceinline__ float row_rstd(const float* st, int row) {
    const f32x4 a = *(const f32x4*)(st + (size_t)row * 4);
    return __builtin_amdgcn_rsqf(((a[0] + a[1]) + (a[2] + a[3])) * (1.f / 1024.f) + RMS_EPS);
}
__device__ __forceinline__ u32x4 pack8(const f32x4 v0, const f32x4 v1) { u32x4 w; w.x = cvt_pk_bf16(v0[0], v0[1]); w.y = cvt_pk_bf16(v0[2], v0[3]); w.z = cvt_pk_bf16(v1[0], v1[1]); w.w = cvt_pk_bf16(v1[2], v1[3]); return w; }
__device__ __forceinline__ float bf_lo(unsigned w) { return __builtin_bit_cast(float, w << 16); }
__device__ __forceinline__ float bf_hi(unsigned w) { return __builtin_bit_cast(float, w & 0xffff0000u); }

struct EpiIn {
    static constexpr bool PERM = true, AFTER_DRAIN = false;
    bf16_t* proj; float* logf; const float* stats; const float* rcos; const float* rsin; const float* bfg; float c2;
    __device__ __forceinline__ void operator()(const f32x4 (&acc)[2][2][4][2], const Unit& u, int wr, int wc, int fr, int fq) const {
        const int pn = u.pn; const int row0 = u.pm * BM + wr * 64 + fr;
        float rr[8];
#pragma unroll
        for (int k = 0; k < 8; ++k) rr[k] = row_rstd(stats, row0 + (k >> 2) * HALF + (k & 3) * 16);
        if (pn == 9 || pn == 10) {
            const float s0 = (pn == 10) ? 0.125f : 1.f;
#pragma unroll
            for (int ai = 0; ai < 2; ++ai) {
                f32x4 cv[4][2], sv[4][2];
#pragma unroll
                for (int m = 0; m < 4; ++m) { const int pos = (row0 + ai * HALF + m * 16) & 4095; const f32x4* cp = (const f32x4*)(rcos + pos * 32 + 8 * fq); const f32x4* sp = (const f32x4*)(rsin + pos * 32 + 8 * fq);
                    cv[m][0] = cp[0]; cv[m][1] = cp[1]; sv[m][0] = sp[0]; sv[m][1] = sp[1]; }
#pragma unroll
                for (int m = 0; m < 4; ++m) { const int row = row0 + ai * HALF + m * 16; const float sc = s0 * rr[ai * 4 + m];
                    f32x4 o1[2], o2[2];
#pragma unroll
                    for (int n = 0; n < 2; ++n) { const f32x4 c = cv[m][n], s = sv[m][n], x1 = acc[ai][0][m][n] * sc, x2 = acc[ai][1][m][n] * sc; o1[n] = x1 * c - x2 * s; o2[n] = x1 * s + x2 * c; }
                    bf16_t* dst = proj + (size_t)row * 3328 + 256 * pn + 64 * wc + 8 * fq;
                    *(u32x4*)dst = pack8(o1[0], o1[1]); *(u32x4*)(dst + 32) = pack8(o2[0], o2[1]); }
            }
            return;
        }
#pragma unroll
        for (int ai = 0; ai < 2; ++ai)
#pragma unroll
            for (int m = 0; m < 4; ++m) {
                const int row = row0 + ai * HALF + m * 16; const float r = rr[ai * 4 + m];
                if (pn == 13) {
                    if (wc == 0 && fq == 0) { const f32x4 b = *(const f32x4*)bfg; f32x4 x = acc[ai][0][m][0] * r + b, o;
#pragma unroll
                        for (int i = 0; i < 4; ++i) o[i] = fminf(x[i], 0.f) - log1pf(__expf(-fabsf(x[i])));
                        *(f32x4*)(logf + (size_t)row * 4) = o; }
                } else {
                    const float sc = (pn <= 1 || pn == 6) ? r * c2 : r;
                    bf16_t* dst = proj + (size_t)row * 3328 + 256 * pn + 32 * wc + 8 * fq;
#pragma unroll
                    for (int bj = 0; bj < 2; ++bj) *(u32x4*)(dst + bj * HALF) = pack8(acc[ai][bj][m][0] * sc, acc[ai][bj][m][1] * sc);
                }
            }
    }
};

template <int MODE> struct EpiRes {
    static constexpr bool PERM = true, AFTER_DRAIN = false;
    const bf16_t* hin; bf16_t* hb; float* stats_out; const float* stats_in; const bf16_t* pp; unsigned char* h8; float asc; PG8_LAS float* red;
    __device__ __forceinline__ void operator()(const f32x4 (&acc)[2][2][4][2], const Unit& u, int wr, int wc, int fr, int fq) const {
        const int row0 = u.pm * BM + wr * 64 + fr; const int col0 = u.pn * BM + wc * 32 + 8 * fq;
#pragma unroll
        for (int ai = 0; ai < 2; ++ai)
#pragma unroll
        for (int mp = 0; mp < 4; mp += 2) {
            u32x4 hw[4][2], pw[4][2]; float rr[4];
#pragma unroll
            for (int m = mp; m < mp + 2; ++m) { const int row = row0 + ai * HALF + m * 16;
#pragma unroll
                for (int bj = 0; bj < 2; ++bj) { hw[m][bj] = *(const u32x4*)(hin + (size_t)row * 1024 + col0 + bj * HALF); if (MODE == 1) pw[m][bj] = *(const u32x4*)(pp + (size_t)row * 1024 + col0 + bj * HALF); }
                rr[m] = (MODE == 1) ? row_rstd(stats_in, row) : 1.f; }
#pragma unroll
            for (int m = mp; m < mp + 2; ++m) {
                const int row = row0 + ai * HALF + m * 16; const float r = rr[m];
                float ss = 0.f;
#pragma unroll
                for (int bj = 0; bj < 2; ++bj) {
                    bf16_t* hp = hb + (size_t)row * 1024 + col0 + bj * HALF; const u32x4 hwv = hw[m][bj];
                    f32x4 h0 = (f32x4){bf_lo(hwv.x), bf_hi(hwv.x), bf_lo(hwv.y), bf_hi(hwv.y)}, h1 = (f32x4){bf_lo(hwv.z), bf_hi(hwv.z), bf_lo(hwv.w), bf_hi(hwv.w)};
                    f32x4 a0 = acc[ai][bj][m][0] * asc, a1 = acc[ai][bj][m][1] * asc;
                    if (MODE == 1) { const u32x4 pwv = pw[m][bj];
                        a0[0] = fast_sigmoid(a0[0] * r) * bf_lo(pwv.x); a0[1] = fast_sigmoid(a0[1] * r) * bf_hi(pwv.x); a0[2] = fast_sigmoid(a0[2] * r) * bf_lo(pwv.y); a0[3] = fast_sigmoid(a0[3] * r) * bf_hi(pwv.y);
                        a1[0] = fast_sigmoid(a1[0] * r) * bf_lo(pwv.z); a1[1] = fast_sigmoid(a1[1] * r) * bf_hi(pwv.z); a1[2] = fast_sigmoid(a1[2] * r) * bf_lo(pwv.w); a1[3] = fast_sigmoid(a1[3] * r) * bf_hi(pwv.w); }
                    h0 = h0 + a0; h1 = h1 + a1;
                    const u32x4 ow = pack8(h0, h1); *(u32x4*)hp = ow;
                    if (h8) *(unsigned long long*)(h8 + (size_t)row * 1024 + col0 + bj * HALF) = pack8_fp8(h0, h1);
                    const float q0 = bf_lo(ow.x), q1 = bf_hi(ow.x), q2 = bf_lo(ow.y), q3 = bf_hi(ow.y), q4 = bf_lo(ow.z), q5 = bf_hi(ow.z), q6 = bf_lo(ow.w), q7 = bf_hi(ow.w);
                    ss += ((q0 * q0 + q1 * q1) + (q2 * q2 + q3 * q3)) + ((q4 * q4 + q5 * q5) + (q6 * q6 + q7 * q7));
                }
                ss += __shfl_xor(ss, 16); ss += __shfl_xor(ss, 32);
                if (fq == 0) red[(wr * 64 + ai * HALF + m * 16 + fr) * 4 + wc] = ss;
            }
        }
        asm volatile("s_waitcnt lgkmcnt(0)" ::: "memory"); __builtin_amdgcn_s_barrier();
        { const int t = (wr * 4 + wc) * 64 + fq * 16 + fr; if (t < 256) { const f32x4 v = *(const PG8_LAS f32x4*)(red + 4 * t); stats_out[(size_t)(u.pm * BM + t) * 4 + u.pn] = (v[0] + v[1]) + (v[2] + v[3]); } }
        asm volatile("s_waitcnt lgkmcnt(0)" ::: "memory"); __builtin_amdgcn_s_barrier();
    }
};

template <bool SCALED, bool F8 = false> struct EpiGU {
    static constexpr bool PERM = true, AFTER_DRAIN = false;
    bf16_t* act; int ldact; const float* stats; float isc, osc;
    __device__ __forceinline__ void operator()(const f32x4 (&acc)[2][2][4][2], const Unit& u, int wr, int wc, int fr, int fq) const {
        const int row0 = u.pm * BM + wr * 64 + fr; const int col0 = u.pn * HALF + wc * 32 + 8 * fq;
        float rr[8];
#pragma unroll
        for (int k = 0; k < 8; ++k) rr[k] = SCALED ? row_rstd(stats, row0 + (k >> 2) * HALF + (k & 3) * 16) : 1.f;
#pragma unroll
        for (int ai = 0; ai < 2; ++ai)
#pragma unroll
            for (int m = 0; m < 4; ++m) {
                const int row = row0 + ai * HALF + m * 16; float r = F8 ? isc : 1.f; if (SCALED) r *= rr[ai * 4 + m];
                f32x4 o[2];
#pragma unroll
                for (int n = 0; n < 2; ++n) { const f32x4 g = acc[ai][0][m][n] * r, up = acc[ai][1][m][n] * r;
#pragma unroll
                    for (int i = 0; i < 4; ++i) o[n][i] = g[i] * fast_sigmoid(g[i]) * up[i]; }
                if (F8) *(unsigned long long*)((unsigned char*)act + (size_t)row * ldact + col0) = pack8_fp8(o[0] * osc, o[1] * osc);
                else *(u32x4*)(act + (size_t)row * ldact + col0) = pack8(o[0], o[1]);
            }
    }
};

struct EpiMoeDown {
    static constexpr bool PERM = true, AFTER_DRAIN = false;
    bf16_t* y; const int* dst; const float* gsort; float sc;
    __device__ __forceinline__ void operator()(const f32x4 (&acc)[2][2][4][2], const Unit& u, int wr, int wc, int fr, int fq) const {
        const int row0 = u.pm * BM + wr * 64 + fr; const int col0 = u.pn * BM + wc * 32 + 8 * fq;
        int dd[8]; float gg[8];
#pragma unroll
        for (int k = 0; k < 8; ++k) { const int row = row0 + (k >> 2) * HALF + (k & 3) * 16; dd[k] = dst[row]; gg[k] = gsort[row]; }
#pragma unroll
        for (int ai = 0; ai < 2; ++ai)
#pragma unroll
            for (int m = 0; m < 4; ++m) {
                const int d = dd[ai * 4 + m]; if (d < 0) continue; const float g = gg[ai * 4 + m] * sc;
#pragma unroll
                for (int bj = 0; bj < 2; ++bj) *(u32x4*)(y + (size_t)d * 1024 + col0 + bj * HALF) = pack8(acc[ai][bj][m][0] * g, acc[ai][bj][m][1] * g);
            }
    }
};

struct MoeOrder {
    int nM, nN, nwg, G, c; int tb[9];
    __device__ __forceinline__ bool next(int i, Unit& u) const {
        const long L = (long)i * G + c; if (L >= nwg) return false;
        int wgid = (int)L; { const int q = nwg / NXCD, r = nwg % NXCD, xcd = wgid % NXCD, off = wgid / NXCD; wgid = (xcd < r ? xcd * (q + 1) : r * (q + 1) + (xcd - r) * q) + off; }
        const int nig = WGM * nN, gid = wgid / nig, fm = gid * WGM, gsz = (nM - fm) < WGM ? (nM - fm) : WGM;
        u.pm = fm + ((wgid % nig) % gsz); u.pn = (wgid % nig) / gsz;
        int e = 0;
#pragma unroll
        for (int k = 1; k < 8; ++k) e += (u.pm >= tb[k]) ? 1 : 0;
        u.pe = e; return true;
    }
    __device__ __forceinline__ void a_ready(const Unit&) const {}
    __device__ __forceinline__ void done(const Unit&) const {}
};
template <class Epi, class Sched, bool ALIGN_EPI = false, bool SP2 = false, bool FP8 = false>
__device__ __forceinline__ void gemm_phase(PG8_LAS unsigned char* lds, const Gemm g, const Sched& S, const Epi& E, const int tid) {
    const int wid = __builtin_amdgcn_readfirstlane(tid >> 6), lane = tid & 63, wr = wid >> 2, wc = wid & 3, fr = lane & 15, fq = lane >> 4;
    const int K = g.K, KB = FP8 ? K : 2 * K  , nt = KB / (2 * BK);
    unsigned voffA[2], voffB[2];
#pragma unroll
    for (int i = 0; i < 2; ++i) { int R, C; stage_rc(tid * 16 + i * 8192, R, C); const int Rb = Epi::PERM ? ((R & ~31) + perm32(R & 31)) : R;
        voffA[i] = (unsigned)(R * KB + 2 * C); voffB[i] = (unsigned)(Rb * KB + 2 * C); }
    const size_t kstep = (size_t)(BK * 2);
    const size_t hstep = (size_t)HALF * KB;
    const size_t tstep = 2 * hstep;
    const unsigned ldsw = (unsigned)wid * 1024u;
    const int aoff = lds_byte(wr * 64 + fr, FP8 ? fq * 16 : fq * 8), boff = lds_byte(wc * 32 + fr, FP8 ? fq * 16 : fq * 8); constexpr int KPIECE = FP8 ? 16 : 1024;
#define PG8_SA(b, h) (((b) * 2 + (h)) * HTB)
#define PG8_SB(b, h) ((4 + (b) * 2 + (h)) * HTB)
#define PG8_STAGE(bufoff, gbase, voff) do { _Pragma("unroll") for (int _i = 0; _i < 2; ++_i) \
        __builtin_amdgcn_global_load_lds((const unsigned*)((const char*)(gbase) + (voff)[_i]), (PG8_LAS unsigned*)(lds + (bufoff) + ldsw + _i * 8192), 16, 0, 0); } while (0)
#define PG8_LDA(dst, b, h) do { if constexpr (FP8) { _Pragma("unroll") for (int m = 0; m < 4; ++m) dst##8[m] = *(const PG8_LAS v8i32*)(lds + PG8_SA(b, h) + aoff + m * 2048); } else _Pragma("unroll") for (int m = 0; m < 4; ++m) _Pragma("unroll") for (int k = 0; k < 2; ++k) dst[m][k] = *(const PG8_LAS bf16x8*)(lds + PG8_SA(b, h) + aoff + m * 2048 + k * 1024); } while (0)
#define PG8_LDB(dst, b, h) do { if constexpr (FP8) { _Pragma("unroll") for (int n = 0; n < 2; ++n) dst##8[n] = *(const PG8_LAS v8i32*)(lds + PG8_SB(b, h) + boff + n * 2048); } else _Pragma("unroll") for (int n = 0; n < 2; ++n) _Pragma("unroll") for (int k = 0; k < 2; ++k) dst[n][k] = *(const PG8_LAS bf16x8*)(lds + PG8_SB(b, h) + boff + n * 2048 + k * 1024); } while (0)
#define PG8_MMA(ai, bj, At, Bt) do { __builtin_amdgcn_s_setprio(1); _Pragma("unroll") for (int m = 0; m < 4; ++m) _Pragma("unroll") for (int n = 0; n < 2; ++n) { \
        if constexpr (FP8) { asm volatile("v_mfma_scale_f32_16x16x128_f8f6f4 %0, %1, %2, %0, %3, %3 op_sel_hi:[0,0,0]" : "+v"(acc[ai][bj][m][n]) : "v"(Bt##8[n]), "v"(At##8[m]), "v"(f8one)); } \
        else { _Pragma("unroll") for (int k = 0; k < 2; ++k) acc[ai][bj][m][n] = __builtin_amdgcn_mfma_f32_16x16x32_bf16(Bt[n][k], At[m][k], acc[ai][bj][m][n], 0, 0, 0); } } __builtin_amdgcn_s_setprio(0); } while (0)
#define PG8_WAIT_V(n) asm volatile("s_waitcnt vmcnt(" #n ")" ::: "memory")
#define PG8_WAIT_L(n) asm volatile("s_waitcnt lgkmcnt(" #n ")" ::: "memory")
#define PG8_BAR __builtin_amdgcn_s_barrier()
#define PG8_SCHED __builtin_amdgcn_sched_barrier(0)
    Unit cur, nxt; int ui = 0;
    if (!S.next(0, cur)) return;
    f32x4 acc[2][2][4][2];
#pragma unroll
    for (int a = 0; a < 2; ++a)
#pragma unroll
        for (int b = 0; b < 2; ++b)
#pragma unroll
            for (int m = 0; m < 4; ++m)
#pragma unroll
                for (int n = 0; n < 2; ++n) acc[a][b][m][n] = (f32x4){0.f, 0.f, 0.f, 0.f};
    bf16x8 At[4][2], B0[2][2], B1[2][2]; v8i32 At8[4], B08[2], B18[2]; const int f8one = 0x7f7f7f7f;
    const char* cA = (const char*)g.A + (size_t)cur.pm * tstep; const char* cB = (const char*)g.Bt + (size_t)cur.pn * tstep + (size_t)cur.pe * g.bstride;
    S.a_ready(cur);
    if constexpr (SP2) {
        PG8_STAGE(PG8_SB(0, 0), cB, voffB); PG8_STAGE(PG8_SB(0, 1), cB + hstep, voffB); PG8_STAGE(PG8_SA(0, 0), cA, voffA); PG8_STAGE(PG8_SA(0, 1), cA + hstep, voffA);
        if (wr == 1) PG8_BAR;
        PG8_WAIT_V(2); PG8_BAR;
        PG8_STAGE(PG8_SB(1, 0), cB + kstep, voffB); PG8_STAGE(PG8_SA(1, 0), cA + kstep, voffA); PG8_STAGE(PG8_SB(1, 1), cB + hstep + kstep, voffB);
        PG8_WAIT_V(6); PG8_BAR;
    } else {
        PG8_STAGE(PG8_SB(0, 0), cB, voffB); PG8_STAGE(PG8_SA(0, 0), cA, voffA); PG8_STAGE(PG8_SB(0, 1), cB + hstep, voffB); PG8_STAGE(PG8_SA(0, 1), cA + hstep, voffA);
        if (wr == 1) PG8_BAR;
        PG8_WAIT_V(4); PG8_BAR;
        PG8_STAGE(PG8_SB(1, 0), cB + kstep, voffB); PG8_STAGE(PG8_SA(1, 0), cA + kstep, voffA); PG8_STAGE(PG8_SB(1, 1), cB + hstep + kstep, voffB);
        PG8_WAIT_V(6); PG8_BAR;
    }
    for (;;) {
        const bool has_next = S.next(ui + 1, nxt);
        const char* nA = has_next ? (const char*)g.A + (size_t)nxt.pm * tstep : cA; const char* nB = has_next ? (const char*)g.Bt + (size_t)nxt.pn * tstep + (size_t)nxt.pe * g.bstride : cB;
#pragma unroll 1
        for (int t = 0; t < nt; t += 2) {
            const bool last = (t == nt - 2);
            const char* a1 = cA + (size_t)(t + 1) * kstep;
            const char* a2 = last ? nA : cA + (size_t)(t + 2) * kstep; const char* b2 = last ? nB : cB + (size_t)(t + 2) * kstep;
            const char* a3 = a2 + kstep; const char* b3 = b2 + kstep;
            if (last && has_next) S.a_ready(nxt);
            if constexpr (SP2) {
            PG8_LDB(B0, 0, 0); PG8_LDB(B1, 0, 1); PG8_SCHED; PG8_LDA(At, 0, 0); PG8_STAGE(PG8_SA(1, 1), a1 + hstep, voffA);
            PG8_WAIT_V(8); PG8_WAIT_L(0); PG8_BAR; PG8_MMA(0, 0, At, B0); PG8_MMA(0, 1, At, B1); PG8_BAR; PG8_SCHED;
            PG8_LDA(At, 0, 1); PG8_STAGE(PG8_SB(0, 0), b2, voffB); PG8_STAGE(PG8_SB(0, 1), b2 + hstep, voffB); PG8_STAGE(PG8_SA(0, 0), a2, voffA);
            PG8_WAIT_V(8); PG8_WAIT_L(0); PG8_BAR; PG8_MMA(1, 0, At, B0); PG8_MMA(1, 1, At, B1); PG8_BAR; PG8_SCHED;
            PG8_LDB(B0, 1, 0); PG8_LDB(B1, 1, 1); PG8_SCHED; PG8_LDA(At, 1, 0); PG8_STAGE(PG8_SA(0, 1), a2 + hstep, voffA);
            PG8_WAIT_V(8); PG8_WAIT_L(0); PG8_BAR; PG8_MMA(0, 0, At, B0); PG8_MMA(0, 1, At, B1); PG8_BAR; PG8_SCHED;
            PG8_LDA(At, 1, 1); PG8_STAGE(PG8_SB(1, 0), b3, voffB); PG8_STAGE(PG8_SB(1, 1), b3 + hstep, voffB); PG8_STAGE(PG8_SA(1, 0), a3, voffA);
            PG8_WAIT_V(8); PG8_WAIT_L(0); PG8_BAR; PG8_MMA(1, 0, At, B0); PG8_MMA(1, 1, At, B1); PG8_BAR; PG8_SCHED;
            } else {
            PG8_LDB(B0, 0, 0); PG8_SCHED; PG8_LDA(At, 0, 0); PG8_STAGE(PG8_SA(1, 1), a1 + hstep, voffA);
            PG8_WAIT_L(8); PG8_BAR; PG8_WAIT_L(0); PG8_MMA(0, 0, At, B0); PG8_BAR; PG8_SCHED;
            PG8_LDB(B1, 0, 1); PG8_STAGE(PG8_SB(0, 0), b2, voffB);
            PG8_BAR; PG8_WAIT_L(0); PG8_MMA(0, 1, At, B1); PG8_BAR;
            PG8_LDA(At, 0, 1); PG8_STAGE(PG8_SA(0, 0), a2, voffA);
            PG8_BAR; PG8_WAIT_L(0); PG8_MMA(1, 0, At, B0); PG8_BAR; PG8_SCHED;
            PG8_STAGE(PG8_SB(0, 1), b2 + hstep, voffB);
            PG8_WAIT_V(6); PG8_BAR; PG8_MMA(1, 1, At, B1); PG8_BAR;
            PG8_LDB(B0, 1, 0); PG8_SCHED; PG8_LDA(At, 1, 0); PG8_STAGE(PG8_SA(0, 1), a2 + hstep, voffA);
            PG8_WAIT_L(8); PG8_BAR; PG8_WAIT_L(0); PG8_MMA(0, 0, At, B0); PG8_BAR; PG8_SCHED;
            PG8_LDB(B1, 1, 1); PG8_STAGE(PG8_SB(1, 0), b3, voffB);
            PG8_BAR; PG8_WAIT_L(0); PG8_MMA(0, 1, At, B1); PG8_BAR;
            PG8_LDA(At, 1, 1); PG8_STAGE(PG8_SA(1, 0), a3, voffA);
            PG8_BAR; PG8_WAIT_L(0); PG8_MMA(1, 0, At, B0); PG8_BAR; PG8_SCHED;
            PG8_STAGE(PG8_SB(1, 1), b3 + hstep, voffB);
            PG8_WAIT_V(6); PG8_BAR; PG8_MMA(1, 1, At, B1); PG8_BAR;
            }
        }
        if constexpr (ALIGN_EPI) { if (wr == 0) PG8_BAR; }
        if constexpr (!Epi::AFTER_DRAIN) { if constexpr (FP8) asm volatile("s_nop 15\n\ts_nop 15" ::: "memory"); int t2_ = tid; asm volatile("" : "+v"(t2_)); const int l2_ = t2_ & 63; E(acc, cur, wr, wc, l2_ & 15, l2_ >> 4); S.done(cur); }
        if (!has_next) break;
#pragma unroll
        for (int a = 0; a < 2; ++a)
#pragma unroll
            for (int b = 0; b < 2; ++b)
#pragma unroll
                for (int m = 0; m < 4; ++m)
#pragma unroll
                    for (int n = 0; n < 2; ++n) acc[a][b][m][n] = (f32x4){0.f, 0.f, 0.f, 0.f};
        cur = nxt; cA = nA; cB = nB; ++ui;
        if constexpr (ALIGN_EPI) { if (wr == 1) PG8_BAR; }
    }
    PG8_WAIT_V(0);
    if constexpr (!ALIGN_EPI) { if (wr == 0) PG8_BAR; }
    PG8_BAR;
    if constexpr (Epi::AFTER_DRAIN) { E.fused(acc, cur, wr, wc, fr, fq, lds, wid, lane); S.done(cur); }
#undef PG8_SA
#undef PG8_SB
#undef PG8_STAGE
#undef PG8_LDA
#undef PG8_LDB
#undef PG8_MMA
#undef PG8_WAIT_V
#undef PG8_WAIT_L
#undef PG8_BAR
#undef PG8_SCHED
}
}
#include <hip/hip_bf16.h>
#include <cmath>
namespace attn_body {
using bf16=__hip_bfloat16;
using bf16x8=__attribute__((ext_vector_type(8)))short;
using s16x4=__attribute__((ext_vector_type(4)))short;
using f32x16=__attribute__((ext_vector_type(16)))float;
using u32x4=__attribute__((ext_vector_type(4)))unsigned;
constexpr int BATCH=4,SEQ=4096,D=64,PQ=3328,PKV=3328,PO=1024;
constexpr int NW=8,QBLK=32,QB=QBLK*NW,KVBLK=64,NQB=SEQ/QB;
constexpr int ATTN_UNIT_ROWS=QB; typedef float f32x4_t __attribute__((ext_vector_type(4)));
__device__ __forceinline__ int crow(int r,int hi){return (r&3)+8*(r>>2)+4*hi;}
#define SBAR() __builtin_amdgcn_sched_barrier(0)
__device__ __forceinline__ void cmask(f32x16&p0,f32x16&p1,int jb,int qrel,int hi){
  const float NEG=-INFINITY; int kb=64*jb+4*hi;
  #pragma unroll
  for(int r=0;r<16;++r){int kv=kb+(r&3)+8*(r>>2); if(kv>qrel)p0[r]=NEG; if(kv+32>qrel)p1[r]=NEG;}
}

constexpr int NSLOT=3, SLOTB=8192;
constexpr int VSLOTB=2*SLOTB; constexpr int LDS_K=0, LDS_V=NSLOT*SLOTB, LDS_WS=NSLOT*SLOTB+NSLOT*VSLOTB, LDS_OST=LDS_WS+NW*64*4, LDS_BYTES=LDS_OST+NW*4096;
constexpr float C2=0.125f*1.4426950408889634f;
__device__ __forceinline__ void glds16(const void*gsrc,unsigned lds_dst){unsigned keep;
  asm volatile("s_mov_b32 %0, m0\n\ts_mov_b32 m0, %2\n\ts_nop 0\n\tglobal_load_lds_dwordx4 %1, off\n\ts_mov_b32 m0, %0":"=&s"(keep):"v"(gsrc),"s"(lds_dst):"memory");}
__device__ __forceinline__ float max3f(float a,float b,float c){float r;asm("v_max3_f32 %0, %1, %2, %3":"=v"(r):"v"(a),"v"(b),"v"(c));return r;}
__device__ __forceinline__ float max2f(float a,float b){float r;asm("v_max_f32_e32 %0, %1, %2":"=v"(r):"v"(a),"v"(b));return r;}
__device__ __forceinline__ float fadd_s(float a,float b){float r;asm("v_add_f32_e32 %0, %1, %2":"=v"(r):"v"(a),"v"(b));return r;}
__device__ __forceinline__ float fsub_s(float a,float b){float r;asm("v_sub_f32_e32 %0, %1, %2":"=v"(r):"v"(a),"v"(b));return r;}
typedef float f32x2_t __attribute__((ext_vector_type(2))); typedef __bf16 bf16x2_t __attribute__((ext_vector_type(2)));
__device__ __forceinline__ unsigned cvtpk_s(float lo,float hi){f32x2_t v={lo,hi};bf16x2_t b=__builtin_convertvector(v,bf16x2_t);return __builtin_bit_cast(unsigned,b);}
#define WAIT_BAR(N) asm volatile("s_waitcnt vmcnt(" #N ") lgkmcnt(0)\n\ts_barrier":::"memory")

__device__ __forceinline__ void qkt(f32x16&p0,f32x16&p1,const char*Kslot,const bf16x8*qr,const f32x16&negm,int r32,int hi){
  const char*kb=Kslot+hi*1024+r32*16;
  #pragma unroll
  for(int d0=0;d0<4;++d0){
    const bf16x8 b0=*reinterpret_cast<const bf16x8*>(kb+d0*2048);
    const bf16x8 b1=*reinterpret_cast<const bf16x8*>(kb+d0*2048+512);
    if(d0==0){p0=__builtin_amdgcn_mfma_f32_32x32x16_bf16(b0,qr[0],negm,0,0,0);p1=__builtin_amdgcn_mfma_f32_32x32x16_bf16(b1,qr[0],negm,0,0,0);}
    else{p0=__builtin_amdgcn_mfma_f32_32x32x16_bf16(b0,qr[d0],p0,0,0,0);p1=__builtin_amdgcn_mfma_f32_32x32x16_bf16(b1,qr[d0],p1,0,0,0);}}
}
typedef __attribute__((address_space(3))) const char* lds_cptr;
typedef short v4i16_t __attribute__((ext_vector_type(4)));
__device__ __forceinline__ void kload8(bf16x8*kf,lds_cptr kp){
  kf[0]=*(const __attribute__((address_space(3))) bf16x8*)(kp);      kf[1]=*(const __attribute__((address_space(3))) bf16x8*)(kp+512);
  kf[2]=*(const __attribute__((address_space(3))) bf16x8*)(kp+2048); kf[3]=*(const __attribute__((address_space(3))) bf16x8*)(kp+2560);
  kf[4]=*(const __attribute__((address_space(3))) bf16x8*)(kp+4096); kf[5]=*(const __attribute__((address_space(3))) bf16x8*)(kp+4608);
  kf[6]=*(const __attribute__((address_space(3))) bf16x8*)(kp+6144); kf[7]=*(const __attribute__((address_space(3))) bf16x8*)(kp+6656);
}
__device__ __forceinline__ void kload2(bf16x8*kf,lds_cptr kp,int j){ kf[2*j]=*(const __attribute__((address_space(3))) bf16x8*)(kp+j*2048); kf[2*j+1]=*(const __attribute__((address_space(3))) bf16x8*)(kp+j*2048+512); }
__device__ __forceinline__ s16x4 vtr(lds_cptr p){ return __builtin_bit_cast(s16x4,__builtin_amdgcn_ds_read_tr16_b64_v4i16((__attribute__((address_space(3))) v4i16_t*)p)); }
__device__ __forceinline__ float rowmax(const f32x16&p0,const f32x16&p1){
  float a=max3f(p0[0],p0[1],p1[0]),b=max3f(p0[2],p0[3],p1[1]);a=max3f(a,p1[2],p1[3]);
  #pragma unroll
  for(int r=4;r<16;r+=4){a=max3f(a,p0[r],p0[r+1]);b=max3f(b,p0[r+2],p0[r+3]);a=max3f(a,p1[r],p1[r+1]);b=max3f(b,p1[r+2],p1[r+3]);}
  const float m=max2f(a,b);
  auto rr=__builtin_amdgcn_permlane32_swap(__float_as_uint(m),__float_as_uint(m),false,false);
  return max2f(__uint_as_float(rr[0]),__uint_as_float(rr[1]));
}
__device__ __forceinline__ void pv(f32x16*o,int vb,bf16x8 pa0,bf16x8 pa1,bf16x8 pa2,bf16x8 pa3){
  #pragma unroll
  for(int d0=0;d0<2;++d0){s16x4 lo[4],hi[4];
    #pragma unroll
    for(int ks=0;ks<4;++ks){
      asm volatile("ds_read_b64_tr_b16 %0,%1 offset:%c2":"=&v"(lo[ks]):"v"(vb),"i"(d0*4096+ks*1024):"memory");
      asm volatile("ds_read_b64_tr_b16 %0,%1 offset:%c2":"=&v"(hi[ks]):"v"(vb),"i"(d0*4096+ks*1024+512):"memory");}
    asm volatile("s_waitcnt lgkmcnt(0)":::"memory");SBAR();
    #define PK(k) (bf16x8){lo[k][0],lo[k][1],lo[k][2],lo[k][3],hi[k][0],hi[k][1],hi[k][2],hi[k][3]}
    o[d0]=__builtin_amdgcn_mfma_f32_32x32x16_bf16(pa0,PK(0),o[d0],0,0,0);
    o[d0]=__builtin_amdgcn_mfma_f32_32x32x16_bf16(pa1,PK(1),o[d0],0,0,0);
    o[d0]=__builtin_amdgcn_mfma_f32_32x32x16_bf16(pa2,PK(2),o[d0],0,0,0);
    o[d0]=__builtin_amdgcn_mfma_f32_32x32x16_bf16(pa3,PK(3),o[d0],0,0,0);
    #undef PK
  }
}

#ifndef ATTN_STORE16
#define ATTN_STORE16(p,v) (*(u32x4*)(p)=(v))
#endif
template<int THRL,bool BIAS,bool DV2> __device__ __forceinline__ void attn_unit(int b,int qb,const bf16*Q,const bf16*__restrict__ K,const bf16*__restrict__ V,bf16*O,char*shm,const __attribute__((address_space(3))) float*kbias,const int tid){
  const int lane=tid&63,r32=lane&31,hi=lane>>5; const int wid=__builtin_amdgcn_readfirstlane(tid>>6);
  const long rowbase=(long)b*SEQ; const int q0=qb*QB;
  const bf16*Qw=Q+(rowbase+q0+wid*QBLK)*PQ;
  const bf16*Kh=K+rowbase*PKV,*Vh=V+rowbase*PKV;
  const unsigned lds0=(unsigned)(uintptr_t)shm;
  float*wsf=(float*)(shm+LDS_WS)+wid*64;
  const bf16*ksrc=Kh+(long)lane*PKV+wid*8;
  const bf16*vsrc=Vh+(long)(16*(wid&3)+(lane>>2))*PKV+(wid>>2)*32+(lane&3)*8;
  const unsigned kdst=lds0+LDS_K+wid*1024, vdst=lds0+LDS_V+wid*1024;
  #define DMA_K(t,slot) glds16(ksrc+(long)(t)*KVBLK*PKV,(unsigned)__builtin_amdgcn_readfirstlane(kdst+(slot)))
  #define DMA_V(t,slot) do{ glds16(vsrc+(long)(t)*KVBLK*PKV,(unsigned)__builtin_amdgcn_readfirstlane(vdst+2*(slot))); if(DV2) glds16(vsrc+64+(long)(t)*KVBLK*PKV,(unsigned)__builtin_amdgcn_readfirstlane(vdst+2*(slot)+8192)); }while(0)
  const int vb0=(int)(lds0+LDS_V)+((lane>>4)&1)*32+(lane&3)*8+(4*hi+((lane&15)>>2))*64;
  const char*Kbase=shm+LDS_K; bf16x8 kf[8];
  const lds_cptr shm3=(lds_cptr)shm; const lds_cptr kp0=shm3+LDS_K+hi*1024+r32*16; const lds_cptr vp0=shm3+LDS_V+((lane>>4)&1)*32+(lane&3)*8+(4*hi+((lane&15)>>2))*64;
  const int NT=(q0+QB)/KVBLK;
  DMA_K(0,0);DMA_V(0,0);DMA_K(1,SLOTB);
  bf16x8 qr[4];
  #pragma unroll
  for(int d0=0;d0<4;++d0)qr[d0]=*reinterpret_cast<const bf16x8*>(&Qw[(long)r32*PQ+d0*16+hi*8]);
  const __attribute__((address_space(3))) char* qst_=(const __attribute__((address_space(3))) char*)((lds_cptr)shm+LDS_OST+wid*4096+lane*16);
  if(DV2){ _Pragma("unroll") for(int d0=0;d0<4;++d0)*(__attribute__((address_space(3))) bf16x8*)(qst_+d0*1024)=qr[d0]; }
  #define QF(j) (DV2?*(const __attribute__((address_space(3))) bf16x8*)(qst_+(j)*1024):qr[j])
  float mhat=0.f,l_reg=0.f;f32x16 o[4];o[0]=f32x16{};o[1]=f32x16{};o[2]=f32x16{};o[3]=f32x16{};const f32x16 negm=f32x16{}; const float kbq=BIAS?kbias[q0+wid*QBLK+r32]:0.f;
  const int qrel=wid*QBLK+r32;
  #define CMASK(P0,P1,t) do{int jb_=(t)-(NT-4); if(jb_>=0)cmask(P0,P1,jb_,qrel,hi);}while(0)
  bool resc=false;
  #define START(P0,P1) do{ const float rm=rowmax(P0,P1); resc=false; \
    mhat=rm; const float mo_=BIAS?mhat+kbq:mhat; \
    _Pragma("unroll") for(int r=0;r<16;++r)P0[r]=__builtin_amdgcn_exp2f((BIAS?P0[r]+kbias[crow(r,hi)]:P0[r])-mo_); \
    _Pragma("unroll") for(int r=0;r<16;++r)P1[r]=__builtin_amdgcn_exp2f((BIAS?P1[r]+kbias[32+crow(r,hi)]:P1[r])-mo_); }while(0)
  #define RESC() do{ if(resc){ asm volatile("s_waitcnt lgkmcnt(0)":::"memory"); \
      _Pragma("unroll") for(int d_=0;d_<(DV2?4:2);++d_) _Pragma("unroll") for(int r=0;r<16;++r)o[d_][r]*=wsf[crow(r,hi)]; } }while(0)
  f32x16 pA0,pA1,pB0,pB1;
  int sl_prev=0,sl_cur=0,sl_next=SLOTB;
  #define ROT() do{sl_prev=sl_cur;sl_cur=sl_next;sl_next=(sl_next==(NSLOT-1)*SLOTB)?0:sl_next+SLOTB;}while(0)
  DMA_K(2,2*SLOTB);
  if(DV2){WAIT_BAR(4);}else{WAIT_BAR(3);}
  qkt(pA0,pA1,Kbase,qr,negm,r32,hi);asm volatile("s_nop 15\n\ts_nop 7":"+v"(pA0),"+v"(pA1));CMASK(pA0,pA1,0);
  START(pA0,pA1);
  WAIT_BAR(0);
  DMA_K(3,0);DMA_V(1,SLOTB);
  ROT();
  kload8(kf,kp0+sl_cur);
  if(DV2){WAIT_BAR(3);}else{WAIT_BAR(2);}
  s16x4 vlo[8],vhi[8]; u32x4 pw0,pw1,pw2,pw3;
  #define PKW(P,B) cvtpk_s(P[B],P[B+1])
  #define PAF(k) __builtin_bit_cast(bf16x8,pw##k)
  #define VFR(i) (bf16x8){vlo[i][0],vlo[i][1],vlo[i][2],vlo[i][3],vhi[i][0],vhi[i][1],vhi[i][2],vhi[i][3]}
  #define PIN(x) asm volatile("":"+v"(x))
  #define MX3(a,b,c) __builtin_fmaxf(__builtin_fmaxf((a),(b)),(c))
  #define GAPA(MF,A0,A1,A2,A3,W0,W1,PW) do{ MF; sacc+=A0; sacc+=A1; sacc+=A2; sacc+=A3; PIN(sacc); W0; W1; PIN(PW); SBAR(); }while(0)
  #define EX(v) __builtin_amdgcn_exp2f(v)
  #define GAPB(MF,X,B,IDX) do{ f32x4_t bq_; if(BIAS)bq_=bp_[IDX]; MF; if(BIAS){ X[B]=EX((X[B]+bq_[0])-mo_); X[B+1]=EX((X[B+1]+bq_[1])-mo_); X[B+2]=EX((X[B+2]+bq_[2])-mo_); X[B+3]=EX((X[B+3]+bq_[3])-mo_); } else { X[B]=EX(X[B]-mo_); X[B+1]=EX(X[B+1]-mo_); X[B+2]=EX(X[B+2]-mo_); X[B+3]=EX(X[B+3]-mo_); } PIN(X); SBAR(); }while(0)
  #define VRD(i) do{ vlo[i]=vtr(vp_+(((i)>>2)*4096+((i)&3)*1024)); vhi[i]=vtr(vp_+(((i)>>2)*4096+((i)&3)*1024+512)); }while(0)
  #define VRD2(i) do{ if(DV2){ vlo[i]=vtr(vp_+8192+(((i)>>2)*4096+((i)&3)*1024)); vhi[i]=vtr(vp_+8192+(((i)>>2)*4096+((i)&3)*1024+512)); SBAR(); } }while(0)
  #define GAPX(MF,X,B,IDX,I,XE) do{ if(DV2){ MF; XE[2*(I)]=EX(XE[2*(I)]-mo_); XE[2*(I)+1]=EX(XE[2*(I)+1]-mo_); PIN(XE); SBAR(); } else { GAPB(MF,X,B,IDX); } }while(0)
  #define KRD(G,j) do{ if(G){ kload2(kf,kp0+sl_next,j); SBAR(); } }while(0)
  #define STEP(C0,C1,P0,P1,t,GK,GV,GL) do{ SBAR(); \
    const lds_cptr vp_=vp0+2*sl_prev; const __attribute__((address_space(3))) f32x4_t* bp_=(const __attribute__((address_space(3))) f32x4_t*)(kbias+64*(t))+hi; \
    VRD(0); SBAR(); float sacc=(P0[0]+P0[1]); \
    GAPA(C0=__builtin_amdgcn_mfma_f32_32x32x16_bf16(kf[0],QF(0),negm,0,0,0), P0[2],P0[3],P0[4],P0[5],     pw0[0]=PKW(P0,0), pw0[1]=PKW(P0,2), pw0); \
    VRD(4); SBAR(); GAPA(C1=__builtin_amdgcn_mfma_f32_32x32x16_bf16(kf[1],QF(0),negm,0,0,0), P0[6],P0[7],P0[8],P0[9],     pw0[2]=PKW(P0,4), pw0[3]=PKW(P0,6), pw0); \
    VRD(1); SBAR(); GAPA(C0=__builtin_amdgcn_mfma_f32_32x32x16_bf16(kf[2],QF(1),C0,0,0,0),   P0[10],P0[11],P0[12],P0[13], pw1[0]=PKW(P0,8), pw1[1]=PKW(P0,10), pw1); \
    VRD(5); SBAR(); GAPA(C1=__builtin_amdgcn_mfma_f32_32x32x16_bf16(kf[3],QF(1),C1,0,0,0),   P0[14],P0[15],P1[0],P1[1],   pw1[2]=PKW(P0,12),pw1[3]=PKW(P0,14), pw1); \
    VRD(2); SBAR(); GAPA(C0=__builtin_amdgcn_mfma_f32_32x32x16_bf16(kf[4],QF(2),C0,0,0,0),   P1[2],P1[3],P1[4],P1[5],     pw2[0]=PKW(P1,0), pw2[1]=PKW(P1,2), pw2); \
    VRD(6); SBAR(); GAPA(C1=__builtin_amdgcn_mfma_f32_32x32x16_bf16(kf[5],QF(2),C1,0,0,0),   P1[6],P1[7],P1[8],P1[9],     pw2[2]=PKW(P1,4), pw2[3]=PKW(P1,6), pw2); \
    VRD(3); SBAR(); GAPA(C0=__builtin_amdgcn_mfma_f32_32x32x16_bf16(kf[6],QF(3),C0,0,0,0),   P1[10],P1[11],P1[12],P1[13], pw3[0]=PKW(P1,8), pw3[1]=PKW(P1,10), pw3); \
    VRD(7); SBAR(); GAPA(C1=__builtin_amdgcn_mfma_f32_32x32x16_bf16(kf[7],QF(3),C1,0,0,0),   P1[14],P1[15],0.f,0.f,       pw3[2]=PKW(P1,12),pw3[3]=PKW(P1,14), pw3); \
    l_reg+=sacc; \
    if(GK){DMA_K((t)+3,sl_cur);} if(GV){DMA_V((t)+1,sl_next);} \
    CMASK(C0,C1,t); \
    { float a=MX3(C0[0],C0[1],C1[0]),b=MX3(C0[2],C0[3],C1[1]); a=MX3(a,C1[2],C1[3]); \
      _Pragma("unroll") for(int r=4;r<16;r+=4){a=MX3(a,C0[r],C0[r+1]);b=MX3(b,C0[r+2],C0[r+3]);a=MX3(a,C1[r],C1[r+1]);b=MX3(b,C1[r+2],C1[r+3]);} \
      float rm=__builtin_fmaxf(a,b); { auto rr=__builtin_amdgcn_permlane32_swap(__float_as_uint(rm),__float_as_uint(rm),false,false); rm=__builtin_fmaxf(__uint_as_float(rr[0]),__uint_as_float(rr[1])); } rm-=mhat; \
      resc=false; \
      if(__builtin_expect(__any(rm>(float)THRL),0)){ const float dl=__builtin_fmaxf(rm,0.f); mhat+=dl; \
        const float f=__builtin_amdgcn_exp2f(-dl); l_reg*=f; if(hi==0)wsf[r32]=f; resc=true; } } const float mo_=BIAS?mhat+kbq:mhat; \
    SBAR(); \
    GAPX(o[0]=__builtin_amdgcn_mfma_f32_32x32x16_bf16(PAF(0),VFR(0),o[0],0,0,0), C0,0,0,0,C0); VRD2(0); \
    GAPX(o[1]=__builtin_amdgcn_mfma_f32_32x32x16_bf16(PAF(0),VFR(4),o[1],0,0,0), C0,4,2,1,C0); VRD2(4); \
    KRD(GL,0); GAPX(o[0]=__builtin_amdgcn_mfma_f32_32x32x16_bf16(PAF(1),VFR(1),o[0],0,0,0), C0,8,4,2,C0); VRD2(1); \
    KRD(GL,1); GAPX(o[1]=__builtin_amdgcn_mfma_f32_32x32x16_bf16(PAF(1),VFR(5),o[1],0,0,0), C0,12,6,3,C0); VRD2(5); \
    KRD(GL,2); GAPX(o[0]=__builtin_amdgcn_mfma_f32_32x32x16_bf16(PAF(2),VFR(2),o[0],0,0,0), C1,0,8,4,C0); VRD2(2); \
    KRD(GL,3); GAPX(o[1]=__builtin_amdgcn_mfma_f32_32x32x16_bf16(PAF(2),VFR(6),o[1],0,0,0), C1,4,10,5,C0); VRD2(6); \
    GAPX(o[0]=__builtin_amdgcn_mfma_f32_32x32x16_bf16(PAF(3),VFR(3),o[0],0,0,0), C1,8,12,6,C0); VRD2(3); \
    GAPX(o[1]=__builtin_amdgcn_mfma_f32_32x32x16_bf16(PAF(3),VFR(7),o[1],0,0,0), C1,12,14,7,C0); VRD2(7); \
    if(DV2){ o[2]=__builtin_amdgcn_mfma_f32_32x32x16_bf16(PAF(0),VFR(0),o[2],0,0,0); C1[0]=EX(C1[0]-mo_); C1[1]=EX(C1[1]-mo_); PIN(C1); SBAR(); o[3]=__builtin_amdgcn_mfma_f32_32x32x16_bf16(PAF(0),VFR(4),o[3],0,0,0); C1[2]=EX(C1[2]-mo_); C1[3]=EX(C1[3]-mo_); PIN(C1); SBAR(); o[2]=__builtin_amdgcn_mfma_f32_32x32x16_bf16(PAF(1),VFR(1),o[2],0,0,0); C1[4]=EX(C1[4]-mo_); C1[5]=EX(C1[5]-mo_); PIN(C1); SBAR(); o[3]=__builtin_amdgcn_mfma_f32_32x32x16_bf16(PAF(1),VFR(5),o[3],0,0,0); C1[6]=EX(C1[6]-mo_); C1[7]=EX(C1[7]-mo_); PIN(C1); SBAR(); \
      o[2]=__builtin_amdgcn_mfma_f32_32x32x16_bf16(PAF(2),VFR(2),o[2],0,0,0); C1[8]=EX(C1[8]-mo_); C1[9]=EX(C1[9]-mo_); PIN(C1); SBAR(); o[3]=__builtin_amdgcn_mfma_f32_32x32x16_bf16(PAF(2),VFR(6),o[3],0,0,0); C1[10]=EX(C1[10]-mo_); C1[11]=EX(C1[11]-mo_); PIN(C1); SBAR(); o[2]=__builtin_amdgcn_mfma_f32_32x32x16_bf16(PAF(3),VFR(3),o[2],0,0,0); C1[12]=EX(C1[12]-mo_); C1[13]=EX(C1[13]-mo_); PIN(C1); SBAR(); o[3]=__builtin_amdgcn_mfma_f32_32x32x16_bf16(PAF(3),VFR(7),o[3],0,0,0); C1[14]=EX(C1[14]-mo_); C1[15]=EX(C1[15]-mo_); PIN(C1); SBAR(); } \
    }while(0)
  int t=1;
  #undef CMASK
  #define CMASK(P0,P1,t) do{}while(0)
  for(;t+5<NT;t+=2){
    STEP(pB0,pB1,pA0,pA1,t,true,true,true);     if(DV2){WAIT_BAR(3);}else{WAIT_BAR(2);} RESC(); ROT();
    STEP(pA0,pA1,pB0,pB1,t+1,true,true,true);   if(DV2){WAIT_BAR(3);}else{WAIT_BAR(2);} RESC(); ROT();
  }
  #undef CMASK
  #define CMASK(P0,P1,t) do{int jb_=(t)-(NT-4); if(jb_>=0)cmask(P0,P1,jb_,qrel,hi);}while(0)
  #define ENDW(tt) do{ if((tt)+3<NT){ if(DV2){WAIT_BAR(3);}else{WAIT_BAR(2);} } else if((tt)+2<NT){ if(DV2){WAIT_BAR(2);}else{WAIT_BAR(1);} } else {WAIT_BAR(0);} }while(0)
  for(;t+1<NT;t+=2){
    STEP(pB0,pB1,pA0,pA1,t,(t+3<NT),(t+1<NT),(t+1<NT));       ENDW(t);   RESC(); ROT();
    STEP(pA0,pA1,pB0,pB1,t+1,(t+4<NT),(t+2<NT),(t+2<NT));     ENDW(t+1); RESC(); ROT();
  }
  STEP(pB0,pB1,pA0,pA1,NT-1,false,false,false); RESC();
  { float sacc=pB0[0]+pB0[1]; _Pragma("unroll") for(int r=2;r<16;++r)sacc+=pB0[r]; _Pragma("unroll") for(int r=0;r<16;++r)sacc+=pB1[r]; l_reg+=sacc;
    pw0=(u32x4){PKW(pB0,0),PKW(pB0,2),PKW(pB0,4),PKW(pB0,6)};pw1=(u32x4){PKW(pB0,8),PKW(pB0,10),PKW(pB0,12),PKW(pB0,14)};pw2=(u32x4){PKW(pB1,0),PKW(pB1,2),PKW(pB1,4),PKW(pB1,6)};pw3=(u32x4){PKW(pB1,8),PKW(pB1,10),PKW(pB1,12),PKW(pB1,14)};
    SBAR(); pv(o,vb0+2*sl_cur,PAF(0),PAF(1),PAF(2),PAF(3)); if(DV2){ SBAR(); pv(o+2,vb0+2*sl_cur+8192,PAF(0),PAF(1),PAF(2),PAF(3)); } }
  #undef PKW
  #undef PAF
  #undef VFR
  #undef PIN
  #undef MX3
  #undef GAPA
  #undef GAPB
  #undef EX
  #undef VRD
  #undef KRD
  #undef VRD2
  #undef GAPX
  #undef STEP
  #undef ENDW
  {auto rr=__builtin_amdgcn_permlane32_swap(__float_as_uint(l_reg),__float_as_uint(l_reg),false,false);l_reg=__uint_as_float(rr[0])+__uint_as_float(rr[1]);}
  if(hi==0)wsf[32+r32]=l_reg;asm volatile("s_waitcnt lgkmcnt(0)":::"memory");
  float rli[16];
  #pragma unroll
  for(int r=0;r<16;++r)rli[r]=__builtin_amdgcn_rcpf(wsf[32+crow(r,hi)]);
  bf16*Ow=O+(rowbase+q0+wid*QBLK)*PO;
  { bf16*stg=(bf16*)(shm+LDS_OST)+wid*2048;
    #pragma unroll
    for(int h2=0;h2<(DV2?2:1);++h2){
    #pragma unroll
    for(int r=0;r<16;++r){const int orow=crow(r,hi);
      #pragma unroll
      for(int d0=0;d0<2;++d0)stg[orow*64+d0*32+r32]=__float2bfloat16(o[2*h2+d0][r]*rli[r]);}
    asm volatile("s_waitcnt lgkmcnt(0)":::"memory");
    #pragma unroll
    for(int i=0;i<4;++i){const int row=i*8+(lane>>3),ch=lane&7; const u32x4 v=*(const u32x4*)(stg+row*64+ch*8); ATTN_STORE16(Ow+(long)row*PO+64*h2+ch*8,v);}
    asm volatile("s_waitcnt lgkmcnt(0)":::"memory"); } }
  asm volatile("s_waitcnt lgkmcnt(0)\n\ts_barrier":::"memory");
  #undef DMA_K
  #undef QF
  #undef DMA_V
  #undef CMASK
  #undef START
  #undef RESC
  #undef ROT
}
constexpr int ATTN_LDS_BYTES=LDS_BYTES;
#undef SBAR
#undef WAIT_BAR
}

constexpr int NWAVES = 8;
constexpr int BATCH = 4, SEQ = 4096, NTOK = BATCH * SEQ, D = 1024, DEPTH = 2;
constexpr int INC = 3332, PROJ_P = 3328, NIN = 3584;
constexpr int FFD = 2816, NGUD = 2 * FFD, NE = 8, FFE = 3584, NGUE = 2 * FFE, PLE = 256;
constexpr int MP_MAX = 2 * NTOK + NE * 256;
constexpr float EPS = 1e-6f;
constexpr int C_QA = 0, C_KA = 512, C_VA = 1024, C_QB = 1536, C_KB = 1792, C_VB = 2048, C_QC = 2304, C_KC = 2560, C_VC = 2816, C_GC = 3072;

constexpr size_t MiB = 1u << 20, KiB = 1u << 10;
constexpr size_t WS_CTL = 0, CTL_ZERO_BYTES = 32 * KiB;
constexpr size_t WS_STATS0 = 1 * MiB, WS_STATS1 = 2 * MiB;
constexpr size_t WS_LOGF = 3 * MiB;
constexpr size_t WS_RCOS = 3 * MiB + 256 * KiB, WS_RSIN = 3 * MiB + 768 * KiB;
constexpr size_t WS_E12 = 4 * MiB + 256 * KiB, WS_G12 = WS_E12 + 128 * KiB, WS_POS = WS_G12 + 128 * KiB;
constexpr size_t WS_DST = WS_POS + 128 * KiB, WS_GSORT = WS_DST + 256 * KiB;
static_assert(WS_GSORT + 256 * KiB <= 6 * MiB, "small region");
constexpr size_t WS_WIN1 = 6 * MiB, WS_WOUT1 = WS_WIN1 + 7 * MiB, WS_PG1 = WS_WOUT1 + 2 * MiB, WS_PPW1 = WS_PG1 + 2 * MiB, WS_P1 = WS_PPW1 + 512 * KiB;
constexpr size_t WS_MGU = WS_P1 + 8 * MiB, WS_MD = WS_MGU + 112 * MiB, WS_HB = WS_MD + 56 * MiB;
constexpr size_t WS_PROJ = WS_HB + 32 * MiB, WS_OA = WS_PROJ + 104 * MiB, WS_OCAT = WS_OA + 32 * MiB;
constexpr size_t WS_ACTD = WS_PROJ, WS_PP = WS_OA;
constexpr size_t WS_WIN0 = WS_OCAT + 32 * MiB, WS_WOUT0 = WS_WIN0 + 7 * MiB, WS_DGU = WS_WOUT0 + 2 * MiB, WS_DD = WS_DGU + 11 * MiB, WS_PG0 = WS_DD + 5632 * KiB, WS_PPW0 = WS_PG0 + 2 * MiB, WS_P0 = WS_PPW0 + 512 * KiB;
constexpr size_t WS_H8 = WS_MD + 28 * MiB;
constexpr size_t WS_ACTE = WS_HB;
constexpr size_t WS_XS = WS_ACTE + (size_t)MP_MAX * FFE * 2;
constexpr size_t WS_END = WS_XS + (size_t)MP_MAX * D * 2;
static_assert(WS_P0 + 8 * MiB <= WS_XS && WS_MD + 56 * MiB == WS_HB && (size_t)NTOK * PROJ_P * 2 == 104 * MiB && (size_t)NIN * D * 2 == 7 * MiB, "d_ws map");
static_assert((size_t)NGUD * D * 2 == 11 * MiB && (size_t)D * FFD * 2 == 5632 * KiB && (size_t)NE * NGUE * D * 2 == 112 * MiB && (size_t)NE * D * FFE * 2 == 56 * MiB, "d_ws map 2");
static_assert((4096 + 3456) * 4 <= (int)CTL_ZERO_BYTES, "barrier words inside the per-call memset");
constexpr int CW_TMO = 0, CW_Q = 64  , CW_CNT = 1024  , CW_BAR = 4096, CW_TS = 2048  ;

constexpr int RING_OFF = 0, RING_BYTES = 131072;
constexpr int LDSCTL_OFF = RING_BYTES, MISC_OFF = LDSCTL_OFF + 320, PT_OFF = LDSCTL_OFF + 512, RED_OFF = LDSCTL_OFF + 1024  ;
constexpr int LDS_BYTES = 147456;
static_assert(MISC_OFF + 128 <= LDS_BYTES, "LDS map");
#define GAS __attribute__((address_space(1)))
#define LAS __attribute__((address_space(3)))
typedef unsigned short bf16;
typedef unsigned v4u __attribute__((ext_vector_type(4)));
typedef float f32x4 __attribute__((ext_vector_type(4)));
typedef short bf16x8 __attribute__((ext_vector_type(8)));
typedef GAS unsigned gu32;
typedef GAS unsigned long long gu64;
#define RLX_AGENT __ATOMIC_RELAXED, __HIP_MEMORY_SCOPE_AGENT
#define LDS_WAIT() asm volatile("s_waitcnt lgkmcnt(0)" ::: "memory")
#define VM_WAIT() asm volatile("s_waitcnt vmcnt(0)" ::: "memory")
__device__ __forceinline__ unsigned long long rt() { return __builtin_amdgcn_s_memrealtime(); }
__device__ __forceinline__ unsigned f2bf(float f) { unsigned u = __builtin_bit_cast(unsigned, f); return (u + 0x7fffu + ((u >> 16) & 1u)) >> 16; }
__device__ __forceinline__ unsigned pk2(float lo, float hi) { return f2bf(lo) | (f2bf(hi) << 16); }

#define XB_TMO      128
#define XB_XCNT(j)  (256  + 64 * (j))
#define XB_XSUB(j)  (1280 + 64 * (j))
#define XB_XGEN(j)  (2304 + 64 * (j))
#define XB_TOP      3328
#define XB_TOPGEN   3392
#define XCD_BAR_WORDS 3456
#define XB_SPIN_CAP (1u << 18)

__device__ __forceinline__ unsigned xb_ld(unsigned* p)              { return __hip_atomic_load(p, __ATOMIC_RELAXED, __HIP_MEMORY_SCOPE_AGENT); }
__device__ __forceinline__ unsigned xb_add(unsigned* p, unsigned v) { return __hip_atomic_fetch_add(p, v, __ATOMIC_RELAXED, __HIP_MEMORY_SCOPE_AGENT); }
__device__ __forceinline__ unsigned xb_xcc_id() { return (unsigned)__builtin_amdgcn_s_getreg((3 << 11) | 20) & 0xFu; }
#define XB_SPIN(cond, bar) do { unsigned _sp = 0; while (cond) { __builtin_amdgcn_s_sleep(1); \
    if ((++_sp & 255u) == 0u) { if (xb_ld(&(bar)[XB_TMO])) break; if (_sp > XB_SPIN_CAP) { atomicAdd(&(bar)[XB_TMO], 1u); break; } } } } while (0)

struct XcdBarrier {
    unsigned* bar; unsigned x;
    volatile LAS unsigned* st;
};

__device__ __forceinline__ XcdBarrier xcd_barrier_post(unsigned* bar, volatile LAS unsigned* st) {
    XcdBarrier b; b.bar = bar; b.x = xb_xcc_id(); b.st = st;
    if (threadIdx.x == 0) (void)xb_add(&bar[XB_XCNT(b.x)], 1u);
    return b;
}
__device__ __forceinline__ void xcd_barrier_complete(unsigned* bar, unsigned x, unsigned& nloc, unsigned& nx) {
    const unsigned G = gridDim.x * gridDim.y * gridDim.z;
    unsigned sum, cnt, mine, sp = 0u;
    for (;;) {
        sum = 0u; cnt = 0u; mine = 0u;
#pragma unroll 1
        for (unsigned j = 0; j < 16; ++j) { const unsigned c = xb_ld(&bar[XB_XCNT(j)]); sum += c; cnt += (c > 0u) ? 1u : 0u; mine = (j == x) ? c : mine; }
        if (sum == G) break;
        __builtin_amdgcn_s_sleep(1);
        if ((++sp & 255u) == 0u) { if (xb_ld(&bar[XB_TMO])) break; if (sp > XB_SPIN_CAP) { atomicAdd(&bar[XB_TMO], 1u); break; } }
    }
    nloc = mine > 0u ? mine : 1u; nx = cnt > 0u ? cnt : 1u;
}

__device__ __attribute__((noinline)) void xcd_barrier(const XcdBarrier b, const int tid_) {
    asm volatile("s_waitcnt vmcnt(0)" ::: "memory");
    __syncthreads();
    if (tid_ == 0) {
        unsigned* bar = b.bar;
        __builtin_amdgcn_s_waitcnt(0);
        unsigned nloc = b.st[0], nx = b.st[1];
        if (nloc == 0u) { xcd_barrier_complete(bar, b.x, nloc, nx); b.st[0] = nloc; b.st[1] = nx; }
        const unsigned old = xb_add(&bar[XB_XSUB(b.x)], 1u);
        const unsigned gen = old / nloc;
        if (old + 1u == (gen + 1u) * nloc) {
            __builtin_amdgcn_fence(__ATOMIC_RELEASE, "agent");
            asm volatile("s_waitcnt vmcnt(0)" ::: "memory");
            const unsigned og = xb_add(&bar[XB_TOP], 1u);
            const unsigned tg = og / nx;
            if (og + 1u == (tg + 1u) * nx) xb_add(&bar[XB_TOPGEN], 1u);
            else XB_SPIN(xb_ld(&bar[XB_TOPGEN]) == tg, bar);
            __builtin_amdgcn_fence(__ATOMIC_ACQUIRE, "agent");
            xb_add(&bar[XB_XGEN(b.x)], 1u);
            asm volatile("s_waitcnt vmcnt(0)" ::: "memory");
        } else {
            XB_SPIN(xb_ld(&bar[XB_XGEN(b.x)]) == gen, bar);
            __builtin_amdgcn_fence(__ATOMIC_ACQUIRE, "agent");
            asm volatile("s_waitcnt vmcnt(0)" ::: "memory");
        }
    }
    __syncthreads();
}

using pg8::bf_lo; using pg8::bf_hi;
struct Frame {
    LAS unsigned char* lds; char* ldsg;
    volatile LAS unsigned* MISC;
    gu32* ctl; unsigned char* ws; float* out;
    int tid, lane, wave;
    int vcu, G;
};
__device__ __forceinline__ const float* in_ptr(const Frame& F, int k) {
    const volatile LAS unsigned* pt = (const volatile LAS unsigned*)(F.lds + PT_OFF); const unsigned lo = __builtin_amdgcn_readfirstlane(pt[2 * k]), hi = __builtin_amdgcn_readfirstlane(pt[2 * k + 1]);
    return (const float*)(((unsigned long long)hi << 32) | lo);
}
__device__ __forceinline__ float wave_sum(float v) {
#pragma unroll
    for (int o = 1; o < 64; o <<= 1) v += __shfl_xor(v, o);
    return v;
}
struct TrDesc { const float* src; const float* gain; bf16* dst; int Nsrc, K; float f8scale; };
__device__ __forceinline__ void tr_load(const TrDesc& t, f32x4 (&v)[8], int lane) {
#pragma unroll
    for (int i = 0; i < 8; ++i) v[i] = *(const GAS f32x4*)(t.src + (size_t)(8 * i + (lane >> 3)) * t.Nsrc + 4 * (lane & 7));
}
__device__ __forceinline__ void tr_store(const TrDesc& t, const f32x4 (&v)[8], LAS float* scr, int lane) {
#pragma unroll
    for (int i = 0; i < 8; ++i) { const int kk = 8 * i + (lane >> 3); f32x4 x = v[i]; if (t.gain) x = x * t.gain[kk]; LAS float* s = scr + kk * 33 + 4 * (lane & 7); s[0] = x[0]; s[1] = x[1]; s[2] = x[2]; s[3] = x[3]; }
    LDS_WAIT(); asm volatile("" ::: "memory");
    const int c = lane & 7;
    if (t.f8scale != 0.f) {
#pragma unroll
        for (int j = 0; j < 4; ++j) { const int n = (lane >> 3) + 8 * j; const LAS float* s = scr + (8 * c) * 33 + n; const float q = t.f8scale;
            const f32x4 a0 = (f32x4){s[0 * 33] * q, s[1 * 33] * q, s[2 * 33] * q, s[3 * 33] * q}, a1 = (f32x4){s[4 * 33] * q, s[5 * 33] * q, s[6 * 33] * q, s[7 * 33] * q};
            *(GAS unsigned long long*)((unsigned char*)t.dst + (size_t)n * t.K + 8 * c) = pg8::pack8_fp8(a0, a1); }
    } else {
#pragma unroll
        for (int j = 0; j < 4; ++j) { const int n = (lane >> 3) + 8 * j; const LAS float* s = scr + (8 * c) * 33 + n;
            v4u o; o.x = pk2(s[0 * 33], s[1 * 33]); o.y = pk2(s[2 * 33], s[3 * 33]); o.z = pk2(s[4 * 33], s[5 * 33]); o.w = pk2(s[6 * 33], s[7 * 33]);
            *(GAS v4u*)(t.dst + (size_t)n * t.K + 8 * c) = o; }
    }
    LDS_WAIT(); asm volatile("" ::: "memory");
}
struct Args { const float* in[24]; float* out; unsigned char* ws; int ph_lo, ph_hi; };

__device__ __forceinline__ void convert_items(Frame& F, const int it0, const int stride, const int itEnd) {
    LAS float* scr = (LAS float*)(F.lds + RING_OFF + F.wave * 16384);
    unsigned char* ws = F.ws;
    const float* norm_mix = in_ptr(F, 2); const float* w_in = in_ptr(F, 3); const float* w_out = in_ptr(F, 11); const float* norm_ffn = in_ptr(F, 12);
    const float* dwg = in_ptr(F, 13); const float* dwu = in_ptr(F, 14); const float* dwd = in_ptr(F, 15);
    const float* mwg = in_ptr(F, 17); const float* mwu = in_ptr(F, 18); const float* mwd = in_ptr(F, 19);
    const float* ple_norm = in_ptr(F, 20); const float* ple_gate = in_ptr(F, 21); const float* ple_proj = in_ptr(F, 22);
    constexpr int I_IN = (NIN / 32) * (D / 64), I_OUT = (D / 32) * (D / 64), I_DGU = (NGUD / 32) * (D / 64), I_DD = (D / 32) * (FFD / 64), I_PG = I_OUT, I_PP = (D / 32) * (PLE / 64);
    constexpr int I_MGU1 = (NGUE / 32) * (D / 64), I_MD1 = (D / 32) * (FFE / 64);
    constexpr int NITEMS = 2 * I_IN + 2 * I_OUT + I_DGU + I_DD + 2 * I_PG + 2 * I_PP + NE * I_MGU1 + NE * I_MD1;
    auto desc = [&](int it) -> TrDesc {
        int r = it; TrDesc t; t.f8scale = 0.f;
        if (r < 2 * I_IN) { const int L = r / I_IN; r -= L * I_IN; const int ng = NIN / 32, kb = r / ng, grp = r % ng, pn = grp >> 3, gi = grp & 7;
            int sc; if (pn <= 8) sc = 32 * grp; else if (pn == 9 || pn == 10) sc = (pn == 9 ? 2308 : 2564) + 64 * (gi & 3) + 32 * (gi >> 2); else if (pn <= 12) sc = 32 * grp + 4; else sc = 2304;
            t.Nsrc = INC; t.K = D; t.src = w_in + (size_t)L * D * INC + (size_t)(64 * kb) * INC + sc; t.gain = norm_mix + L * D + 64 * kb; t.dst = (bf16*)(ws + (L ? WS_WIN1 : WS_WIN0)) + (size_t)(32 * grp) * D + 64 * kb; return t; } r -= 2 * I_IN;
        if (r < 2 * I_OUT) { const int L = r / I_OUT; r -= L * I_OUT; const int ng = D / 32, kb = r / ng, grp = r % ng;
            t.Nsrc = D; t.K = D; t.src = w_out + (size_t)L * D * D + (size_t)(64 * kb) * D + 32 * grp; t.gain = nullptr; t.dst = (bf16*)(ws + (L ? WS_WOUT1 : WS_WOUT0)) + (size_t)(32 * grp) * D + 64 * kb; return t; } r -= 2 * I_OUT;
        if (r < I_DGU) { const int ng = NGUD / 32, kb = r / ng, grp = r % ng, pn = grp >> 3, gi = grp & 7;
            t.Nsrc = FFD; t.K = D; t.src = ((gi >> 2) ? dwu : dwg) + (size_t)(64 * kb) * FFD + 128 * pn + 32 * (gi & 3); t.gain = norm_ffn + 64 * kb; t.dst = (bf16*)(ws + WS_DGU) + (size_t)(32 * grp) * D + 64 * kb; return t; } r -= I_DGU;
        if (r < I_DD) { const int ng = D / 32, kb = r / ng, grp = r % ng;
            t.Nsrc = D; t.K = FFD; t.src = dwd + (size_t)(64 * kb) * D + 32 * grp; t.gain = nullptr; t.dst = (bf16*)(ws + WS_DD) + (size_t)(32 * grp) * FFD + 64 * kb; return t; } r -= I_DD;
        if (r < 2 * I_PG) { const int L = r / I_PG; r -= L * I_PG; const int ng = D / 32, kb = r / ng, grp = r % ng;
            t.Nsrc = D; t.K = D; t.src = ple_gate + (size_t)L * D * D + (size_t)(64 * kb) * D + 32 * grp; t.gain = ple_norm + L * D + 64 * kb; t.dst = (bf16*)(ws + (L ? WS_PG1 : WS_PG0)) + (size_t)(32 * grp) * D + 64 * kb; return t; } r -= 2 * I_PG;
        if (r < 2 * I_PP) { const int L = r / I_PP; r -= L * I_PP; const int ng = D / 32, kb = r / ng, grp = r % ng;
            t.Nsrc = D; t.K = PLE; t.src = ple_proj + (size_t)L * PLE * D + (size_t)(64 * kb) * D + 32 * grp; t.gain = nullptr; t.dst = (bf16*)(ws + (L ? WS_PPW1 : WS_PPW0)) + (size_t)(32 * grp) * PLE + 64 * kb; return t; } r -= 2 * I_PP;
        if (r < NE * I_MGU1) { const int e = r / I_MGU1; r -= e * I_MGU1; const int ng = NGUE / 32, kb = r / ng, grp = r % ng, pn = grp >> 3, gi = grp & 7;
            t.Nsrc = FFE; t.K = D; t.src = ((gi >> 2) ? mwu : mwg) + (size_t)e * D * FFE + (size_t)(64 * kb) * FFE + 128 * pn + 32 * (gi & 3); t.gain = nullptr; t.f8scale = 32.f; t.dst = (bf16*)(ws + WS_MGU + (size_t)e * NGUE * D + (size_t)(32 * grp) * D + 64 * kb); return t; } r -= NE * I_MGU1;
        { const int e = r / I_MD1; r -= e * I_MD1; const int ng = D / 32, kb = r / ng, grp = r % ng;
            t.Nsrc = D; t.K = FFE; t.src = mwd + (size_t)e * FFE * D + (size_t)(64 * kb) * D + 32 * grp; t.gain = nullptr; t.f8scale = 64.f; t.dst = (bf16*)(ws + WS_MD + (size_t)e * D * FFE + (size_t)(32 * grp) * FFE + 64 * kb); return t; }
    };
    {
        f32x4 va[8], vb[8]; int it = it0; TrDesc ta, tb;
        if (it < itEnd) { ta = desc(it); tr_load(ta, va, F.lane); }
        while (it < itEnd) {
            const int i2 = it + stride; if (i2 < itEnd) { tb = desc(i2); tr_load(tb, vb, F.lane); }
            tr_store(ta, va, scr, F.lane);
            if (i2 >= itEnd) break;
            const int i3 = i2 + stride; if (i3 < itEnd) { ta = desc(i3); tr_load(ta, va, F.lane); }
            tr_store(tb, vb, scr, F.lane);
            it = i3;
        }
    }
}
constexpr int CV_SMALL = 2 * ((NIN / 32) * (D / 64)) + 2 * ((D / 32) * (D / 64)) + (NGUD / 32) * (D / 64) + (D / 32) * (FFD / 64) + 2 * ((D / 32) * (D / 64)) + 2 * ((D / 32) * (PLE / 64));
constexpr int CV_MOE = NE * ((NGUE / 32) * (D / 64)) + NE * ((D / 32) * (FFE / 64));
#ifndef MK_CV_PER_WAVE
#define MK_CV_PER_WAVE 14
#endif
constexpr int CV_SLOTS = 3, CV_BLOCKS = 128, CV_PER_WAVE = MK_CV_PER_WAVE, CV_INSLOTS = CV_SLOTS * CV_BLOCKS * NWAVES * CV_PER_WAVE;
static_assert(CV_INSLOTS <= CV_MOE, "expert weight items: the first CV_INSLOTS in the slots, the rest in the prologue");
__device__ __forceinline__ void convert_slot(Frame& F, int slot, int bid) {
    if (bid < 256 - CV_BLOCKS) return;
    const int first = CV_SMALL + ((slot * CV_BLOCKS + (bid - (256 - CV_BLOCKS))) * NWAVES + F.wave) * CV_PER_WAVE;
    convert_items(F, first, 1, first + CV_PER_WAVE);
    __syncthreads();
}
__device__ __forceinline__ void p0_prologue(Frame& F, const Args& a) {
    const int gw = F.vcu * NWAVES + F.wave, NGW = F.G * NWAVES;
    unsigned char* ws = F.ws;
#ifdef MK_CONV_IN_PROLOGUE
    convert_items(F, gw, NGW, CV_SMALL + CV_MOE);
#else
    convert_items(F, gw, NGW, CV_SMALL);
    convert_items(F, CV_SMALL + (F.G == 256 ? CV_INSLOTS : 0) + gw, NGW, CV_SMALL + CV_MOE);
#endif
    for (int i = gw * 64 + F.lane; i < SEQ * 32; i += NGW * 64) { const int pos = i >> 5, d = i & 31;
        const double inv = exp2((double)d * (-13.287712379549449 / 32.0)); double ang = (double)pos * inv; ang -= 6.283185307179586 * rint(ang * 0.15915494309189535);
        ((float*)(ws + WS_RCOS))[i] = __cosf((float)ang); ((float*)(ws + WS_RSIN))[i] = __sinf((float)ang); }
    { const float* p = in_ptr(F, 1); const size_t n8 = (size_t)DEPTH * NTOK * PLE / 8, half8 = (size_t)NTOK * PLE / 8;
      for (size_t i = (size_t)gw * 64 + F.lane; i < n8; i += (size_t)NGW * 64) { const f32x4 v0 = ((const f32x4*)p)[2 * i], v1 = ((const f32x4*)p)[2 * i + 1];
          v4u o; o.x = pk2(v0[0], v0[1]); o.y = pk2(v0[2], v0[3]); o.z = pk2(v1[0], v1[1]); o.w = pk2(v1[2], v1[3]);
          if (i < half8) ((v4u*)(ws + WS_P0))[i] = o; else ((v4u*)(ws + WS_P1))[i - half8] = o; } }
    { const float* x = in_ptr(F, 0); bf16* hb = (bf16*)(ws + WS_HB); float* st = (float*)(ws + WS_STATS0);
      for (int m0 = gw; m0 < NTOK; m0 += 2 * NGW) {
          f32x4 xv[2][4];
#pragma unroll
          for (int u = 0; u < 2; ++u) { if (m0 + u * NGW >= NTOK) continue; const GAS f32x4* xr = (const GAS f32x4*)(x + (size_t)(m0 + u * NGW) * D) + F.lane;
#pragma unroll
              for (int j = 0; j < 4; ++j) xv[u][j] = xr[64 * j]; }
#pragma unroll
          for (int u = 0; u < 2; ++u) { const int m = m0 + u * NGW; if (m >= NTOK) continue; GAS unsigned long long* o8 = (GAS unsigned long long*)(hb + (size_t)m * D) + F.lane; float s = 0.f;
#pragma unroll
              for (int j = 0; j < 4; ++j) { const f32x4 v = xv[u][j]; const unsigned w0 = pk2(v[0], v[1]), w1 = pk2(v[2], v[3]);
                  const float q0 = bf_lo(w0), q1 = bf_hi(w0), q2 = bf_lo(w1), q3 = bf_hi(w1); s += (q0 * q0 + q1 * q1) + (q2 * q2 + q3 * q3);
                  o8[64 * j] = (unsigned long long)w0 | ((unsigned long long)w1 << 32); }
              s = wave_sum(s); if (F.lane < 4) st[(size_t)m * 4 + F.lane] = (F.lane == 0) ? s : 0.f; } } }
}

namespace ret {
constexpr int QP = 72, VP = 136;
constexpr int OFF_Q = 0, OFF_K = OFF_Q + 128 * QP * 2, OFF_VT = OFF_K + 128 * QP * 2, OFF_KD = OFF_VT + 64 * VP * 2, OFF_AS = OFF_KD + 64 * VP * 2, OFF_ST = OFF_AS + 128 * VP * 2, BYTES = OFF_ST + 2 * 64 * QP * 2;
static_assert(BYTES <= RING_BYTES, "retention LDS");
typedef LAS unsigned short lbf;
__device__ __forceinline__ bf16x8 ld8(const lbf* p) { return *(const LAS bf16x8*)p; }
__device__ __forceinline__ void unit(Frame& F, const int tid, int b, int h, int seg, const bf16* proj, bf16* ocat, const float* ret_gn) {
    const int lane = tid & 63, w = __builtin_amdgcn_readfirstlane(tid >> 6), l15 = lane & 15, q4 = lane >> 4;
    lbf* Qs = (lbf*)(F.lds + OFF_Q); lbf* Ks = (lbf*)(F.lds + OFF_K); lbf* Vt = (lbf*)(F.lds + OFF_VT); lbf* Kd = (lbf*)(F.lds + OFF_KD); lbf* As = (lbf*)(F.lds + OFF_AS); lbf* St = (lbf*)(F.lds + OFF_ST);
    const float l2g = log2f(1.f - exp2f(-5.f - (float)h));
    const float cdec = exp2f(128.f * l2g);
    const size_t rowb = (size_t)b * SEQ;
    const bf16* qg = proj + C_QC + 64 * h; const bf16* kg = proj + C_KC + 64 * h; const bf16* vg = proj + C_VC + 64 * h; const bf16* gg = proj + C_GC + 64 * h;
    v4u rq[2], rk[2], rv[2];
#define RET_LOAD(c) do { _Pragma("unroll") for (int i = 0; i < 2; ++i) { const int p = tid + 512 * i, row = p >> 3, c8 = p & 7; const size_t go = (rowb + (size_t)(c) * 128 + row) * PROJ_P + 8 * c8; \
        if ((c) >= c0) rq[i] = *(const GAS v4u*)(qg + go); rk[i] = *(const GAS v4u*)(kg + go); rv[i] = *(const GAS v4u*)(vg + go); } } while (0)
    const int c0 = 16 * seg, c1 = c0 + 16;
    rq[0] = rq[1] = (v4u){0u, 0u, 0u, 0u};
    RET_LOAD(0);
    f32x4 st[2];
    st[0] = (f32x4){0.f, 0.f, 0.f, 0.f}; st[1] = st[0];
    for (int i = tid; i < 64 * QP / 2; i += 512) ((LAS unsigned*)St)[i] = 0u;
#pragma unroll 1
    for (int c = 0; c < c1; ++c) {
        const bool full = c >= c0;
        __syncthreads();
#pragma unroll
        for (int i = 0; i < 2; ++i) { const int p = tid + 512 * i, row = p >> 3, c8 = p & 7;
            if (full) { *(LAS v4u*)(Qs + row * QP + 8 * c8) = rq[i]; *(LAS v4u*)(Ks + row * QP + 8 * c8) = rk[i]; }
            const float kd = __builtin_amdgcn_exp2f((float)(127 - row) * l2g);
            const unsigned kw[4] = {rk[i].x, rk[i].y, rk[i].z, rk[i].w}, vw[4] = {rv[i].x, rv[i].y, rv[i].z, rv[i].w};
#pragma unroll
            for (int e = 0; e < 4; ++e) { Vt[(8 * c8 + 2 * e) * VP + row] = (unsigned short)(vw[e] & 0xffffu); Vt[(8 * c8 + 2 * e + 1) * VP + row] = (unsigned short)(vw[e] >> 16);
                Kd[(8 * c8 + 2 * e) * VP + row] = (unsigned short)f2bf(bf_lo(kw[e]) * kd); Kd[(8 * c8 + 2 * e + 1) * VP + row] = (unsigned short)f2bf(bf_hi(kw[e]) * kd); } }
        if (c + 1 < c1) RET_LOAD(c + 1);
        __syncthreads();
        const lbf* Stc = St + (c & 1) * 64 * QP; lbf* Stn = St + ((c + 1) & 1) * 64 * QP;
        f32x4 o1[4], o2[4];
        if (full) {
        bf16x8 qa[2]; qa[0] = ld8(Qs + (16 * w + l15) * QP + 8 * q4); qa[1] = ld8(Qs + (16 * w + l15) * QP + 32 + 8 * q4);
#pragma unroll 1
        for (int nt = 0; nt <= w; ++nt) {
            f32x4 s = (f32x4){0.f, 0.f, 0.f, 0.f};
            s = __builtin_amdgcn_mfma_f32_16x16x32_bf16(qa[0], ld8(Ks + (16 * nt + l15) * QP + 8 * q4), s, 0, 0, 0);
            s = __builtin_amdgcn_mfma_f32_16x16x32_bf16(qa[1], ld8(Ks + (16 * nt + l15) * QP + 32 + 8 * q4), s, 0, 0, 0);
#pragma unroll
            for (int i = 0; i < 4; ++i) { const int dt = (16 * w + 4 * q4 + i) - (16 * nt + l15); const float v = dt >= 0 ? s[i] * __builtin_amdgcn_exp2f((float)dt * l2g) : 0.f;
                As[(16 * w + 4 * q4 + i) * VP + 16 * nt + l15] = (unsigned short)f2bf(v); } }
        if ((w & 1) == 0) {
#pragma unroll
            for (int i = 0; i < 4; ++i) As[(16 * w + 4 * q4 + i) * VP + 16 * (w + 1) + l15] = 0; }
        LDS_WAIT();
#pragma unroll
        for (int nv = 0; nv < 4; ++nv) { o1[nv] = (f32x4){0.f, 0.f, 0.f, 0.f}; o2[nv] = o1[nv]; }
#pragma unroll 1
        for (int ks = 0; ks <= (w >> 1); ++ks) { const bf16x8 af = ld8(As + (16 * w + l15) * VP + 32 * ks + 8 * q4);
#pragma unroll
            for (int nv = 0; nv < 4; ++nv) o1[nv] = __builtin_amdgcn_mfma_f32_16x16x32_bf16(af, ld8(Vt + (16 * nv + l15) * VP + 32 * ks + 8 * q4), o1[nv], 0, 0, 0); }
#pragma unroll
        for (int ks = 0; ks < 2; ++ks)
#pragma unroll
            for (int nv = 0; nv < 4; ++nv) o2[nv] = __builtin_amdgcn_mfma_f32_16x16x32_bf16(qa[ks], ld8(Stc + (16 * nv + l15) * QP + 32 * ks + 8 * q4), o2[nv], 0, 0, 0);
        }
#pragma unroll
        for (int i = 0; i < 2; ++i) { const int j = 2 * w + i, tv = j >> 2, td = j & 3; f32x4 u = (f32x4){0.f, 0.f, 0.f, 0.f};
#pragma unroll
            for (int ks = 0; ks < 4; ++ks) u = __builtin_amdgcn_mfma_f32_16x16x32_bf16(ld8(Vt + (16 * tv + l15) * VP + 32 * ks + 8 * q4), ld8(Kd + (16 * td + l15) * VP + 32 * ks + 8 * q4), u, 0, 0, 0);
            st[i] = st[i] * cdec + u;
#pragma unroll
            for (int e = 0; e < 4; ++e) Stn[(16 * tv + 4 * q4 + e) * QP + 16 * td + l15] = (unsigned short)f2bf(st[i][e]); }
        if (full) {
#pragma unroll
        for (int i = 0; i < 4; ++i) { const int j = 16 * w + 4 * q4 + i; const float qd = __builtin_amdgcn_exp2f((float)(j + 1) * l2g);
            float v[4], s = 0.f;
#pragma unroll
            for (int nv = 0; nv < 4; ++nv) { v[nv] = o1[nv][i] + qd * o2[nv][i]; s += v[nv]; }
            s += __shfl_xor(s, 1); s += __shfl_xor(s, 2); s += __shfl_xor(s, 4); s += __shfl_xor(s, 8);
            const float mu = s * (1.f / 64.f); float s2 = 0.f;
#pragma unroll
            for (int nv = 0; nv < 4; ++nv) { v[nv] -= mu; s2 += v[nv] * v[nv]; }
            s2 += __shfl_xor(s2, 1); s2 += __shfl_xor(s2, 2); s2 += __shfl_xor(s2, 4); s2 += __shfl_xor(s2, 8);
            const float rs = __builtin_amdgcn_rsqf(s2 * (1.f / 64.f) + EPS);
            const size_t tok = rowb + (size_t)c * 128 + j;
#pragma unroll
            for (int nv = 0; nv < 4; ++nv) { const int ch = 16 * nv + l15; const float g = bf_lo((unsigned)gg[tok * PROJ_P + ch]);
                ocat[tok * D + 768 + 64 * h + ch] = (bf16)f2bf(v[nv] * rs * ret_gn[64 * h + ch] * g * pg8::fast_sigmoid(g)); } }
        }
    }
    __syncthreads();
#undef RET_LOAD
}
}

__device__ __forceinline__ void fox_bias(Frame& F, const float* logf, int b, int h, int n, LAS float* kb) {
    LAS float* red = (LAS float*)(F.lds + LDSCTL_OFF);
    const int t0 = 8 * F.tid; float p[8]; float run = 0.f;
#pragma unroll
    for (int i = 0; i < 8; ++i) { const float v = (t0 + i < n) ? logf[((size_t)b * SEQ + t0 + i) * 4 + h] : 0.f; run += v; p[i] = run; }
    float inc = run;
#pragma unroll
    for (int o = 1; o < 64; o <<= 1) { const float y = __shfl_up(inc, o); if (F.lane >= o) inc += y; }
    if (F.lane == 63) red[F.wave] = inc;
    __syncthreads();
    float woff = 0.f, tot = 0.f;
#pragma unroll
    for (int k = 0; k < 8; ++k) { const float x = red[k]; if (k < F.wave) woff += x; tot += x; }
    const float base = woff + inc - run;
    if (t0 < n) {
#pragma unroll
        for (int i = 0; i < 8; ++i) kb[t0 + i] = (tot - (base + p[i])) * pg8::LOG2E;
    }
    __syncthreads();
}
constexpr int MIX_UNITS = 16 + 16 * 80;
constexpr int KB_OFF = attn_body::ATTN_LDS_BYTES;
static_assert(KB_OFF + 16384 <= RING_BYTES && KB_OFF % 16 == 0, "attention LDS + bias array");
__device__ __forceinline__ int mixer_grab(Frame& F, int word) {
    if (F.tid == 0) F.MISC[0] = __hip_atomic_fetch_add((unsigned*)(F.ctl + word), 1u, __ATOMIC_RELAXED, __HIP_MEMORY_SCOPE_AGENT);
    __syncthreads();
    const int u = __builtin_amdgcn_readfirstlane((int)F.MISC[0]);
    __syncthreads();
    return u;
}
__device__ __forceinline__ void mixer_phase(Frame& F, const Args& a, int layer) {
    unsigned char* ws = F.ws; const bf16* proj = (const bf16*)(ws + WS_PROJ); bf16* oa = (bf16*)(ws + WS_OA); bf16* ocat = (bf16*)(ws + WS_OCAT);
    const float* logf = (const float*)(ws + WS_LOGF); const float* ret_gn = in_ptr(F, 10) + layer * 256;
    char* lds = F.ldsg;
#ifndef MIXSEL
#define MIXSEL 7
#endif
#ifndef MIXDUP
#define MIXDUP 0
#endif
#define LOOP_RET(QW) { asm volatile("" : "+v"(F.tid)); const int t1 = F.tid; for (;;) { const int u = mixer_grab(F, (QW)); if (u >= 32) break; ret::unit(F, t1, (u >> 2) & 3, u & 3, 1 - (u >> 4), proj, ocat, ret_gn); } }
#define LOOP_A(QW) { asm volatile("" : "+v"(F.tid)); const int t2 = F.tid; for (;;) { const int u = mixer_grab(F, (QW)); if (u >= 512) break; \
        const int qb = 15 - (u >> 5), w = u & 31, b = w >> 3, j = w & 7;     \
        attn_body::attn_unit<8, false, true>(b, qb, (const attn_body::bf16*)(proj + C_QA + 64 * j), (const attn_body::bf16*)(proj + C_KA + 64 * j), (const attn_body::bf16*)(proj + C_VA + 128 * (j >> 1)), \
                                       (attn_body::bf16*)(oa + 128 * j), lds, (const LAS float*)nullptr, t2); } }
#define LOOP_B(QW) { asm volatile("" : "+v"(F.tid)); const int t3 = F.tid; for (;;) { const int u = mixer_grab(F, (QW)); if (u >= 256) break; \
        const int qb = 15 - (u >> 4), w = u & 15, b = w >> 2, h = w & 3; \
        LAS float* kb = (LAS float*)(F.lds + KB_OFF); \
        fox_bias(F, logf, b, h, 256 * qb + 256, kb); \
        attn_body::attn_unit<8, true, false>(b, qb, (const attn_body::bf16*)(proj + C_QB + 64 * h), (const attn_body::bf16*)(proj + C_KB + 64 * h), (const attn_body::bf16*)(proj + C_VB + 64 * h), \
                                      (attn_body::bf16*)(ocat + 512 + 64 * h), lds, (const LAS float*)kb, t3); } }
    const int qw = CW_Q + 64 * (3 * layer);
    if (MIXSEL & 1) LOOP_RET(qw)
    if (MIXSEL & 4) LOOP_B(qw + 128)
    if (MIXSEL & 2) LOOP_A(qw + 64)
#if MIXDUP & 1
    LOOP_RET(qw + 64 * 6)
#endif
#if MIXDUP & 2
    LOOP_A(qw + 64 * 7)
#endif
#if MIXDUP & 4
    LOOP_B(qw + 64 * 8)
#endif
#undef LOOP_RET
#undef LOOP_A
#undef LOOP_B
}
__device__ __forceinline__ void combine_phase(Frame& F, const Args& a, int layer) {
    unsigned char* ws = F.ws; const bf16* oa = (const bf16*)(ws + WS_OA); bf16* ocat = (bf16*)(ws + WS_OCAT);
    const int gw = F.vcu * NWAVES + F.wave, NGW = F.G * NWAVES;
    const float lam_init = 0.8f - 0.6f * expf(-0.3f * (float)layer);
    const float lam = expf(wave_sum(in_ptr(F, 5)[layer * 64 + F.lane] * in_ptr(F, 6)[layer * 64 + F.lane])) - expf(wave_sum(in_ptr(F, 7)[layer * 64 + F.lane] * in_ptr(F, 8)[layer * 64 + F.lane])) + lam_init;
    const int hd = F.lane >> 4, i16 = F.lane & 15;
    const float* sg = in_ptr(F, 9) + layer * 128 + 8 * i16; float g[8];
#pragma unroll
    for (int e = 0; e < 8; ++e) g[e] = sg[e] * (1.f - lam_init);
    for (int m0 = gw; m0 < NTOK; m0 += 2 * NGW) {
        v4u w1[2], w2[2];
#pragma unroll
        for (int u = 0; u < 2; ++u) { const int m = m0 + u * NGW; if (m >= NTOK) continue; w1[u] = *(const GAS v4u*)(oa + (size_t)m * D + 256 * hd + 8 * i16); w2[u] = *(const GAS v4u*)(oa + (size_t)m * D + 256 * hd + 128 + 8 * i16); }
#pragma unroll
        for (int u = 0; u < 2; ++u) { const int m = m0 + u * NGW; if (m >= NTOK) continue;
            const unsigned a1[4] = {w1[u].x, w1[u].y, w1[u].z, w1[u].w}, a2[4] = {w2[u].x, w2[u].y, w2[u].z, w2[u].w}; float d[8], ss = 0.f;
#pragma unroll
            for (int e = 0; e < 4; ++e) { d[2 * e] = bf_lo(a1[e]) - lam * bf_lo(a2[e]); d[2 * e + 1] = bf_hi(a1[e]) - lam * bf_hi(a2[e]); ss += d[2 * e] * d[2 * e] + d[2 * e + 1] * d[2 * e + 1]; }
            ss += __shfl_xor(ss, 1); ss += __shfl_xor(ss, 2); ss += __shfl_xor(ss, 4); ss += __shfl_xor(ss, 8);
            const float r = __builtin_amdgcn_rsqf(ss * (1.f / 128.f) + EPS);
            v4u o; o.x = pk2(d[0] * r * g[0], d[1] * r * g[1]); o.y = pk2(d[2] * r * g[2], d[3] * r * g[3]); o.z = pk2(d[4] * r * g[4], d[5] * r * g[5]); o.w = pk2(d[6] * r * g[6], d[7] * r * g[7]);
            *(GAS v4u*)(ocat + (size_t)m * D + 128 * hd + 8 * i16) = o; }
    }
}
__device__ __forceinline__ void router_phase(Frame& F, const Args& a, const bf16* h) {
    unsigned char* ws = F.ws; const float* gain = in_ptr(F, 12) + D; const float* router = in_ptr(F, 16);
    LAS float* R = (LAS float*)(F.lds + RING_OFF);
    LAS int* lcnt = (LAS int*)(F.lds + RING_OFF + 32768); LAS int* gbase = lcnt + 8; LAS int* rowe = lcnt + 16; LAS int* rowp = rowe + 128; LAS float* rowg = (LAS float*)(rowp + 128);
    for (int i = F.tid; i < D * NE; i += 512) R[(i & 7) * D + (i >> 3)] = gain[i >> 3] * router[i];
    const int nblk = NTOK / 64;
    for (int blk = F.vcu; blk < nblk; blk += F.G) {
        if (F.tid < 8) lcnt[F.tid] = 0;
        __syncthreads();
#pragma unroll 1
        for (int rr = 0; rr < 8; ++rr) { const int lr = F.wave * 8 + rr, m = blk * 64 + lr;
            const GAS unsigned long long* xr = (const GAS unsigned long long*)(h + (size_t)m * D) + F.lane; float lg[8]; float ss = 0.f;
#pragma unroll
            for (int e = 0; e < 8; ++e) lg[e] = 0.f;
#pragma unroll
            for (int j = 0; j < 4; ++j) { const unsigned long long pw = xr[64 * j]; const f32x4 v = (f32x4){bf_lo((unsigned)pw), bf_hi((unsigned)pw), bf_lo((unsigned)(pw >> 32)), bf_hi((unsigned)(pw >> 32))}; ss += (v[0] * v[0] + v[1] * v[1]) + (v[2] * v[2] + v[3] * v[3]);
#pragma unroll
                for (int e = 0; e < 8; ++e) { const f32x4 rr = *(const LAS f32x4*)(R + e * D + 256 * j + 4 * F.lane); lg[e] += (v[0] * rr[0] + v[1] * rr[1]) + (v[2] * rr[2] + v[3] * rr[3]); } }
            ss = wave_sum(ss); const float rs = 1.f / sqrtf(ss * (1.f / D) + EPS);
#pragma unroll
            for (int e = 0; e < 8; ++e) lg[e] = wave_sum(lg[e]) * rs;
            int i1 = 0; float v1 = lg[0];
#pragma unroll
            for (int e = 1; e < 8; ++e) if (lg[e] > v1) { v1 = lg[e]; i1 = e; }
            int i2 = -1; float v2 = -INFINITY;
#pragma unroll
            for (int e = 0; e < 8; ++e) if (e != i1 && lg[e] > v2) { v2 = lg[e]; i2 = e; }
            const float g2 = 1.f / (1.f + expf(v1 - v2)), g1 = 1.f - g2;
            if (F.lane == 0) { rowe[2 * lr] = i1; rowe[2 * lr + 1] = i2; rowg[2 * lr] = g1; rowg[2 * lr + 1] = g2;
                rowp[2 * lr] = __hip_atomic_fetch_add(lcnt + i1, 1, __ATOMIC_RELAXED, __HIP_MEMORY_SCOPE_WORKGROUP); rowp[2 * lr + 1] = __hip_atomic_fetch_add(lcnt + i2, 1, __ATOMIC_RELAXED, __HIP_MEMORY_SCOPE_WORKGROUP); }
        }
        __syncthreads();
        if (F.tid < 8) gbase[F.tid] = (int)__hip_atomic_fetch_add((unsigned*)(F.ctl + CW_CNT + 64 * F.tid), (unsigned)lcnt[F.tid], __ATOMIC_RELAXED, __HIP_MEMORY_SCOPE_AGENT);
        __syncthreads();
        if (F.tid < 128) { const int m2 = blk * 128 + F.tid; const int e = rowe[F.tid];
            ((int*)(ws + WS_E12))[m2] = e; ((float*)(ws + WS_G12))[m2] = rowg[F.tid]; ((int*)(ws + WS_POS))[m2] = gbase[e] + rowp[F.tid]; }
        __syncthreads();
    }
}
__device__ __forceinline__ void moe_tiles(Frame& F, int (&tb)[9]) {
    int acc = 0;
#pragma unroll
    for (int e = 0; e < 8; ++e) { tb[e] = acc; const int c = __builtin_amdgcn_readfirstlane((int)__hip_atomic_load((unsigned*)(F.ctl + CW_CNT + 64 * e), __ATOMIC_RELAXED, __HIP_MEMORY_SCOPE_AGENT)); acc += (c + 255) >> 8; }
    tb[8] = acc;
}
__device__ __forceinline__ void gather_phase(Frame& F, const Args& a, const bf16* h) {
    unsigned char* ws = F.ws; const float* gain = in_ptr(F, 12) + D;
    bf16* xs = (bf16*)(ws + WS_XS); int* dst = (int*)(ws + WS_DST); float* gsort = (float*)(ws + WS_GSORT);
    const int* e12 = (const int*)(ws + WS_E12); const float* g12 = (const float*)(ws + WS_G12); const int* pos = (const int*)(ws + WS_POS);
    int tb[9]; moe_tiles(F, tb);
    const int gw = F.vcu * NWAVES + F.wave, NGW = F.G * NWAVES;
#pragma unroll
    for (int e = 0; e < 8; ++e) { const int c = (int)__hip_atomic_load((unsigned*)(F.ctl + CW_CNT + 64 * e), __ATOMIC_RELAXED, __HIP_MEMORY_SCOPE_AGENT);
        const int lo = tb[e] * 256 + c, hi = tb[e + 1] * 256; for (int r = lo + gw * 64 + F.lane; r < hi; r += NGW * 64) { dst[r] = -1; gsort[r] = 0.f; } }
    f32x4 gv[4];
#pragma unroll
    for (int j = 0; j < 4; ++j) gv[j] = ((const GAS f32x4*)gain)[F.lane + 64 * j];
    for (int m = gw; m < NTOK; m += NGW) {
        const GAS unsigned long long* xr = (const GAS unsigned long long*)(h + (size_t)m * D) + F.lane; f32x4 v[4]; float ss = 0.f;
#pragma unroll
        for (int j = 0; j < 4; ++j) { const unsigned long long pw = xr[64 * j]; v[j] = (f32x4){bf_lo((unsigned)pw), bf_hi((unsigned)pw), bf_lo((unsigned)(pw >> 32)), bf_hi((unsigned)(pw >> 32))}; ss += (v[j][0] * v[j][0] + v[j][1] * v[j][1]) + (v[j][2] * v[j][2] + v[j][3] * v[j][3]); }
        ss = wave_sum(ss); const float rs = 1.f / sqrtf(ss * (1.f / D) + EPS);
        const int e1 = e12[2 * m], e2 = e12[2 * m + 1];
        int r1 = 0, r2 = 0;
#pragma unroll
        for (int e = 0; e < 8; ++e) { if (e == e1) r1 = tb[e] * 256; if (e == e2) r2 = tb[e] * 256; }
        r1 += pos[2 * m]; r2 += pos[2 * m + 1];
        GAS unsigned* o1 = (GAS unsigned*)((unsigned char*)xs + (size_t)r1 * D) + F.lane; GAS unsigned* o2 = (GAS unsigned*)((unsigned char*)xs + (size_t)r2 * D) + F.lane;
#pragma unroll
        for (int j = 0; j < 4; ++j) { const f32x4 y = v[j] * rs * gv[j]; unsigned pk = 0; pk = __builtin_amdgcn_cvt_pk_fp8_f32(y[0], y[1], pk, false); pk = __builtin_amdgcn_cvt_pk_fp8_f32(y[2], y[3], pk, true); o1[64 * j] = pk; o2[64 * j] = pk; }
        if (F.lane == 0) { dst[r1] = 2 * m; dst[r2] = 2 * m + 1; gsort[r1] = g12[2 * m]; gsort[r2] = g12[2 * m + 1]; }
    }
}
__device__ __forceinline__ void moe_combine_phase(Frame& F, const Args& a, float* stats_out, bf16* hb) {
    unsigned char* ws = F.ws; const bf16* y = (const bf16*)(ws + WS_XS);
    const int gw = F.vcu * NWAVES + F.wave, NGW = F.G * NWAVES;
    for (int m0 = gw; m0 < NTOK; m0 += 2 * NGW) {
        unsigned long long p0[2][4], p1[2][4], p2[2][4];
#pragma unroll
        for (int u = 0; u < 2; ++u) { const int m = m0 + u * NGW; if (m >= NTOK) continue; const GAS unsigned long long* y1 = (const GAS unsigned long long*)(y + (size_t)(2 * m) * D) + F.lane; const GAS unsigned long long* y2 = y1 + D / 4;
            const GAS unsigned long long* h8 = (const GAS unsigned long long*)(hb + (size_t)m * D) + F.lane;
#pragma unroll
            for (int j = 0; j < 4; ++j) { p0[u][j] = h8[64 * j]; p1[u][j] = y1[64 * j]; p2[u][j] = y2[64 * j]; } }
#pragma unroll
        for (int u = 0; u < 2; ++u) { const int m = m0 + u * NGW; if (m >= NTOK) continue; GAS unsigned long long* o8 = (GAS unsigned long long*)(hb + (size_t)m * D) + F.lane; float s = 0.f;
#pragma unroll
            for (int j = 0; j < 4; ++j) { const unsigned long long q0_ = p0[u][j], q1_ = p1[u][j], q2_ = p2[u][j]; f32x4 v;
                v[0] = bf_lo((unsigned)q0_) + (bf_lo((unsigned)q1_) + bf_lo((unsigned)q2_)); v[1] = bf_hi((unsigned)q0_) + (bf_hi((unsigned)q1_) + bf_hi((unsigned)q2_));
                v[2] = bf_lo((unsigned)(q0_ >> 32)) + (bf_lo((unsigned)(q1_ >> 32)) + bf_lo((unsigned)(q2_ >> 32))); v[3] = bf_hi((unsigned)(q0_ >> 32)) + (bf_hi((unsigned)(q1_ >> 32)) + bf_hi((unsigned)(q2_ >> 32)));
                const unsigned w0 = pk2(v[0], v[1]), w1 = pk2(v[2], v[3]); const float q0 = bf_lo(w0), q1 = bf_hi(w0), q2 = bf_lo(w1), q3 = bf_hi(w1);
                s += (q0 * q0 + q1 * q1) + (q2 * q2 + q3 * q3);
                o8[64 * j] = (unsigned long long)w0 | ((unsigned long long)w1 << 32); }
            s = wave_sum(s); if (F.lane < 4) stats_out[(size_t)m * 4 + F.lane] = (F.lane == 0) ? s : 0.f; }
    }
}
__device__ __forceinline__ void final_phase(Frame& F, const Args& a) {
    float* h = F.out; const bf16* hbp = (const bf16*)(F.ws + WS_HB); const float* gain = in_ptr(F, 23);
    const int gw = F.vcu * NWAVES + F.wave, NGW = F.G * NWAVES;
    float dscale = 1.f;
#ifdef TSDIAG
    { const unsigned long long* ts = (const unsigned long long*)(F.ctl + CW_TS); dscale = 1.f + (float)(ts[TS_A1] - ts[TS_A0]) * (0.01f / 3000.f); }
#endif
    f32x4 gv[4];
#pragma unroll
    for (int j = 0; j < 4; ++j) gv[j] = ((const GAS f32x4*)gain)[F.lane + 64 * j];
    for (int m0 = gw; m0 < NTOK; m0 += 2 * NGW) {
        unsigned long long pw[2][4];
#pragma unroll
        for (int u = 0; u < 2; ++u) { if (m0 + u * NGW >= NTOK) continue; const GAS unsigned long long* xr = (const GAS unsigned long long*)(hbp + (size_t)(m0 + u * NGW) * D) + F.lane;
#pragma unroll
            for (int j = 0; j < 4; ++j) pw[u][j] = xr[64 * j]; }
#pragma unroll
        for (int u = 0; u < 2; ++u) { if (m0 + u * NGW >= NTOK) continue; GAS f32x4* hr = (GAS f32x4*)(h + (size_t)(m0 + u * NGW) * D) + F.lane; f32x4 v[4]; float ss = 0.f;
#pragma unroll
            for (int j = 0; j < 4; ++j) { const unsigned long long q = pw[u][j]; v[j] = (f32x4){bf_lo((unsigned)q), bf_hi((unsigned)q), bf_lo((unsigned)(q >> 32)), bf_hi((unsigned)(q >> 32))}; ss += (v[j][0] * v[j][0] + v[j][1] * v[j][1]) + (v[j][2] * v[j][2] + v[j][3] * v[j][3]); }
            ss = wave_sum(ss); const float rs = 1.f / sqrtf(ss * (1.f / D) + EPS);
#pragma unroll
            for (int j = 0; j < 4; ++j) hr[64 * j] = v[j] * rs * gv[j] * dscale; }
    }
#ifdef TSDIAG
    if (gw == 0 && F.lane == 0) { const unsigned long long* ts = (const unsigned long long*)(F.ctl + CW_TS); h[0] = (float)(ts[TS_B1] - ts[TS_B0]) * (0.01f / 30.f); }
#endif
}

__device__ __forceinline__ int launder2() { int n = 2; asm volatile("" : "+s"(n)); return n; }
constexpr int N_PHASES = 26;
__global__ void __launch_bounds__(NWAVES * 64, 2) mega_fwd(Args args) {
    extern __shared__ __attribute__((aligned(16))) unsigned char lds[];
    Frame F;
    F.lds = (LAS unsigned char*)lds; F.ldsg = (char*)lds;
    F.MISC = (volatile LAS unsigned*)(F.lds + MISC_OFF);
    F.tid = threadIdx.x; F.lane = F.tid & 63; F.wave = __builtin_amdgcn_readfirstlane(F.tid >> 6);
    F.G = gridDim.x; { const int bx = blockIdx.x; F.vcu = (F.G % 8 == 0) ? (bx % 8) * (F.G / 8) + bx / 8 : bx; }
    F.ws = args.ws; F.out = F.out;
    F.ctl = (gu32*)(F.ws + WS_CTL);
    for (int u = F.tid; u < (LDS_BYTES - LDSCTL_OFF) / 4; u += NWAVES * 64) ((LAS unsigned*)(F.lds + LDSCTL_OFF))[u] = 0u;
    __syncthreads();
    if (F.tid == 0) {
#pragma unroll
        for (int i = 0; i < 24; ++i) ((LAS unsigned long long*)(F.lds + PT_OFF))[i] = (unsigned long long)args.in[i]; }
    __syncthreads();
    int lo = args.ph_lo, hi = args.ph_hi, bid = (int)blockIdx.x; size_t zoff = 0; int nst = 0;
#define one (lo == 0 && hi == N_PHASES)
    XcdBarrier bar; bar.bar = (unsigned*)(F.ctl + CW_BAR); bar.x = 0; bar.st = nullptr;
    if (one) bar = xcd_barrier_post((unsigned*)(F.ctl + CW_BAR), F.MISC + 8);
#define IN(k) (lo <= (k) && (k) < hi)
#ifndef MK_PHMASK
#define MK_PHMASK 0xffffffffu
#endif
#define EN(n) (((MK_PHMASK) >> (n)) & 1u)
#ifndef DUPK
#define DUPK -1
#endif
#define NREP(k) ((DUPK) == (k) ? launder2() : 1)
#ifndef DUPBAR
#define DUPBAR 1
#endif
#ifdef TSDIAG
#define STAMP() do { if (bid == 0 && F.tid == 0) ((unsigned long long*)(F.ctl + CW_TS))[nst] = __builtin_amdgcn_s_memrealtime(); ++nst; } while (0)
#else
#define STAMP() do {} while (0)
#endif
#define SEAM() do { if (one) { for (int b_ = 0; b_ < DUPBAR; ++b_) xcd_barrier(bar, F.tid); } STAMP(); } while (0)
#define FRESH() do { asm volatile("" : "+v"(F.tid)); asm volatile("" : "+s"(zoff), "+s"(lo), "+s"(hi), "+s"(bid), "+s"(F.G), "+s"(F.vcu)); F.ws = args.ws + zoff; F.out = (float*)((char*)args.out + zoff); F.lane = F.tid & 63; F.wave = __builtin_amdgcn_readfirstlane(F.tid >> 6); F.ctl = (gu32*)(F.ws + WS_CTL); } while (0)
#define hb ((bf16*)(L == 0 ? (void*)(F.ws + WS_HB) : (void*)F.out))
#define hbn ((bf16*)(L == 0 ? (void*)F.out : (void*)(F.ws + WS_HB)))
#define st0 ((float*)(F.ws + WS_STATS0))
#define st1 ((float*)(F.ws + WS_STATS1))
#define ST_CUR (sb ? st1 : st0)
#define ST_NXT (sb ? st0 : st1)

    STAMP();
    FRESH(); if (EN(0) && IN(0)) { for (int r_ = 0; r_ < NREP(0); ++r_) p0_prologue(F, args); SEAM(); }
    int sb = 0;
#pragma unroll
    for (int L = 0; L < DEPTH; ++L) {
        const int pb = 1 + 12 * L;
        FRESH(); if (EN(1) && IN(pb + 0)) {
            pg8::Gemm g{hb, (const pg8::bf16_t*)(F.ws + (L ? WS_WIN1 : WS_WIN0)), NTOK, NIN, D, 0}; pg8::StaticOrder S; S.init(NTOK, NIN, F.G, bid);
            pg8::EpiIn E{(pg8::bf16_t*)(F.ws + WS_PROJ), (float*)(F.ws + WS_LOGF), ST_CUR, (const float*)(F.ws + WS_RCOS), (const float*)(F.ws + WS_RSIN), in_ptr(F, 4) + 4 * L, attn_body::C2};
            if (DUPK == 1) { pg8::EpiBf16<0> EJ{(pg8::bf16_t*)(F.ws + WS_PROJ), PROJ_P, nullptr, 0, 0, 1.f}; pg8::gemm_phase<pg8::EpiBf16<0>, pg8::StaticOrder, true, true>(F.lds + RING_OFF, g, S, EJ, F.tid); }
            pg8::gemm_phase<pg8::EpiIn, pg8::StaticOrder, true, true>(F.lds + RING_OFF, g, S, E, F.tid);
#ifndef MK_CONV_IN_PROLOGUE
            if (F.G == 256) convert_slot(F, L == 0 ? 0 : 2, bid);
#endif
            SEAM(); }
        FRESH(); if (EN(2) && IN(pb + 1)) { mixer_phase(F, args, L); SEAM(); }
        FRESH(); if (EN(3) && IN(pb + 2)) { for (int r_ = 0; r_ < NREP(3); ++r_) combine_phase(F, args, L); SEAM(); }
        FRESH(); if (EN(4) && IN(pb + 3)) {
            pg8::Gemm g{(const pg8::bf16_t*)(F.ws + WS_OCAT), (const pg8::bf16_t*)(F.ws + (L ? WS_WOUT1 : WS_WOUT0)), NTOK, D, D, 0}; pg8::StaticOrder S; S.init(NTOK, D, F.G, bid);
            pg8::EpiRes<0> E{hb, hb, ST_NXT, nullptr, nullptr, nullptr, 1.f, (LAS float*)(F.lds + RED_OFF)};
            pg8::gemm_phase<pg8::EpiRes<0>, pg8::StaticOrder, true, true>(F.lds + RING_OFF, g, S, E, F.tid);
            if (DUPK == 4) { pg8::EpiBf16<0> EJ{(pg8::bf16_t*)(F.ws + WS_OA), D, nullptr, 0, 0, 1.f}; pg8::gemm_phase<pg8::EpiBf16<0>, pg8::StaticOrder, false, true>(F.lds + RING_OFF, g, S, EJ, F.tid); }
            SEAM(); }
        sb ^= 1;
        if (L == 0) {
            FRESH(); if (EN(5) && IN(pb + 4)) {
                pg8::Gemm g{hb, (const pg8::bf16_t*)(F.ws + WS_DGU), NTOK, NGUD, D, 0}; pg8::StaticOrder S; S.init(NTOK, NGUD, F.G, bid);
                pg8::EpiGU<true> E{(pg8::bf16_t*)(F.ws + WS_ACTD), FFD, ST_CUR, 1.f, 1.f};
                for (int r_ = 0; r_ < NREP(5); ++r_) pg8::gemm_phase<pg8::EpiGU<true>, pg8::StaticOrder, true, true>(F.lds + RING_OFF, g, S, E, F.tid);
#ifndef MK_CONV_IN_PROLOGUE
                if (F.G == 256) convert_slot(F, 1, bid);
#endif
                SEAM(); }
            FRESH(); if (EN(6) && IN(pb + 5)) {
                pg8::Gemm g{(const pg8::bf16_t*)(F.ws + WS_ACTD), (const pg8::bf16_t*)(F.ws + WS_DD), NTOK, D, FFD, 0}; pg8::StaticOrder S; S.init(NTOK, D, F.G, bid);
                pg8::EpiRes<0> E{hb, hb, ST_NXT, nullptr, nullptr, nullptr, 1.f, (LAS float*)(F.lds + RED_OFF)};
                pg8::gemm_phase<pg8::EpiRes<0>, pg8::StaticOrder, true, true>(F.lds + RING_OFF, g, S, E, F.tid);
                if (DUPK == 6) { pg8::EpiBf16<0> EJ{(pg8::bf16_t*)(F.ws + WS_OA), D, nullptr, 0, 0, 1.f}; pg8::gemm_phase<pg8::EpiBf16<0>, pg8::StaticOrder, false, true>(F.lds + RING_OFF, g, S, EJ, F.tid); }
                SEAM(); }
        } else {
            FRESH(); if (EN(7) && IN(pb + 4)) { router_phase(F, args, hb); SEAM(); }
            FRESH(); if (EN(8) && IN(pb + 5)) { for (int r_ = 0; r_ < NREP(8); ++r_) gather_phase(F, args, hb); SEAM(); }
            FRESH(); if (EN(9) && IN(pb + 6)) {
                pg8::MoeOrder S; moe_tiles(F, S.tb); S.nM = S.tb[8]; S.nN = NGUE / 256; S.nwg = S.nM * S.nN; S.G = F.G; S.c = bid;
                pg8::Gemm g{(const pg8::bf16_t*)(F.ws + WS_XS), (const pg8::bf16_t*)(F.ws + WS_MGU), MP_MAX, NGUE, D, (size_t)NGUE * D};
                pg8::EpiGU<false, true> E{(pg8::bf16_t*)(F.ws + WS_ACTE), FFE, nullptr, 1.f / 32.f, 4.f};
                if (DUPK == 9) { pg8::gemm_phase<pg8::EpiGU<false, true>, pg8::MoeOrder, true, true, true>(F.lds + RING_OFF, g, S, E, F.tid); SEAM(); }
                pg8::gemm_phase<pg8::EpiGU<false, true>, pg8::MoeOrder, true, true, true>(F.lds + RING_OFF, g, S, E, F.tid);
                SEAM(); }
            FRESH(); if (EN(10) && IN(pb + 7)) {
                pg8::MoeOrder S; moe_tiles(F, S.tb); S.nM = S.tb[8]; S.nN = D / 256; S.nwg = S.nM * S.nN; S.G = F.G; S.c = bid;
                pg8::Gemm g{(const pg8::bf16_t*)(F.ws + WS_ACTE), (const pg8::bf16_t*)(F.ws + WS_MD), MP_MAX, D, FFE, (size_t)D * FFE};
                pg8::EpiMoeDown E{(pg8::bf16_t*)(F.ws + WS_XS), (const int*)(F.ws + WS_DST), (const float*)(F.ws + WS_GSORT), 1.f / 256.f};
                for (int r_ = 0; r_ < NREP(10); ++r_) pg8::gemm_phase<pg8::EpiMoeDown, pg8::MoeOrder, true, true, true>(F.lds + RING_OFF, g, S, E, F.tid);
                SEAM(); }
            FRESH(); if (EN(11) && IN(pb + 8)) { moe_combine_phase(F, args, ST_NXT, hb); SEAM(); }
        }
        sb ^= 1;
        FRESH(); if (EN(12) && IN(pb + 9)) {
            pg8::Gemm g{(const pg8::bf16_t*)(F.ws + (L ? WS_P1 : WS_P0)), (const pg8::bf16_t*)(F.ws + (L ? WS_PPW1 : WS_PPW0)), NTOK, D, PLE, 0}; pg8::StaticOrder S; S.init(NTOK, D, F.G, bid);
            pg8::EpiBf16<0> E{(pg8::bf16_t*)(F.ws + WS_PP), D, nullptr, 0, 0, 1.f};
            for (int r_ = 0; r_ < NREP(12); ++r_) pg8::gemm_phase<pg8::EpiBf16<0>, pg8::StaticOrder, true, true>(F.lds + RING_OFF, g, S, E, F.tid);
            if (!one) {   } }
        FRESH(); if (EN(13) && IN(pb + 10)) {
            pg8::Gemm g{hb, (const pg8::bf16_t*)(F.ws + (L ? WS_PG1 : WS_PG0)), NTOK, D, D, 0}; pg8::StaticOrder S; S.init(NTOK, D, F.G, bid);
            pg8::EpiRes<1> E{hb, hbn, ST_NXT, ST_CUR, (const pg8::bf16_t*)(F.ws + WS_PP), nullptr, 1.f, (LAS float*)(F.lds + RED_OFF)};
            pg8::gemm_phase<pg8::EpiRes<1>, pg8::StaticOrder, true, true>(F.lds + RING_OFF, g, S, E, F.tid);
            if (DUPK == 13) { pg8::EpiBf16<0> EJ{(pg8::bf16_t*)(F.ws + WS_OCAT), D, nullptr, 0, 0, 1.f}; pg8::gemm_phase<pg8::EpiBf16<0>, pg8::StaticOrder, false, true>(F.lds + RING_OFF, g, S, EJ, F.tid); }
            SEAM(); }
        sb ^= 1;
    }
    FRESH(); if (EN(14) && IN(25)) final_phase(F, args);
#undef IN
#undef SEAM
#undef FRESH
#undef one
#undef hb
#undef hbn
#undef st0
#undef st1
}

#ifndef MK_PER_PHASE
#define MK_PER_PHASE 0
#endif
extern "C" void kernel_launch(void* const* d_in, const int* in_sizes, int n_in, void* d_out, int out_size, void* d_ws, size_t ws_size, hipStream_t stream) {
    static int grid = 0;
    if (grid == 0) {
        if (n_in != 24 || in_sizes[0] != NTOK * D || out_size != NTOK * D || ws_size < WS_END) { fprintf(stderr, "kernel_launch: unexpected shapes or workspace (%zu < %zu)\n", ws_size, (size_t)WS_END); grid = -1; return; }
        int dev = 0, cus = 0, per_cu = 0;
        if (hipGetDevice(&dev) != hipSuccess || hipDeviceGetAttribute(&cus, hipDeviceAttributeMultiprocessorCount, dev) != hipSuccess) { grid = -1; return; }
        if (hipFuncSetAttribute((const void*)mega_fwd, hipFuncAttributeMaxDynamicSharedMemorySize, LDS_BYTES) != hipSuccess) { fprintf(stderr, "kernel_launch: hipFuncSetAttribute failed\n"); grid = -1; return; }
        if (hipOccupancyMaxActiveBlocksPerMultiprocessor(&per_cu, (const void*)mega_fwd, NWAVES * 64, LDS_BYTES) != hipSuccess || per_cu < 1) { fprintf(stderr, "kernel_launch: occupancy query says %d\n", per_cu); }
        (void)hipGetLastError();
        grid = cus;
    }
    if (grid < 0) return;
    if (hipMemsetAsync((char*)d_ws + WS_CTL, 0, CTL_ZERO_BYTES, stream) != hipSuccess) return;
    Args a{};
    for (int i = 0; i < 24; ++i) a.in[i] = (const float*)d_in[i];
    a.out = (float*)d_out; a.ws = (unsigned char*)d_ws;
#if MK_PER_PHASE
    for (int p = 0; p < N_PHASES; ++p) { a.ph_lo = p; a.ph_hi = p + 1; hipLaunchKernelGGL(mega_fwd, dim3(grid), dim3(NWAVES * 64), LDS_BYTES, stream, a); }
#else
    a.ph_lo = 0; a.ph_hi = N_PHASES; hipLaunchKernelGGL(mega_fwd, dim3(grid), dim3(NWAVES * 64), LDS_BYTES, stream, a);
#endif
}
```

```cpp
#include <hip/hip_runtime.h>
#include <cstdio>
#include <cstdint>
namespace pg8 {
#define PG8_LAS __attribute__((address_space(3)))
typedef unsigned short bf16_t;
typedef short bf16x8 __attribute__((ext_vector_type(8)));
typedef float f32x4 __attribute__((ext_vector_type(4)));
typedef unsigned u32x4 __attribute__((ext_vector_type(4)));
constexpr int BM = 256, BK = 64, HALF = 128, HTB = HALF * BK * 2  , STAGE_BYTES = 8 * HTB, NXCD = 8, WGM = 8;

__host__ __device__ __forceinline__ int lds_byte(int r, int c) { const int st = (r >> 4) * 2 + (c >> 5), rr = r & 15, cc = c & 31, ob = rr * 64 + cc * 2; return st * 1024 + (ob ^ (((ob >> 9) & 1) << 5)); }
__host__ __device__ __forceinline__ void stage_rc(int b, int& R, int& C) { const int st = b / 1024, sb = b % 1024, swz = sb ^ (((sb >> 9) & 1) << 5); R = (st >> 1) * 16 + swz / 64; C = (st & 1) * 32 + (swz % 64) / 2; }
__host__ __device__ __forceinline__ int perm32(int rho) { const int n = rho >> 4, i = rho & 15; return 8 * (i >> 2) + 4 * n + (i & 3); }

struct Unit { int pm, pn, pe; };
struct Gemm { const bf16_t* A; const bf16_t* Bt; int M, N, K; size_t bstride; };

struct StaticOrder {
    int nM, nN, nwg, G, c;
    __host__ __device__ void init(int M, int N, int G_, int c_) { nM = M / BM; nN = N / BM; nwg = nM * nN; G = G_; c = c_; }
    __host__ __device__ bool next(int i, Unit& u) const {
        const long L = (long)i * G + c; if (L >= nwg) return false;
        int wgid = (int)L; { const int q = nwg / NXCD, r = nwg % NXCD, xcd = wgid % NXCD, off = wgid / NXCD; wgid = (xcd < r ? xcd * (q + 1) : r * (q + 1) + (xcd - r) * q) + off; }
        const int nig = WGM * nN, gid = wgid / nig, fm = gid * WGM, gsz = (nM - fm) < WGM ? (nM - fm) : WGM;
        u.pm = fm + ((wgid % nig) % gsz); u.pn = (wgid % nig) / gsz; u.pe = 0; return true;
    }
    __device__ __forceinline__ void a_ready(const Unit&) const {}
    __device__ __forceinline__ void done(const Unit&) const {}
};

__device__ __forceinline__ unsigned cvt_pk_bf16(float lo, float hi) { unsigned r; asm volatile("v_cvt_pk_bf16_f32 %0, %1, %2" : "=v"(r) : "v"(lo), "v"(hi)); return r; }
typedef float f32x2 __attribute__((ext_vector_type(2)));
__device__ __forceinline__ f32x2 gelu_pk(f32x2 v) {
    const f32x2 av = __builtin_elementwise_abs(v), d = av * 0.2316418882f + 1.0f;
    f32x2 t; t.x = __builtin_amdgcn_rcpf(d.x); t.y = __builtin_amdgcn_rcpf(d.y);
    f32x2 q = t * 0.5307027145f + (-0.7265760135f); q = q * t + 0.7107068705f; q = q * t + (-0.142248368f); q = q * t + 0.127414796f; q = q * t;
    const f32x2 s = (v * v) * (-0.72134752044f);
    f32x2 e; e.x = __builtin_amdgcn_exp2f(s.x); e.y = __builtin_amdgcn_exp2f(s.y);
    const f32x2 m = v * (q * e), r = v - m;
    f32x2 o; o.x = v.x < 0.f ? m.x : r.x; o.y = v.y < 0.f ? m.y : r.y; return o;
}

template <int ACT  > struct EpiBf16 {
    static constexpr bool PERM = true, AFTER_DRAIN = false; static_assert(ACT == 0 || ACT == 1, "EpiBf16: ACT is 0 (none) or 1 (gelu_pk)");
    bf16_t* O; int ldc; const float* bias; int split_cols; size_t split_stride; float scale0;
    __device__ __forceinline__ void operator()(const f32x4 (&acc)[2][2][4][2], const Unit& u, int wr, int wc, int fr, int fq) const {
        const int row0 = u.pm * BM + wr * 64 + fr; int colt = u.pn * BM; bf16_t* base = O;
        float sc = 1.f; if (split_cols) { const int t = colt / split_cols; base += (size_t)t * split_stride; colt -= t * split_cols; if (t == 0) sc = scale0; }
        const int col0 = colt + wc * 32 + 8 * fq, bcol0 = u.pn * BM + wc * 32 + 8 * fq;
        f32x4 bv[2][2];
#pragma unroll
        for (int bj = 0; bj < 2; ++bj)
#pragma unroll
            for (int n = 0; n < 2; ++n) bv[bj][n] = bias ? *(const f32x4*)(bias + bcol0 + bj * HALF + 4 * n) : (f32x4){0.f, 0.f, 0.f, 0.f};
#pragma unroll
        for (int ai = 0; ai < 2; ++ai)
#pragma unroll
            for (int m = 0; m < 4; ++m) { bf16_t* rowp = base + (size_t)(row0 + ai * HALF + m * 16) * ldc + col0;
#pragma unroll
                for (int bj = 0; bj < 2; ++bj) { f32x4 v0 = acc[ai][bj][m][0] + bv[bj][0], v1 = acc[ai][bj][m][1] + bv[bj][1];
                    if (ACT == 1) { f32x2 a = gelu_pk((f32x2){v0[0], v0[1]}), b = gelu_pk((f32x2){v0[2], v0[3]}), c = gelu_pk((f32x2){v1[0], v1[1]}), d = gelu_pk((f32x2){v1[2], v1[3]});
                        v0 = (f32x4){a.x, a.y, b.x, b.y}; v1 = (f32x4){c.x, c.y, d.x, d.y}; }
                    v0 = v0 * sc; v1 = v1 * sc; u32x4 w; w.x = cvt_pk_bf16(v0[0], v0[1]); w.y = cvt_pk_bf16(v0[2], v0[3]); w.z = cvt_pk_bf16(v1[0], v1[1]); w.w = cvt_pk_bf16(v1[2], v1[3]);
                    *(u32x4*)(rowp + bj * HALF) = w; } }
    }
};

typedef int v8i32 __attribute__((ext_vector_type(8))); typedef short s16x16 __attribute__((ext_vector_type(16)));
__device__ __forceinline__ v8i32 cat8(bf16x8 lo, bf16x8 hi) { return __builtin_bit_cast(v8i32, __builtin_shufflevector(lo, hi, 0, 1, 2, 3, 4, 5, 6, 7, 8, 9, 10, 11, 12, 13, 14, 15)); }
__device__ __forceinline__ unsigned long long pack8_fp8(const f32x4 v0, const f32x4 v1) {
    unsigned lo = 0, hi = 0; lo = __builtin_amdgcn_cvt_pk_fp8_f32(v0[0], v0[1], lo, false); lo = __builtin_amdgcn_cvt_pk_fp8_f32(v0[2], v0[3], lo, true);
    hi = __builtin_amdgcn_cvt_pk_fp8_f32(v1[0], v1[1], hi, false); hi = __builtin_amdgcn_cvt_pk_fp8_f32(v1[2], v1[3], hi, true); return (unsigned long long)lo | ((unsigned long long)hi << 32); }
constexpr float RMS_EPS = 1e-6f;
constexpr float LOG2E = 1.4426950408889634f;
__device__ __forceinline__ float fast_sigmoid(float x) { return __builtin_amdgcn_rcpf(1.f + __builtin_amdgcn_exp2f(-x * LOG2E)); }
__device__ __forceinline__ float row_rstd(const float* st, int row) {
    const f32x4 a = *(const f32x4*)(st + (size_t)row * 4);
    return __builtin_amdgcn_rsqf(((a[0] + a[1]) + (a[2] + a[3])) * (1.f / 1024.f) + RMS_EPS);
}
__device__ __forceinline__ u32x4 pack8(const f32x4 v0, const f32x4 v1) { u32x4 w; w.x = cvt_pk_bf16(v0[0], v0[1]); w.y = cvt_pk_bf16(v0[2], v0[3]); w.z = cvt_pk_bf16(v1[0], v1[1]); w.w = cvt_pk_bf16(v1[2], v1[3]); return w; }
__device__ __forceinline__ float bf_lo(unsigned w) { return __builtin_bit_cast(float, w << 16); }
__device__ __forceinline__ float bf_hi(unsigned w) { return __builtin_bit_cast(float, w & 0xffff0000u); }

struct EpiIn {
    static constexpr bool PERM = true, AFTER_DRAIN = false;
    bf16_t* proj; float* logf; const float* stats; const float* rcos; const float* rsin; const float* bfg; float c2;
    __device__ __forceinline__ void operator()(const f32x4 (&acc)[2][2][4][2], const Unit& u, int wr, int wc, int fr, int fq) const {
        const int pn = u.pn; const int row0 = u.pm * BM + wr * 64 + fr;
        float rr[8];
#pragma unroll
        for (int k = 0; k < 8; ++k) rr[k] = row_rstd(stats, row0 + (k >> 2) * HALF + (k & 3) * 16);
        if (pn == 9 || pn == 10) {
            const float s0 = (pn == 10) ? 0.125f : 1.f;
#pragma unroll
            for (int ai = 0; ai < 2; ++ai) {
                f32x4 cv[4][2], sv[4][2];
#pragma unroll
                for (int m = 0; m < 4; ++m) { const int pos = (row0 + ai * HALF + m * 16) & 4095; const f32x4* cp = (const f32x4*)(rcos + pos * 32 + 8 * fq); const f32x4* sp = (const f32x4*)(rsin + pos * 32 + 8 * fq);
                    cv[m][0] = cp[0]; cv[m][1] = cp[1]; sv[m][0] = sp[0]; sv[m][1] = sp[1]; }
#pragma unroll
                for (int m = 0; m < 4; ++m) { const int row = row0 + ai * HALF + m * 16; const float sc = s0 * rr[ai * 4 + m];
                    f32x4 o1[2], o2[2];
#pragma unroll
                    for (int n = 0; n < 2; ++n) { const f32x4 c = cv[m][n], s = sv[m][n], x1 = acc[ai][0][m][n] * sc, x2 = acc[ai][1][m][n] * sc; o1[n] = x1 * c - x2 * s; o2[n] = x1 * s + x2 * c; }
                    bf16_t* dst = proj + (size_t)row * 3328 + 256 * pn + 64 * wc + 8 * fq;
                    *(u32x4*)dst = pack8(o1[0], o1[1]); *(u32x4*)(dst + 32) = pack8(o2[0], o2[1]); }
            }
            return;
        }
#pragma unroll
        for (int ai = 0; ai < 2; ++ai)
#pragma unroll
            for (int m = 0; m < 4; ++m) {
                const int row = row0 + ai * HALF + m * 16; const float r = rr[ai * 4 + m];
                if (pn == 13) {
                    if (wc == 0 && fq == 0) { const f32x4 b = *(const f32x4*)bfg; f32x4 x = acc[ai][0][m][0] * r + b, o;
#pragma unroll
                        for (int i = 0; i < 4; ++i) o[i] = fminf(x[i], 0.f) - log1pf(__expf(-fabsf(x[i])));
                        *(f32x4*)(logf + (size_t)row * 4) = o; }
                } else {
                    const float sc = (pn <= 1 || pn == 6) ? r * c2 : r;
                    bf16_t* dst = proj + (size_t)row * 3328 + 256 * pn + 32 * wc + 8 * fq;
#pragma unroll
                    for (int bj = 0; bj < 2; ++bj) *(u32x4*)(dst + bj * HALF) = pack8(acc[ai][bj][m][0] * sc, acc[ai][bj][m][1] * sc);
                }
            }
    }
};

template <int MODE> struct EpiRes {
    static constexpr bool PERM = true, AFTER_DRAIN = false;
    const bf16_t* hin; bf16_t* hb; float* stats_out; const float* stats_in; const bf16_t* pp; unsigned char* h8; float asc; PG8_LAS float* red;
    __device__ __forceinline__ void operator()(const f32x4 (&acc)[2][2][4][2], const Unit& u, int wr, int wc, int fr, int fq) const {
        const int row0 = u.pm * BM + wr * 64 + fr; const int col0 = u.pn * BM + wc * 32 + 8 * fq;
#pragma unroll
        for (int ai = 0; ai < 2; ++ai)
#pragma unroll
        for (int mp = 0; mp < 4; mp += 2) {
            u32x4 hw[4][2], pw[4][2]; float rr[4];
#pragma unroll
            for (int m = mp; m < mp + 2; ++m) { const int row = row0 + ai * HALF + m * 16;
#pragma unroll
                for (int bj = 0; bj < 2; ++bj) { hw[m][bj] = *(const u32x4*)(hin + (size_t)row * 1024 + col0 + bj * HALF); if (MODE == 1) pw[m][bj] = *(const u32x4*)(pp + (size_t)row * 1024 + col0 + bj * HALF); }
                rr[m] = (MODE == 1) ? row_rstd(stats_in, row) : 1.f; }
#pragma unroll
            for (int m = mp; m < mp + 2; ++m) {
                const int row = row0 + ai * HALF + m * 16; const float r = rr[m];
                float ss = 0.f;
#pragma unroll
                for (int bj = 0; bj < 2; ++bj) {
                    bf16_t* hp = hb + (size_t)row * 1024 + col0 + bj * HALF; const u32x4 hwv = hw[m][bj];
                    f32x4 h0 = (f32x4){bf_lo(hwv.x), bf_hi(hwv.x), bf_lo(hwv.y), bf_hi(hwv.y)}, h1 = (f32x4){bf_lo(hwv.z), bf_hi(hwv.z), bf_lo(hwv.w), bf_hi(hwv.w)};
                    f32x4 a0 = acc[ai][bj][m][0] * asc, a1 = acc[ai][bj][m][1] * asc;
                    if (MODE == 1) { const u32x4 pwv = pw[m][bj];
                        a0[0] = fast_sigmoid(a0[0] * r) * bf_lo(pwv.x); a0[1] = fast_sigmoid(a0[1] * r) * bf_hi(pwv.x); a0[2] = fast_sigmoid(a0[2] * r) * bf_lo(pwv.y); a0[3] = fast_sigmoid(a0[3] * r) * bf_hi(pwv.y);
                        a1[0] = fast_sigmoid(a1[0] * r) * bf_lo(pwv.z); a1[1] = fast_sigmoid(a1[1] * r) * bf_hi(pwv.z); a1[2] = fast_sigmoid(a1[2] * r) * bf_lo(pwv.w); a1[3] = fast_sigmoid(a1[3] * r) * bf_hi(pwv.w); }
                    h0 = h0 + a0; h1 = h1 + a1;
                    const u32x4 ow = pack8(h0, h1); *(u32x4*)hp = ow;
                    if (h8) *(unsigned long long*)(h8 + (size_t)row * 1024 + col0 + bj * HALF) = pack8_fp8(h0, h1);
                    const float q0 = bf_lo(ow.x), q1 = bf_hi(ow.x), q2 = bf_lo(ow.y), q3 = bf_hi(ow.y), q4 = bf_lo(ow.z), q5 = bf_hi(ow.z), q6 = bf_lo(ow.w), q7 = bf_hi(ow.w);
                    ss += ((q0 * q0 + q1 * q1) + (q2 * q2 + q3 * q3)) + ((q4 * q4 + q5 * q5) + (q6 * q6 + q7 * q7));
                }
                ss += __shfl_xor(ss, 16); ss += __shfl_xor(ss, 32);
                if (fq == 0) red[(wr * 64 + ai * HALF + m * 16 + fr) * 4 + wc] = ss;
            }
        }
        asm volatile("s_waitcnt lgkmcnt(0)" ::: "memory"); __builtin_amdgcn_s_barrier();
        { const int t = (wr * 4 + wc) * 64 + fq * 16 + fr; if (t < 256) { const f32x4 v = *(const PG8_LAS f32x4*)(red + 4 * t); stats_out[(size_t)(u.pm * BM + t) * 4 + u.pn] = (v[0] + v[1]) + (v[2] + v[3]); } }
        asm volatile("s_waitcnt lgkmcnt(0)" ::: "memory"); __builtin_amdgcn_s_barrier();
    }
};

template <bool SCALED, bool F8 = false> struct EpiGU {
    static constexpr bool PERM = true, AFTER_DRAIN = false;
    bf16_t* act; int ldact; const float* stats; float isc, osc;
    __device__ __forceinline__ void operator()(const f32x4 (&acc)[2][2][4][2], const Unit& u, int wr, int wc, int fr, int fq) const {
        const int row0 = u.pm * BM + wr * 64 + fr; const int col0 = u.pn * HALF + wc * 32 + 8 * fq;
        float rr[8];
#pragma unroll
        for (int k = 0; k < 8; ++k) rr[k] = SCALED ? row_rstd(stats, row0 + (k >> 2) * HALF + (k & 3) * 16) : 1.f;
#pragma unroll
        for (int ai = 0; ai < 2; ++ai)
#pragma unroll
            for (int m = 0; m < 4; ++m) {
                const int row = row0 + ai * HALF + m * 16; float r = F8 ? isc : 1.f; if (SCALED) r *= rr[ai * 4 + m];
                f32x4 o[2];
#pragma unroll
                for (int n = 0; n < 2; ++n) { const f32x4 g = acc[ai][0][m][n] * r, up = acc[ai][1][m][n] * r;
#pragma unroll
                    for (int i = 0; i < 4; ++i) o[n][i] = g[i] * fast_sigmoid(g[i]) * up[i]; }
                if (F8) *(unsigned long long*)((unsigned char*)act + (size_t)row * ldact + col0) = pack8_fp8(o[0] * osc, o[1] * osc);
                else *(u32x4*)(act + (size_t)row * ldact + col0) = pack8(o[0], o[1]);
            }
    }
};

struct EpiMoeDown {
    static constexpr bool PERM = true, AFTER_DRAIN = false;
    bf16_t* y; const int* dst; const float* gsort; float sc;
    __device__ __forceinline__ void operator()(const f32x4 (&acc)[2][2][4][2], const Unit& u, int wr, int wc, int fr, int fq) const {
        const int row0 = u.pm * BM + wr * 64 + fr; const int col0 = u.pn * BM + wc * 32 + 8 * fq;
        int dd[8]; float gg[8];
#pragma unroll
        for (int k = 0; k < 8; ++k) { const int row = row0 + (k >> 2) * HALF + (k & 3) * 16; dd[k] = dst[row]; gg[k] = gsort[row]; }
#pragma unroll
        for (int ai = 0; ai < 2; ++ai)
#pragma unroll
            for (int m = 0; m < 4; ++m) {
                const int d = dd[ai * 4 + m]; if (d < 0) continue; const float g = gg[ai * 4 + m] * sc;
#pragma unroll
                for (int bj = 0; bj < 2; ++bj) *(u32x4*)(y + (size_t)d * 1024 + col0 + bj * HALF) = pack8(acc[ai][bj][m][0] * g, acc[ai][bj][m][1] * g);
            }
    }
};

struct MoeOrder {
    int nM, nN, nwg, G, c; int tb[9];
    __device__ __forceinline__ bool next(int i, Unit& u) const {
        const long L = (long)i * G + c; if (L >= nwg) return false;
        int wgid = (int)L; { const int q = nwg / NXCD, r = nwg % NXCD, xcd = wgid % NXCD, off = wgid / NXCD; wgid = (xcd < r ? xcd * (q + 1) : r * (q + 1) + (xcd - r) * q) + off; }
        const int nig = WGM * nN, gid = wgid / nig, fm = gid * WGM, gsz = (nM - fm) < WGM ? (nM - fm) : WGM;
        u.pm = fm + ((wgid % nig) % gsz); u.pn = (wgid % nig) / gsz;
        int e = 0;
#pragma unroll
        for (int k = 1; k < 8; ++k) e += (u.pm >= tb[k]) ? 1 : 0;
        u.pe = e; return true;
    }
    __device__ __forceinline__ void a_ready(const Unit&) const {}
    __device__ __forceinline__ void done(const Unit&) const {}
};
template <class Epi, class Sched, bool ALIGN_EPI = false, bool SP2 = false, bool FP8 = false>
__device__ __forceinline__ void gemm_phase(PG8_LAS unsigned char* lds, const Gemm g, const Sched& S, const Epi& E, const int tid) {
    const int wid = __builtin_amdgcn_readfirstlane(tid >> 6), lane = tid & 63, wr = wid >> 2, wc = wid & 3, fr = lane & 15, fq = lane >> 4;
    const int K = g.K, KB = FP8 ? K : 2 * K  , nt = KB / (2 * BK);
    unsigned voffA[2], voffB[2];
#pragma unroll
    for (int i = 0; i < 2; ++i) { int R, C; stage_rc(tid * 16 + i * 8192, R, C); const int Rb = Epi::PERM ? ((R & ~31) + perm32(R & 31)) : R;
        voffA[i] = (unsigned)(R * KB + 2 * C); voffB[i] = (unsigned)(Rb * KB + 2 * C); }
    const size_t kstep = (size_t)(BK * 2);
    const size_t hstep = (size_t)HALF * KB;
    const size_t tstep = 2 * hstep;
    const unsigned ldsw = (unsigned)wid * 1024u;
    const int aoff = lds_byte(wr * 64 + fr, FP8 ? fq * 16 : fq * 8), boff = lds_byte(wc * 32 + fr, FP8 ? fq * 16 : fq * 8); constexpr int KPIECE = FP8 ? 16 : 1024;
#define PG8_SA(b, h) (((b) * 2 + (h)) * HTB)
#define PG8_SB(b, h) ((4 + (b) * 2 + (h)) * HTB)
#define PG8_STAGE(bufoff, gbase, voff) do { _Pragma("unroll") for (int _i = 0; _i < 2; ++_i) \
        __builtin_amdgcn_global_load_lds((const unsigned*)((const char*)(gbase) + (voff)[_i]), (PG8_LAS unsigned*)(lds + (bufoff) + ldsw + _i * 8192), 16, 0, 0); } while (0)
#define PG8_LDA(dst, b, h) do { if constexpr (FP8) { _Pragma("unroll") for (int m = 0; m < 4; ++m) dst##8[m] = *(const PG8_LAS v8i32*)(lds + PG8_SA(b, h) + aoff + m * 2048); } else _Pragma("unroll") for (int m = 0; m < 4; ++m) _Pragma("unroll") for (int k = 0; k < 2; ++k) dst[m][k] = *(const PG8_LAS bf16x8*)(lds + PG8_SA(b, h) + aoff + m * 2048 + k * 1024); } while (0)
#define PG8_LDB(dst, b, h) do { if constexpr (FP8) { _Pragma("unroll") for (int n = 0; n < 2; ++n) dst##8[n] = *(const PG8_LAS v8i32*)(lds + PG8_SB(b, h) + boff + n * 2048); } else _Pragma("unroll") for (int n = 0; n < 2; ++n) _Pragma("unroll") for (int k = 0; k < 2; ++k) dst[n][k] = *(const PG8_LAS bf16x8*)(lds + PG8_SB(b, h) + boff + n * 2048 + k * 1024); } while (0)
#define PG8_MMA(ai, bj, At, Bt) do { __builtin_amdgcn_s_setprio(1); _Pragma("unroll") for (int m = 0; m < 4; ++m) _Pragma("unroll") for (int n = 0; n < 2; ++n) { \
        if constexpr (FP8) { asm volatile("v_mfma_scale_f32_16x16x128_f8f6f4 %0, %1, %2, %0, %3, %3 op_sel_hi:[0,0,0]" : "+v"(acc[ai][bj][m][n]) : "v"(Bt##8[n]), "v"(At##8[m]), "v"(f8one)); } \
        else { _Pragma("unroll") for (int k = 0; k < 2; ++k) acc[ai][bj][m][n] = __builtin_amdgcn_mfma_f32_16x16x32_bf16(Bt[n][k], At[m][k], acc[ai][bj][m][n], 0, 0, 0); } } __builtin_amdgcn_s_setprio(0); } while (0)
#define PG8_WAIT_V(n) asm volatile("s_waitcnt vmcnt(" #n ")" ::: "memory")
#define PG8_WAIT_L(n) asm volatile("s_waitcnt lgkmcnt(" #n ")" ::: "memory")
#define PG8_BAR __builtin_amdgcn_s_barrier()
#define PG8_SCHED __builtin_amdgcn_sched_barrier(0)
    Unit cur, nxt; int ui = 0;
    if (!S.next(0, cur)) return;
    f32x4 acc[2][2][4][2];
#pragma unroll
    for (int a = 0; a < 2; ++a)
#pragma unroll
        for (int b = 0; b < 2; ++b)
#pragma unroll
            for (int m = 0; m < 4; ++m)
#pragma unroll
                for (int n = 0; n < 2; ++n) acc[a][b][m][n] = (f32x4){0.f, 0.f, 0.f, 0.f};
    bf16x8 At[4][2], B0[2][2], B1[2][2]; v8i32 At8[4], B08[2], B18[2]; const int f8one = 0x7f7f7f7f;
    const char* cA = (const char*)g.A + (size_t)cur.pm * tstep; const char* cB = (const char*)g.Bt + (size_t)cur.pn * tstep + (size_t)cur.pe * g.bstride;
    S.a_ready(cur);
    if constexpr (SP2) {
        PG8_STAGE(PG8_SB(0, 0), cB, voffB); PG8_STAGE(PG8_SB(0, 1), cB + hstep, voffB); PG8_STAGE(PG8_SA(0, 0), cA, voffA); PG8_STAGE(PG8_SA(0, 1), cA + hstep, voffA);
        if (wr == 1) PG8_BAR;
        PG8_WAIT_V(2); PG8_BAR;
        PG8_STAGE(PG8_SB(1, 0), cB + kstep, voffB); PG8_STAGE(PG8_SA(1, 0), cA + kstep, voffA); PG8_STAGE(PG8_SB(1, 1), cB + hstep + kstep, voffB);
        PG8_WAIT_V(6); PG8_BAR;
    } else {
        PG8_STAGE(PG8_SB(0, 0), cB, voffB); PG8_STAGE(PG8_SA(0, 0), cA, voffA); PG8_STAGE(PG8_SB(0, 1), cB + hstep, voffB); PG8_STAGE(PG8_SA(0, 1), cA + hstep, voffA);
        if (wr == 1) PG8_BAR;
        PG8_WAIT_V(4); PG8_BAR;
        PG8_STAGE(PG8_SB(1, 0), cB + kstep, voffB); PG8_STAGE(PG8_SA(1, 0), cA + kstep, voffA); PG8_STAGE(PG8_SB(1, 1), cB + hstep + kstep, voffB);
        PG8_WAIT_V(6); PG8_BAR;
    }
    for (;;) {
        const bool has_next = S.next(ui + 1, nxt);
        const char* nA = has_next ? (const char*)g.A + (size_t)nxt.pm * tstep : cA; const char* nB = has_next ? (const char*)g.Bt + (size_t)nxt.pn * tstep + (size_t)nxt.pe * g.bstride : cB;
#pragma unroll 1
        for (int t = 0; t < nt; t += 2) {
            const bool last = (t == nt - 2);
            const char* a1 = cA + (size_t)(t + 1) * kstep;
            const char* a2 = last ? nA : cA + (size_t)(t + 2) * kstep; const char* b2 = last ? nB : cB + (size_t)(t + 2) * kstep;
            const char* a3 = a2 + kstep; const char* b3 = b2 + kstep;
            if (last && has_next) S.a_ready(nxt);
            if constexpr (SP2) {
            PG8_LDB(B0, 0, 0); PG8_LDB(B1, 0, 1); PG8_SCHED; PG8_LDA(At, 0, 0); PG8_STAGE(PG8_SA(1, 1), a1 + hstep, voffA);
            PG8_WAIT_V(8); PG8_WAIT_L(0); PG8_BAR; PG8_MMA(0, 0, At, B0); PG8_MMA(0, 1, At, B1); PG8_BAR; PG8_SCHED;
            PG8_LDA(At, 0, 1); PG8_STAGE(PG8_SB(0, 0), b2, voffB); PG8_STAGE(PG8_SB(0, 1), b2 + hstep, voffB); PG8_STAGE(PG8_SA(0, 0), a2, voffA);
            PG8_WAIT_V(8); PG8_WAIT_L(0); PG8_BAR; PG8_MMA(1, 0, At, B0); PG8_MMA(1, 1, At, B1); PG8_BAR; PG8_SCHED;
            PG8_LDB(B0, 1, 0); PG8_LDB(B1, 1, 1); PG8_SCHED; PG8_LDA(At, 1, 0); PG8_STAGE(PG8_SA(0, 1), a2 + hstep, voffA);
            PG8_WAIT_V(8); PG8_WAIT_L(0); PG8_BAR; PG8_MMA(0, 0, At, B0); PG8_MMA(0, 1, At, B1); PG8_BAR; PG8_SCHED;
            PG8_LDA(At, 1, 1); PG8_STAGE(PG8_SB(1, 0), b3, voffB); PG8_STAGE(PG8_SB(1, 1), b3 + hstep, voffB); PG8_STAGE(PG8_SA(1, 0), a3, voffA);
            PG8_WAIT_V(8); PG8_WAIT_L(0); PG8_BAR; PG8_MMA(1, 0, At, B0); PG8_MMA(1, 1, At, B1); PG8_BAR; PG8_SCHED;
            } else {
            PG8_LDB(B0, 0, 0); PG8_SCHED; PG8_LDA(At, 0, 0); PG8_STAGE(PG8_SA(1, 1), a1 + hstep, voffA);
            PG8_WAIT_L(8); PG8_BAR; PG8_WAIT_L(0); PG8_MMA(0, 0, At, B0); PG8_BAR; PG8_SCHED;
            PG8_LDB(B1, 0, 1); PG8_STAGE(PG8_SB(0, 0), b2, voffB);
            PG8_BAR; PG8_WAIT_L(0); PG8_MMA(0, 1, At, B1); PG8_BAR;
            PG8_LDA(At, 0, 1); PG8_STAGE(PG8_SA(0, 0), a2, voffA);
            PG8_BAR; PG8_WAIT_L(0); PG8_MMA(1, 0, At, B0); PG8_BAR; PG8_SCHED;
            PG8_STAGE(PG8_SB(0, 1), b2 + hstep, voffB);
            PG8_WAIT_V(6); PG8_BAR; PG8_MMA(1, 1, At, B1); PG8_BAR;
            PG8_LDB(B0, 1, 0); PG8_SCHED; PG8_LDA(At, 1, 0); PG8_STAGE(PG8_SA(0, 1), a2 + hstep, voffA);
            PG8_WAIT_L(8); PG8_BAR; PG8_WAIT_L(0); PG8_MMA(0, 0, At, B0); PG8_BAR; PG8_SCHED;
            PG8_LDB(B1, 1, 1); PG8_STAGE(PG8_SB(1, 0), b3, voffB);
            PG8_BAR; PG8_WAIT_L(0); PG8_MMA(0, 1, At, B1); PG8_BAR;
            PG8_LDA(At, 1, 1); PG8_STAGE(PG8_SA(1, 0), a3, voffA);
            PG8_BAR; PG8_WAIT_L(0); PG8_MMA(1, 0, At, B0); PG8_BAR; PG8_SCHED;
            PG8_STAGE(PG8_SB(1, 1), b3 + hstep, voffB);
            PG8_WAIT_V(6); PG8_BAR; PG8_MMA(1, 1, At, B1); PG8_BAR;
            }
        }
        if constexpr (ALIGN_EPI) { if (wr == 0) PG8_BAR; }
        if constexpr (!Epi::AFTER_DRAIN) { if constexpr (FP8) asm volatile("s_nop 15\n\ts_nop 15" ::: "memory"); int t2_ = tid; asm volatile("" : "+v"(t2_)); const int l2_ = t2_ & 63; E(acc, cur, wr, wc, l2_ & 15, l2_ >> 4); S.done(cur); }
        if (!has_next) break;
#pragma unroll
        for (int a = 0; a < 2; ++a)
#pragma unroll
            for (int b = 0; b < 2; ++b)
#pragma unroll
                for (int m = 0; m < 4; ++m)
#pragma unroll
                    for (int n = 0; n < 2; ++n) acc[a][b][m][n] = (f32x4){0.f, 0.f, 0.f, 0.f};
        cur = nxt; cA = nA; cB = nB; ++ui;
        if constexpr (ALIGN_EPI) { if (wr == 1) PG8_BAR; }
    }
    PG8_WAIT_V(0);
    if constexpr (!ALIGN_EPI) { if (wr == 0) PG8_BAR; }
    PG8_BAR;
    if constexpr (Epi::AFTER_DRAIN) { E.fused(acc, cur, wr, wc, fr, fq, lds, wid, lane); S.done(cur); }
#undef PG8_SA
#undef PG8_SB
#undef PG8_STAGE
#undef PG8_LDA
#undef PG8_LDB
#undef PG8_MMA
#undef PG8_WAIT_V
#undef PG8_WAIT_L
#undef PG8_BAR
#undef PG8_SCHED
}
}
#include <hip/hip_bf16.h>
#include <cmath>
namespace attn_body {
using bf16=__hip_bfloat16;
using bf16x8=__attribute__((ext_vector_type(8)))short;
using s16x4=__attribute__((ext_vector_type(4)))short;
using f32x16=__attribute__((ext_vector_type(16)))float;
using u32x4=__attribute__((ext_vector_type(4)))unsigned;
constexpr int BATCH=4,SEQ=4096,D=64,PQ=3328,PKV=3328,PO=1024;
constexpr int NW=8,QBLK=32,QB=QBLK*NW,KVBLK=64,NQB=SEQ/QB;
constexpr int ATTN_UNIT_ROWS=QB; typedef float f32x4_t __attribute__((ext_vector_type(4)));
__device__ __forceinline__ int crow(int r,int hi){return (r&3)+8*(r>>2)+4*hi;}
#define SBAR() __builtin_amdgcn_sched_barrier(0)
__device__ __forceinline__ void cmask(f32x16&p0,f32x16&p1,int jb,int qrel,int hi){
  const float NEG=-INFINITY; int kb=64*jb+4*hi;
  #pragma unroll
  for(int r=0;r<16;++r){int kv=kb+(r&3)+8*(r>>2); if(kv>qrel)p0[r]=NEG; if(kv+32>qrel)p1[r]=NEG;}
}

constexpr int NSLOT=3, SLOTB=8192;
constexpr int VSLOTB=2*SLOTB; constexpr int LDS_K=0, LDS_V=NSLOT*SLOTB, LDS_WS=NSLOT*SLOTB+NSLOT*VSLOTB, LDS_OST=LDS_WS+NW*64*4, LDS_BYTES=LDS_OST+NW*4096;
constexpr float C2=0.125f*1.4426950408889634f;
__device__ __forceinline__ void glds16(const void*gsrc,unsigned lds_dst){unsigned keep;
  asm volatile("s_mov_b32 %0, m0\n\ts_mov_b32 m0, %2\n\ts_nop 0\n\tglobal_load_lds_dwordx4 %1, off\n\ts_mov_b32 m0, %0":"=&s"(keep):"v"(gsrc),"s"(lds_dst):"memory");}
__device__ __forceinline__ float max3f(float a,float b,float c){float r;asm("v_max3_f32 %0, %1, %2, %3":"=v"(r):"v"(a),"v"(b),"v"(c));return r;}
__device__ __forceinline__ float max2f(float a,float b){float r;asm("v_max_f32_e32 %0, %1, %2":"=v"(r):"v"(a),"v"(b));return r;}
__device__ __forceinline__ float fadd_s(float a,float b){float r;asm("v_add_f32_e32 %0, %1, %2":"=v"(r):"v"(a),"v"(b));return r;}
__device__ __forceinline__ float fsub_s(float a,float b){float r;asm("v_sub_f32_e32 %0, %1, %2":"=v"(r):"v"(a),"v"(b));return r;}
typedef float f32x2_t __attribute__((ext_vector_type(2))); typedef __bf16 bf16x2_t __attribute__((ext_vector_type(2)));
__device__ __forceinline__ unsigned cvtpk_s(float lo,float hi){f32x2_t v={lo,hi};bf16x2_t b=__builtin_convertvector(v,bf16x2_t);return __builtin_bit_cast(unsigned,b);}
#define WAIT_BAR(N) asm volatile("s_waitcnt vmcnt(" #N ") lgkmcnt(0)\n\ts_barrier":::"memory")

__device__ __forceinline__ void qkt(f32x16&p0,f32x16&p1,const char*Kslot,const bf16x8*qr,const f32x16&negm,int r32,int hi){
  const char*kb=Kslot+hi*1024+r32*16;
  #pragma unroll
  for(int d0=0;d0<4;++d0){
    const bf16x8 b0=*reinterpret_cast<const bf16x8*>(kb+d0*2048);
    const bf16x8 b1=*reinterpret_cast<const bf16x8*>(kb+d0*2048+512);
    if(d0==0){p0=__builtin_amdgcn_mfma_f32_32x32x16_bf16(b0,qr[0],negm,0,0,0);p1=__builtin_amdgcn_mfma_f32_32x32x16_bf16(b1,qr[0],negm,0,0,0);}
    else{p0=__builtin_amdgcn_mfma_f32_32x32x16_bf16(b0,qr[d0],p0,0,0,0);p1=__builtin_amdgcn_mfma_f32_32x32x16_bf16(b1,qr[d0],p1,0,0,0);}}
}
typedef __attribute__((address_space(3))) const char* lds_cptr;
typedef short v4i16_t __attribute__((ext_vector_type(4)));
__device__ __forceinline__ void kload8(bf16x8*kf,lds_cptr kp){
  kf[0]=*(const __attribute__((address_space(3))) bf16x8*)(kp);      kf[1]=*(const __attribute__((address_space(3))) bf16x8*)(kp+512);
  kf[2]=*(const __attribute__((address_space(3))) bf16x8*)(kp+2048); kf[3]=*(const __attribute__((address_space(3))) bf16x8*)(kp+2560);
  kf[4]=*(const __attribute__((address_space(3))) bf16x8*)(kp+4096); kf[5]=*(const __attribute__((address_space(3))) bf16x8*)(kp+4608);
  kf[6]=*(const __attribute__((address_space(3))) bf16x8*)(kp+6144); kf[7]=*(const __attribute__((address_space(3))) bf16x8*)(kp+6656);
}
__device__ __forceinline__ void kload2(bf16x8*kf,lds_cptr kp,int j){ kf[2*j]=*(const __attribute__((address_space(3))) bf16x8*)(kp+j*2048); kf[2*j+1]=*(const __attribute__((address_space(3))) bf16x8*)(kp+j*2048+512); }
__device__ __forceinline__ s16x4 vtr(lds_cptr p){ return __builtin_bit_cast(s16x4,__builtin_amdgcn_ds_read_tr16_b64_v4i16((__attribute__((address_space(3))) v4i16_t*)p)); }
__device__ __forceinline__ float rowmax(const f32x16&p0,const f32x16&p1){
  float a=max3f(p0[0],p0[1],p1[0]),b=max3f(p0[2],p0[3],p1[1]);a=max3f(a,p1[2],p1[3]);
  #pragma unroll
  for(int r=4;r<16;r+=4){a=max3f(a,p0[r],p0[r+1]);b=max3f(b,p0[r+2],p0[r+3]);a=max3f(a,p1[r],p1[r+1]);b=max3f(b,p1[r+2],p1[r+3]);}
  const float m=max2f(a,b);
  auto rr=__builtin_amdgcn_permlane32_swap(__float_as_uint(m),__float_as_uint(m),false,false);
  return max2f(__uint_as_float(rr[0]),__uint_as_float(rr[1]));
}
__device__ __forceinline__ void pv(f32x16*o,int vb,bf16x8 pa0,bf16x8 pa1,bf16x8 pa2,bf16x8 pa3){
  #pragma unroll
  for(int d0=0;d0<2;++d0){s16x4 lo[4],hi[4];
    #pragma unroll
    for(int ks=0;ks<4;++ks){
      asm volatile("ds_read_b64_tr_b16 %0,%1 offset:%c2":"=&v"(lo[ks]):"v"(vb),"i"(d0*4096+ks*1024):"memory");
      asm volatile("ds_read_b64_tr_b16 %0,%1 offset:%c2":"=&v"(hi[ks]):"v"(vb),"i"(d0*4096+ks*1024+512):"memory");}
    asm volatile("s_waitcnt lgkmcnt(0)":::"memory");SBAR();
    #define PK(k) (bf16x8){lo[k][0],lo[k][1],lo[k][2],lo[k][3],hi[k][0],hi[k][1],hi[k][2],hi[k][3]}
    o[d0]=__builtin_amdgcn_mfma_f32_32x32x16_bf16(pa0,PK(0),o[d0],0,0,0);
    o[d0]=__builtin_amdgcn_mfma_f32_32x32x16_bf16(pa1,PK(1),o[d0],0,0,0);
    o[d0]=__builtin_amdgcn_mfma_f32_32x32x16_bf16(pa2,PK(2),o[d0],0,0,0);
    o[d0]=__builtin_amdgcn_mfma_f32_32x32x16_bf16(pa3,PK(3),o[d0],0,0,0);
    #undef PK
  }
}

#ifndef ATTN_STORE16
#define ATTN_STORE16(p,v) (*(u32x4*)(p)=(v))
#endif
template<int THRL,bool BIAS,bool DV2> __device__ __forceinline__ void attn_unit(int b,int qb,const bf16*Q,const bf16*__restrict__ K,const bf16*__restrict__ V,bf16*O,char*shm,const __attribute__((address_space(3))) float*kbias,const int tid){
  const int lane=tid&63,r32=lane&31,hi=lane>>5; const int wid=__builtin_amdgcn_readfirstlane(tid>>6);
  const long rowbase=(long)b*SEQ; const int q0=qb*QB;
  const bf16*Qw=Q+(rowbase+q0+wid*QBLK)*PQ;
  const bf16*Kh=K+rowbase*PKV,*Vh=V+rowbase*PKV;
  const unsigned lds0=(unsigned)(uintptr_t)shm;
  float*wsf=(float*)(shm+LDS_WS)+wid*64;
  const bf16*ksrc=Kh+(long)lane*PKV+wid*8;
  const bf16*vsrc=Vh+(long)(16*(wid&3)+(lane>>2))*PKV+(wid>>2)*32+(lane&3)*8;
  const unsigned kdst=lds0+LDS_K+wid*1024, vdst=lds0+LDS_V+wid*1024;
  #define DMA_K(t,slot) glds16(ksrc+(long)(t)*KVBLK*PKV,(unsigned)__builtin_amdgcn_readfirstlane(kdst+(slot)))
  #define DMA_V(t,slot) do{ glds16(vsrc+(long)(t)*KVBLK*PKV,(unsigned)__builtin_amdgcn_readfirstlane(vdst+2*(slot))); if(DV2) glds16(vsrc+64+(long)(t)*KVBLK*PKV,(unsigned)__builtin_amdgcn_readfirstlane(vdst+2*(slot)+8192)); }while(0)
  const int vb0=(int)(lds0+LDS_V)+((lane>>4)&1)*32+(lane&3)*8+(4*hi+((lane&15)>>2))*64;
  const char*Kbase=shm+LDS_K; bf16x8 kf[8];
  const lds_cptr shm3=(lds_cptr)shm; const lds_cptr kp0=shm3+LDS_K+hi*1024+r32*16; const lds_cptr vp0=shm3+LDS_V+((lane>>4)&1)*32+(lane&3)*8+(4*hi+((lane&15)>>2))*64;
  const int NT=(q0+QB)/KVBLK;
  DMA_K(0,0);DMA_V(0,0);DMA_K(1,SLOTB);
  bf16x8 qr[4];
  #pragma unroll
  for(int d0=0;d0<4;++d0)qr[d0]=*reinterpret_cast<const bf16x8*>(&Qw[(long)r32*PQ+d0*16+hi*8]);
  const __attribute__((address_space(3))) char* qst_=(const __attribute__((address_space(3))) char*)((lds_cptr)shm+LDS_OST+wid*4096+lane*16);
  constexpr bool QPARK=false;
  if(DV2&&QPARK){ _Pragma("unroll") for(int d0=0;d0<4;++d0)*(__attribute__((address_space(3))) bf16x8*)(qst_+d0*1024)=qr[d0]; }
  #define QF(j) ((DV2&&QPARK)?*(const __attribute__((address_space(3))) bf16x8*)(qst_+(j)*1024):qr[j])
  float mhat=0.f,l_reg=0.f;f32x16 o[4];o[0]=f32x16{};o[1]=f32x16{};o[2]=f32x16{};o[3]=f32x16{};const f32x16 negm=f32x16{}; const float kbq=BIAS?kbias[q0+wid*QBLK+r32]:0.f;
  const int qrel=wid*QBLK+r32;
  #define CMASK(P0,P1,t) do{int jb_=(t)-(NT-4); if(jb_>=0)cmask(P0,P1,jb_,qrel,hi);}while(0)
  bool resc=false;
  #define START(P0,P1) do{ const float rm=rowmax(P0,P1); resc=false; \
    mhat=rm; const float mo_=BIAS?mhat+kbq:mhat; \
    _Pragma("unroll") for(int r=0;r<16;++r)P0[r]=__builtin_amdgcn_exp2f((BIAS?P0[r]+kbias[crow(r,hi)]:P0[r])-mo_); \
    _Pragma("unroll") for(int r=0;r<16;++r)P1[r]=__builtin_amdgcn_exp2f((BIAS?P1[r]+kbias[32+crow(r,hi)]:P1[r])-mo_); }while(0)
  #define RESC() do{ if(resc){ asm volatile("s_waitcnt lgkmcnt(0)":::"memory"); \
      _Pragma("unroll") for(int d_=0;d_<(DV2?4:2);++d_) _Pragma("unroll") for(int r=0;r<16;++r)o[d_][r]*=wsf[crow(r,hi)]; } }while(0)
  f32x16 pA0,pA1,pB0,pB1;
  int sl_prev=0,sl_cur=0,sl_next=SLOTB;
  #define ROT() do{sl_prev=sl_cur;sl_cur=sl_next;sl_next=(sl_next==(NSLOT-1)*SLOTB)?0:sl_next+SLOTB;}while(0)
  DMA_K(2,2*SLOTB);
  if(DV2){WAIT_BAR(4);}else{WAIT_BAR(3);}
  qkt(pA0,pA1,Kbase,qr,negm,r32,hi);asm volatile("s_nop 15\n\ts_nop 7":"+v"(pA0),"+v"(pA1));CMASK(pA0,pA1,0);
  START(pA0,pA1);
  WAIT_BAR(0);
  DMA_K(3,0);DMA_V(1,SLOTB);
  ROT();
  kload8(kf,kp0+sl_cur);
  if(DV2){WAIT_BAR(3);}else{WAIT_BAR(2);}
  s16x4 vlo[8],vhi[8]; u32x4 pw0,pw1,pw2,pw3;
  #define PKW(P,B) cvtpk_s(P[B],P[B+1])
  #define PAF(k) __builtin_bit_cast(bf16x8,pw##k)
  #define VFR(i) (bf16x8){vlo[i][0],vlo[i][1],vlo[i][2],vlo[i][3],vhi[i][0],vhi[i][1],vhi[i][2],vhi[i][3]}
  #define PIN(x) asm volatile("":"+v"(x))
  #define MX3(a,b,c) __builtin_fmaxf(__builtin_fmaxf((a),(b)),(c))
  #define GAPA(MF,A0,A1,A2,A3,W0,W1,PW) do{ MF; sacc+=A0; sacc+=A1; sacc+=A2; sacc+=A3; PIN(sacc); W0; W1; PIN(PW); SBAR(); }while(0)
  #define EX(v) __builtin_amdgcn_exp2f(v)
  #define GAPB(MF,X,B,IDX) do{ f32x4_t bq_; if(BIAS)bq_=bp_[IDX]; MF; if(BIAS){ X[B]=EX((X[B]+bq_[0])-mo_); X[B+1]=EX((X[B+1]+bq_[1])-mo_); X[B+2]=EX((X[B+2]+bq_[2])-mo_); X[B+3]=EX((X[B+3]+bq_[3])-mo_); } else { X[B]=EX(X[B]-mo_); X[B+1]=EX(X[B+1]-mo_); X[B+2]=EX(X[B+2]-mo_); X[B+3]=EX(X[B+3]-mo_); } PIN(X); SBAR(); }while(0)
  #define VRD(i) do{ vlo[i]=vtr(vp_+(((i)>>2)*4096+((i)&3)*1024)); vhi[i]=vtr(vp_+(((i)>>2)*4096+((i)&3)*1024+512)); }while(0)
  #define VRD2(i) do{ if(DV2){ vlo[i]=vtr(vp_+8192+(((i)>>2)*4096+((i)&3)*1024)); vhi[i]=vtr(vp_+8192+(((i)>>2)*4096+((i)&3)*1024+512)); SBAR(); } }while(0)
  #define GAPX(MF,X,B,IDX,I,XE) do{ if(DV2){ MF; XE[2*(I)]=EX(XE[2*(I)]-mo_); XE[2*(I)+1]=EX(XE[2*(I)+1]-mo_); PIN(XE); SBAR(); } else { GAPB(MF,X,B,IDX); } }while(0)
  #define KRD(G,j) do{ if(G){ kload2(kf,kp0+sl_next,j); SBAR(); } }while(0)
  #define STEP(C0,C1,P0,P1,t,GK,GV,GL) do{ SBAR(); \
    const lds_cptr vp_=vp0+2*sl_prev; const __attribute__((address_space(3))) f32x4_t* bp_=(const __attribute__((address_space(3))) f32x4_t*)(kbias+64*(t))+hi; \
    VRD(0); SBAR(); float sacc=(P0[0]+P0[1]); \
    GAPA(C0=__builtin_amdgcn_mfma_f32_32x32x16_bf16(kf[0],QF(0),negm,0,0,0), P0[2],P0[3],P0[4],P0[5],     pw0[0]=PKW(P0,0), pw0[1]=PKW(P0,2), pw0); \
    VRD(4); SBAR(); GAPA(C1=__builtin_amdgcn_mfma_f32_32x32x16_bf16(kf[1],QF(0),negm,0,0,0), P0[6],P0[7],P0[8],P0[9],     pw0[2]=PKW(P0,4), pw0[3]=PKW(P0,6), pw0); \
    VRD(1); SBAR(); GAPA(C0=__builtin_amdgcn_mfma_f32_32x32x16_bf16(kf[2],QF(1),C0,0,0,0),   P0[10],P0[11],P0[12],P0[13], pw1[0]=PKW(P0,8), pw1[1]=PKW(P0,10), pw1); \
    VRD(5); SBAR(); GAPA(C1=__builtin_amdgcn_mfma_f32_32x32x16_bf16(kf[3],QF(1),C1,0,0,0),   P0[14],P0[15],P1[0],P1[1],   pw1[2]=PKW(P0,12),pw1[3]=PKW(P0,14), pw1); \
    VRD(2); SBAR(); GAPA(C0=__builtin_amdgcn_mfma_f32_32x32x16_bf16(kf[4],QF(2),C0,0,0,0),   P1[2],P1[3],P1[4],P1[5],     pw2[0]=PKW(P1,0), pw2[1]=PKW(P1,2), pw2); \
    VRD(6); SBAR(); GAPA(C1=__builtin_amdgcn_mfma_f32_32x32x16_bf16(kf[5],QF(2),C1,0,0,0),   P1[6],P1[7],P1[8],P1[9],     pw2[2]=PKW(P1,4), pw2[3]=PKW(P1,6), pw2); \
    VRD(3); SBAR(); GAPA(C0=__builtin_amdgcn_mfma_f32_32x32x16_bf16(kf[6],QF(3),C0,0,0,0),   P1[10],P1[11],P1[12],P1[13], pw3[0]=PKW(P1,8), pw3[1]=PKW(P1,10), pw3); \
    VRD(7); SBAR(); GAPA(C1=__builtin_amdgcn_mfma_f32_32x32x16_bf16(kf[7],QF(3),C1,0,0,0),   P1[14],P1[15],0.f,0.f,       pw3[2]=PKW(P1,12),pw3[3]=PKW(P1,14), pw3); \
    l_reg+=sacc; \
    if(GK){DMA_K((t)+3,sl_cur);} if(GV){DMA_V((t)+1,sl_next);} \
    CMASK(C0,C1,t); \
    { float a=MX3(C0[0],C0[1],C1[0]),b=MX3(C0[2],C0[3],C1[1]); a=MX3(a,C1[2],C1[3]); \
      _Pragma("unroll") for(int r=4;r<16;r+=4){a=MX3(a,C0[r],C0[r+1]);b=MX3(b,C0[r+2],C0[r+3]);a=MX3(a,C1[r],C1[r+1]);b=MX3(b,C1[r+2],C1[r+3]);} \
      float rm=__builtin_fmaxf(a,b); { auto rr=__builtin_amdgcn_permlane32_swap(__float_as_uint(rm),__float_as_uint(rm),false,false); rm=__builtin_fmaxf(__uint_as_float(rr[0]),__uint_as_float(rr[1])); } rm-=mhat; \
      resc=false; \
      if(__builtin_expect(__any(rm>(float)THRL),0)){ const float dl=__builtin_fmaxf(rm,0.f); mhat+=dl; \
        const float f=__builtin_amdgcn_exp2f(-dl); l_reg*=f; if(hi==0)wsf[r32]=f; resc=true; } } const float mo_=BIAS?mhat+kbq:mhat; \
    SBAR(); \
    GAPX(o[0]=__builtin_amdgcn_mfma_f32_32x32x16_bf16(PAF(0),VFR(0),o[0],0,0,0), C0,0,0,0,C0); VRD2(0); \
    GAPX(o[1]=__builtin_amdgcn_mfma_f32_32x32x16_bf16(PAF(0),VFR(4),o[1],0,0,0), C0,4,2,1,C0); VRD2(4); \
    KRD(GL,0); GAPX(o[0]=__builtin_amdgcn_mfma_f32_32x32x16_bf16(PAF(1),VFR(1),o[0],0,0,0), C0,8,4,2,C0); VRD2(1); \
    KRD(GL,1); GAPX(o[1]=__builtin_amdgcn_mfma_f32_32x32x16_bf16(PAF(1),VFR(5),o[1],0,0,0), C0,12,6,3,C0); VRD2(5); \
    KRD(GL,2); GAPX(o[0]=__builtin_amdgcn_mfma_f32_32x32x16_bf16(PAF(2),VFR(2),o[0],0,0,0), C1,0,8,4,C0); VRD2(2); \
    KRD(GL,3); GAPX(o[1]=__builtin_amdgcn_mfma_f32_32x32x16_bf16(PAF(2),VFR(6),o[1],0,0,0), C1,4,10,5,C0); VRD2(6); \
    GAPX(o[0]=__builtin_amdgcn_mfma_f32_32x32x16_bf16(PAF(3),VFR(3),o[0],0,0,0), C1,8,12,6,C0); VRD2(3); \
    GAPX(o[1]=__builtin_amdgcn_mfma_f32_32x32x16_bf16(PAF(3),VFR(7),o[1],0,0,0), C1,12,14,7,C0); VRD2(7); \
    if(DV2){ o[2]=__builtin_amdgcn_mfma_f32_32x32x16_bf16(PAF(0),VFR(0),o[2],0,0,0); C1[0]=EX(C1[0]-mo_); C1[1]=EX(C1[1]-mo_); PIN(C1); SBAR(); o[3]=__builtin_amdgcn_mfma_f32_32x32x16_bf16(PAF(0),VFR(4),o[3],0,0,0); C1[2]=EX(C1[2]-mo_); C1[3]=EX(C1[3]-mo_); PIN(C1); SBAR(); o[2]=__builtin_amdgcn_mfma_f32_32x32x16_bf16(PAF(1),VFR(1),o[2],0,0,0); C1[4]=EX(C1[4]-mo_); C1[5]=EX(C1[5]-mo_); PIN(C1); SBAR(); o[3]=__builtin_amdgcn_mfma_f32_32x32x16_bf16(PAF(1),VFR(5),o[3],0,0,0); C1[6]=EX(C1[6]-mo_); C1[7]=EX(C1[7]-mo_); PIN(C1); SBAR(); \
      o[2]=__builtin_amdgcn_mfma_f32_32x32x16_bf16(PAF(2),VFR(2),o[2],0,0,0); C1[8]=EX(C1[8]-mo_); C1[9]=EX(C1[9]-mo_); PIN(C1); SBAR(); o[3]=__builtin_amdgcn_mfma_f32_32x32x16_bf16(PAF(2),VFR(6),o[3],0,0,0); C1[10]=EX(C1[10]-mo_); C1[11]=EX(C1[11]-mo_); PIN(C1); SBAR(); o[2]=__builtin_amdgcn_mfma_f32_32x32x16_bf16(PAF(3),VFR(3),o[2],0,0,0); C1[12]=EX(C1[12]-mo_); C1[13]=EX(C1[13]-mo_); PIN(C1); SBAR(); o[3]=__builtin_amdgcn_mfma_f32_32x32x16_bf16(PAF(3),VFR(7),o[3],0,0,0); C1[14]=EX(C1[14]-mo_); C1[15]=EX(C1[15]-mo_); PIN(C1); SBAR(); } \
    }while(0)
  int t=1;
  #undef CMASK
  #define CMASK(P0,P1,t) do{}while(0)
  for(;t+5<NT;t+=2){
    STEP(pB0,pB1,pA0,pA1,t,true,true,true);     if(DV2){WAIT_BAR(3);}else{WAIT_BAR(2);} RESC(); ROT();
    STEP(pA0,pA1,pB0,pB1,t+1,true,true,true);   if(DV2){WAIT_BAR(3);}else{WAIT_BAR(2);} RESC(); ROT();
  }
  #undef CMASK
  #define CMASK(P0,P1,t) do{int jb_=(t)-(NT-4); if(jb_>=0)cmask(P0,P1,jb_,qrel,hi);}while(0)
  #define ENDW(tt) do{ if((tt)+3<NT){ if(DV2){WAIT_BAR(3);}else{WAIT_BAR(2);} } else if((tt)+2<NT){ if(DV2){WAIT_BAR(2);}else{WAIT_BAR(1);} } else {WAIT_BAR(0);} }while(0)
  for(;t+1<NT;t+=2){
    STEP(pB0,pB1,pA0,pA1,t,(t+3<NT),(t+1<NT),(t+1<NT));       ENDW(t);   RESC(); ROT();
    STEP(pA0,pA1,pB0,pB1,t+1,(t+4<NT),(t+2<NT),(t+2<NT));     ENDW(t+1); RESC(); ROT();
  }
  STEP(pB0,pB1,pA0,pA1,NT-1,false,false,false); RESC();
  { float sacc=pB0[0]+pB0[1]; _Pragma("unroll") for(int r=2;r<16;++r)sacc+=pB0[r]; _Pragma("unroll") for(int r=0;r<16;++r)sacc+=pB1[r]; l_reg+=sacc;
    pw0=(u32x4){PKW(pB0,0),PKW(pB0,2),PKW(pB0,4),PKW(pB0,6)};pw1=(u32x4){PKW(pB0,8),PKW(pB0,10),PKW(pB0,12),PKW(pB0,14)};pw2=(u32x4){PKW(pB1,0),PKW(pB1,2),PKW(pB1,4),PKW(pB1,6)};pw3=(u32x4){PKW(pB1,8),PKW(pB1,10),PKW(pB1,12),PKW(pB1,14)};
    SBAR(); pv(o,vb0+2*sl_cur,PAF(0),PAF(1),PAF(2),PAF(3)); if(DV2){ SBAR(); pv(o+2,vb0+2*sl_cur+8192,PAF(0),PAF(1),PAF(2),PAF(3)); } }
  #undef PKW
  #undef PAF
  #undef VFR
  #undef PIN
  #undef MX3
  #undef GAPA
  #undef GAPB
  #undef EX
  #undef VRD
  #undef KRD
  #undef VRD2
  #undef GAPX
  #undef STEP
  #undef ENDW
  {auto rr=__builtin_amdgcn_permlane32_swap(__float_as_uint(l_reg),__float_as_uint(l_reg),false,false);l_reg=__uint_as_float(rr[0])+__uint_as_float(rr[1]);}
  if(hi==0)wsf[32+r32]=l_reg;asm volatile("s_waitcnt lgkmcnt(0)":::"memory");
  float rli[16];
  #pragma unroll
  for(int r=0;r<16;++r)rli[r]=__builtin_amdgcn_rcpf(wsf[32+crow(r,hi)]);
  bf16*Ow=O+(rowbase+q0+wid*QBLK)*PO;
  { bf16*stg=(bf16*)(shm+LDS_OST)+wid*2048;
    #pragma unroll
    for(int h2=0;h2<(DV2?2:1);++h2){
    #pragma unroll
    for(int r=0;r<16;++r){const int orow=crow(r,hi);
      #pragma unroll
      for(int d0=0;d0<2;++d0)stg[orow*64+d0*32+r32]=__float2bfloat16(o[2*h2+d0][r]*rli[r]);}
    asm volatile("s_waitcnt lgkmcnt(0)":::"memory");
    #pragma unroll
    for(int i=0;i<4;++i){const int row=i*8+(lane>>3),ch=lane&7; const u32x4 v=*(const u32x4*)(stg+row*64+ch*8); ATTN_STORE16(Ow+(long)row*PO+64*h2+ch*8,v);}
    asm volatile("s_waitcnt lgkmcnt(0)":::"memory"); } }
  asm volatile("s_waitcnt lgkmcnt(0)\n\ts_barrier":::"memory");
  #undef DMA_K
  #undef QF
  #undef DMA_V
  #undef CMASK
  #undef START
  #undef RESC
  #undef ROT
}
constexpr int ATTN_LDS_BYTES=LDS_BYTES;
#undef SBAR
#undef WAIT_BAR
}

constexpr int NWAVES = 8;
constexpr int BATCH = 4, SEQ = 4096, NTOK = BATCH * SEQ, D = 1024, DEPTH = 2;
constexpr int INC = 3332, PROJ_P = 3328, NIN = 3584;
constexpr int FFD = 2816, NGUD = 2 * FFD, NE = 8, FFE = 3584, NGUE = 2 * FFE, PLE = 256;
constexpr int MP_MAX = 2 * NTOK + NE * 256;
constexpr float EPS = 1e-6f;
constexpr int C_QA = 0, C_KA = 512, C_VA = 1024, C_QB = 1536, C_KB = 1792, C_VB = 2048, C_QC = 2304, C_KC = 2560, C_VC = 2816, C_GC = 3072;

constexpr size_t MiB = 1u << 20, KiB = 1u << 10;
constexpr size_t WS_CTL = 0, CTL_ZERO_BYTES = 32 * KiB;
constexpr size_t WS_STATS0 = 1 * MiB, WS_STATS1 = 2 * MiB;
constexpr size_t WS_LOGF = 3 * MiB;
constexpr size_t WS_RCOS = 3 * MiB + 256 * KiB, WS_RSIN = 3 * MiB + 768 * KiB;
constexpr size_t WS_E12 = 4 * MiB + 256 * KiB, WS_G12 = WS_E12 + 128 * KiB, WS_POS = WS_G12 + 128 * KiB;
constexpr size_t WS_DST = WS_POS + 128 * KiB, WS_GSORT = WS_DST + 256 * KiB;
static_assert(WS_GSORT + 256 * KiB <= 6 * MiB, "small region");
constexpr size_t WS_WIN1 = 6 * MiB, WS_WOUT1 = WS_WIN1 + 7 * MiB, WS_PG1 = WS_WOUT1 + 2 * MiB, WS_PPW1 = WS_PG1 + 2 * MiB, WS_P1 = WS_PPW1 + 512 * KiB;
constexpr size_t WS_MGU = WS_P1 + 8 * MiB, WS_MD = WS_MGU + 112 * MiB, WS_HB = WS_MD + 56 * MiB;
constexpr size_t WS_PROJ = WS_HB + 32 * MiB, WS_OA = WS_PROJ + 104 * MiB, WS_OCAT = WS_OA + 32 * MiB;
constexpr size_t WS_ACTD = WS_PROJ, WS_PP = WS_OA;
constexpr size_t WS_WIN0 = WS_OCAT + 32 * MiB, WS_WOUT0 = WS_WIN0 + 7 * MiB, WS_DGU = WS_WOUT0 + 2 * MiB, WS_DD = WS_DGU + 11 * MiB, WS_PG0 = WS_DD + 5632 * KiB, WS_PPW0 = WS_PG0 + 2 * MiB, WS_P0 = WS_PPW0 + 512 * KiB;
constexpr size_t WS_H8 = WS_MD + 28 * MiB;
constexpr size_t WS_ACTE = WS_HB;
constexpr size_t WS_XS = WS_ACTE + (size_t)MP_MAX * FFE * 2;
constexpr size_t WS_END = WS_XS + (size_t)MP_MAX * D * 2;
static_assert(WS_P0 + 8 * MiB <= WS_XS && WS_MD + 56 * MiB == WS_HB && (size_t)NTOK * PROJ_P * 2 == 104 * MiB && (size_t)NIN * D * 2 == 7 * MiB, "d_ws map");
static_assert((size_t)NGUD * D * 2 == 11 * MiB && (size_t)D * FFD * 2 == 5632 * KiB && (size_t)NE * NGUE * D * 2 == 112 * MiB && (size_t)NE * D * FFE * 2 == 56 * MiB, "d_ws map 2");
static_assert((4096 + 3456) * 4 <= (int)CTL_ZERO_BYTES, "barrier words inside the per-call memset");
constexpr int CW_TMO = 0, CW_Q = 64  , CW_CNT = 1024  , CW_BAR = 4096, CW_TS = 2048  ;

constexpr int RING_OFF = 0, RING_BYTES = 131072;
constexpr int LDSCTL_OFF = RING_BYTES, MISC_OFF = LDSCTL_OFF + 320, PT_OFF = LDSCTL_OFF + 512, RED_OFF = LDSCTL_OFF + 1024  ;
constexpr int LDS_BYTES = 147456;
static_assert(MISC_OFF + 128 <= LDS_BYTES, "LDS map");
#define GAS __attribute__((address_space(1)))
#define LAS __attribute__((address_space(3)))
typedef unsigned short bf16;
typedef unsigned v4u __attribute__((ext_vector_type(4)));
typedef float f32x4 __attribute__((ext_vector_type(4)));
typedef short bf16x8 __attribute__((ext_vector_type(8)));
typedef GAS unsigned gu32;
typedef GAS unsigned long long gu64;
#define RLX_AGENT __ATOMIC_RELAXED, __HIP_MEMORY_SCOPE_AGENT
#define LDS_WAIT() asm volatile("s_waitcnt lgkmcnt(0)" ::: "memory")
#define VM_WAIT() asm volatile("s_waitcnt vmcnt(0)" ::: "memory")
__device__ __forceinline__ unsigned long long rt() { return __builtin_amdgcn_s_memrealtime(); }
__device__ __forceinline__ unsigned f2bf(float f) { unsigned u = __builtin_bit_cast(unsigned, f); return (u + 0x7fffu + ((u >> 16) & 1u)) >> 16; }
__device__ __forceinline__ unsigned pk2(float lo, float hi) { return f2bf(lo) | (f2bf(hi) << 16); }

#define XB_TMO      128
#define XB_XCNT(j)  (256  + 64 * (j))
#define XB_XSUB(j)  (1280 + 64 * (j))
#define XB_XGEN(j)  (2304 + 64 * (j))
#define XB_TOP      3328
#define XB_TOPGEN   3392
#define XCD_BAR_WORDS 3456
#define XB_SPIN_CAP (1u << 18)

__device__ __forceinline__ unsigned xb_ld(unsigned* p)              { return __hip_atomic_load(p, __ATOMIC_RELAXED, __HIP_MEMORY_SCOPE_AGENT); }
__device__ __forceinline__ unsigned xb_add(unsigned* p, unsigned v) { return __hip_atomic_fetch_add(p, v, __ATOMIC_RELAXED, __HIP_MEMORY_SCOPE_AGENT); }
__device__ __forceinline__ unsigned xb_xcc_id() { return (unsigned)__builtin_amdgcn_s_getreg((3 << 11) | 20) & 0xFu; }
#define XB_SPIN(cond, bar) do { unsigned _sp = 0; while (cond) { __builtin_amdgcn_s_sleep(1); \
    if ((++_sp & 255u) == 0u) { if (xb_ld(&(bar)[XB_TMO])) break; if (_sp > XB_SPIN_CAP) { atomicAdd(&(bar)[XB_TMO], 1u); break; } } } } while (0)

struct XcdBarrier {
    unsigned* bar; unsigned x;
    volatile LAS unsigned* st;
};

__device__ __forceinline__ XcdBarrier xcd_barrier_post(unsigned* bar, volatile LAS unsigned* st) {
    XcdBarrier b; b.bar = bar; b.x = xb_xcc_id(); b.st = st;
    if (threadIdx.x == 0) (void)xb_add(&bar[XB_XCNT(b.x)], 1u);
    return b;
}
__device__ __forceinline__ void xcd_barrier_complete(unsigned* bar, unsigned x, unsigned& nloc, unsigned& nx) {
    const unsigned G = gridDim.x * gridDim.y * gridDim.z;
    unsigned sum, cnt, mine, sp = 0u;
    for (;;) {
        sum = 0u; cnt = 0u; mine = 0u;
#pragma unroll 1
        for (unsigned j = 0; j < 16; ++j) { const unsigned c = xb_ld(&bar[XB_XCNT(j)]); sum += c; cnt += (c > 0u) ? 1u : 0u; mine = (j == x) ? c : mine; }
        if (sum == G) break;
        __builtin_amdgcn_s_sleep(1);
        if ((++sp & 255u) == 0u) { if (xb_ld(&bar[XB_TMO])) break; if (sp > XB_SPIN_CAP) { atomicAdd(&bar[XB_TMO], 1u); break; } }
    }
    nloc = mine > 0u ? mine : 1u; nx = cnt > 0u ? cnt : 1u;
}

__device__ __attribute__((noinline)) void xcd_barrier(const XcdBarrier b, const int tid_) {
    asm volatile("s_waitcnt vmcnt(0)" ::: "memory");
    __syncthreads();
    if (tid_ == 0) {
        unsigned* bar = b.bar;
        __builtin_amdgcn_s_waitcnt(0);
        unsigned nloc = b.st[0], nx = b.st[1];
        if (nloc == 0u) { xcd_barrier_complete(bar, b.x, nloc, nx); b.st[0] = nloc; b.st[1] = nx; }
        const unsigned old = xb_add(&bar[XB_XSUB(b.x)], 1u);
        const unsigned gen = old / nloc;
        if (old + 1u == (gen + 1u) * nloc) {
            __builtin_amdgcn_fence(__ATOMIC_RELEASE, "agent");
            asm volatile("s_waitcnt vmcnt(0)" ::: "memory");
            const unsigned og = xb_add(&bar[XB_TOP], 1u);
            const unsigned tg = og / nx;
            if (og + 1u == (tg + 1u) * nx) xb_add(&bar[XB_TOPGEN], 1u);
            else XB_SPIN(xb_ld(&bar[XB_TOPGEN]) == tg, bar);
            __builtin_amdgcn_fence(__ATOMIC_ACQUIRE, "agent");
            xb_add(&bar[XB_XGEN(b.x)], 1u);
            asm volatile("s_waitcnt vmcnt(0)" ::: "memory");
        } else {
            XB_SPIN(xb_ld(&bar[XB_XGEN(b.x)]) == gen, bar);
            __builtin_amdgcn_fence(__ATOMIC_ACQUIRE, "agent");
            asm volatile("s_waitcnt vmcnt(0)" ::: "memory");
        }
    }
    __syncthreads();
}

using pg8::bf_lo; using pg8::bf_hi;
struct Frame {
    LAS unsigned char* lds; char* ldsg;
    volatile LAS unsigned* MISC;
    gu32* ctl; unsigned char* ws; float* out;
    int tid, lane, wave;
    int vcu, G;
};
__device__ __forceinline__ const float* in_ptr(const Frame& F, int k) {
    const volatile LAS unsigned* pt = (const volatile LAS unsigned*)(F.lds + PT_OFF); const unsigned lo = __builtin_amdgcn_readfirstlane(pt[2 * k]), hi = __builtin_amdgcn_readfirstlane(pt[2 * k + 1]);
    return (const float*)(((unsigned long long)hi << 32) | lo);
}
__device__ __forceinline__ float wave_sum(float v) {
#pragma unroll
    for (int o = 1; o < 64; o <<= 1) v += __shfl_xor(v, o);
    return v;
}
struct TrDesc { const float* src; const float* gain; bf16* dst; int Nsrc, K; float f8scale; };
__device__ __forceinline__ void tr_load(const TrDesc& t, f32x4 (&v)[8], int lane) {
#pragma unroll
    for (int i = 0; i < 8; ++i) v[i] = *(const GAS f32x4*)(t.src + (size_t)(8 * i + (lane >> 3)) * t.Nsrc + 4 * (lane & 7));
}
__device__ __forceinline__ void tr_store(const TrDesc& t, const f32x4 (&v)[8], LAS float* scr, int lane) {
#pragma unroll
    for (int i = 0; i < 8; ++i) { const int kk = 8 * i + (lane >> 3); f32x4 x = v[i]; if (t.gain) x = x * t.gain[kk]; LAS float* s = scr + kk * 33 + 4 * (lane & 7); s[0] = x[0]; s[1] = x[1]; s[2] = x[2]; s[3] = x[3]; }
    LDS_WAIT(); asm volatile("" ::: "memory");
    const int c = lane & 7;
    if (t.f8scale != 0.f) {
#pragma unroll
        for (int j = 0; j < 4; ++j) { const int n = (lane >> 3) + 8 * j; const LAS float* s = scr + (8 * c) * 33 + n; const float q = t.f8scale;
            const f32x4 a0 = (f32x4){s[0 * 33] * q, s[1 * 33] * q, s[2 * 33] * q, s[3 * 33] * q}, a1 = (f32x4){s[4 * 33] * q, s[5 * 33] * q, s[6 * 33] * q, s[7 * 33] * q};
            *(GAS unsigned long long*)((unsigned char*)t.dst + (size_t)n * t.K + 8 * c) = pg8::pack8_fp8(a0, a1); }
    } else {
#pragma unroll
        for (int j = 0; j < 4; ++j) { const int n = (lane >> 3) + 8 * j; const LAS float* s = scr + (8 * c) * 33 + n;
            v4u o; o.x = pk2(s[0 * 33], s[1 * 33]); o.y = pk2(s[2 * 33], s[3 * 33]); o.z = pk2(s[4 * 33], s[5 * 33]); o.w = pk2(s[6 * 33], s[7 * 33]);
            *(GAS v4u*)(t.dst + (size_t)n * t.K + 8 * c) = o; }
    }
    LDS_WAIT(); asm volatile("" ::: "memory");
}
struct Args { const float* in[24]; float* out; unsigned char* ws; int ph_lo, ph_hi; };

__device__ __forceinline__ void convert_items(Frame& F, const int it0, const int stride, const int itEnd) {
    LAS float* scr = (LAS float*)(F.lds + RING_OFF + F.wave * 16384);
    unsigned char* ws = F.ws;
    const float* norm_mix = in_ptr(F, 2); const float* w_in = in_ptr(F, 3); const float* w_out = in_ptr(F, 11); const float* norm_ffn = in_ptr(F, 12);
    const float* dwg = in_ptr(F, 13); const float* dwu = in_ptr(F, 14); const float* dwd = in_ptr(F, 15);
    const float* mwg = in_ptr(F, 17); const float* mwu = in_ptr(F, 18); const float* mwd = in_ptr(F, 19);
    const float* ple_norm = in_ptr(F, 20); const float* ple_gate = in_ptr(F, 21); const float* ple_proj = in_ptr(F, 22);
    constexpr int I_IN = (NIN / 32) * (D / 64), I_OUT = (D / 32) * (D / 64), I_DGU = (NGUD / 32) * (D / 64), I_DD = (D / 32) * (FFD / 64), I_PG = I_OUT, I_PP = (D / 32) * (PLE / 64);
    constexpr int I_MGU1 = (NGUE / 32) * (D / 64), I_MD1 = (D / 32) * (FFE / 64);
    constexpr int NITEMS = 2 * I_IN + 2 * I_OUT + I_DGU + I_DD + 2 * I_PG + 2 * I_PP + NE * I_MGU1 + NE * I_MD1;
    auto desc = [&](int it) -> TrDesc {
        int r = it; TrDesc t; t.f8scale = 0.f;
        if (r < 2 * I_IN) { const int L = r / I_IN; r -= L * I_IN; const int ng = NIN / 32, kb = r / ng, grp = r % ng, pn = grp >> 3, gi = grp & 7;
            int sc; if (pn <= 8) sc = 32 * grp; else if (pn == 9 || pn == 10) sc = (pn == 9 ? 2308 : 2564) + 64 * (gi & 3) + 32 * (gi >> 2); else if (pn <= 12) sc = 32 * grp + 4; else sc = 2304;
            t.Nsrc = INC; t.K = D; t.src = w_in + (size_t)L * D * INC + (size_t)(64 * kb) * INC + sc; t.gain = norm_mix + L * D + 64 * kb; t.dst = (bf16*)(ws + (L ? WS_WIN1 : WS_WIN0)) + (size_t)(32 * grp) * D + 64 * kb; return t; } r -= 2 * I_IN;
        if (r < 2 * I_OUT) { const int L = r / I_OUT; r -= L * I_OUT; const int ng = D / 32, kb = r / ng, grp = r % ng;
            t.Nsrc = D; t.K = D; t.src = w_out + (size_t)L * D * D + (size_t)(64 * kb) * D + 32 * grp; t.gain = nullptr; t.dst = (bf16*)(ws + (L ? WS_WOUT1 : WS_WOUT0)) + (size_t)(32 * grp) * D + 64 * kb; return t; } r -= 2 * I_OUT;
        if (r < I_DGU) { const int ng = NGUD / 32, kb = r / ng, grp = r % ng, pn = grp >> 3, gi = grp & 7;
            t.Nsrc = FFD; t.K = D; t.src = ((gi >> 2) ? dwu : dwg) + (size_t)(64 * kb) * FFD + 128 * pn + 32 * (gi & 3); t.gain = norm_ffn + 64 * kb; t.dst = (bf16*)(ws + WS_DGU) + (size_t)(32 * grp) * D + 64 * kb; return t; } r -= I_DGU;
        if (r < I_DD) { const int ng = D / 32, kb = r / ng, grp = r % ng;
            t.Nsrc = D; t.K = FFD; t.src = dwd + (size_t)(64 * kb) * D + 32 * grp; t.gain = nullptr; t.dst = (bf16*)(ws + WS_DD) + (size_t)(32 * grp) * FFD + 64 * kb; return t; } r -= I_DD;
        if (r < 2 * I_PG) { const int L = r / I_PG; r -= L * I_PG; const int ng = D / 32, kb = r / ng, grp = r % ng;
            t.Nsrc = D; t.K = D; t.src = ple_gate + (size_t)L * D * D + (size_t)(64 * kb) * D + 32 * grp; t.gain = ple_norm + L * D + 64 * kb; t.dst = (bf16*)(ws + (L ? WS_PG1 : WS_PG0)) + (size_t)(32 * grp) * D + 64 * kb; return t; } r -= 2 * I_PG;
        if (r < 2 * I_PP) { const int L = r / I_PP; r -= L * I_PP; const int ng = D / 32, kb = r / ng, grp = r % ng;
            t.Nsrc = D; t.K = PLE; t.src = ple_proj + (size_t)L * PLE * D + (size_t)(64 * kb) * D + 32 * grp; t.gain = nullptr; t.dst = (bf16*)(ws + (L ? WS_PPW1 : WS_PPW0)) + (size_t)(32 * grp) * PLE + 64 * kb; return t; } r -= 2 * I_PP;
        if (r < NE * I_MGU1) { const int e = r / I_MGU1; r -= e * I_MGU1; const int ng = NGUE / 32, kb = r / ng, grp = r % ng, pn = grp >> 3, gi = grp & 7;
            t.Nsrc = FFE; t.K = D; t.src = ((gi >> 2) ? mwu : mwg) + (size_t)e * D * FFE + (size_t)(64 * kb) * FFE + 128 * pn + 32 * (gi & 3); t.gain = nullptr; t.f8scale = 32.f; t.dst = (bf16*)(ws + WS_MGU + (size_t)e * NGUE * D + (size_t)(32 * grp) * D + 64 * kb); return t; } r -= NE * I_MGU1;
        { const int e = r / I_MD1; r -= e * I_MD1; const int ng = D / 32, kb = r / ng, grp = r % ng;
            t.Nsrc = D; t.K = FFE; t.src = mwd + (size_t)e * FFE * D + (size_t)(64 * kb) * D + 32 * grp; t.gain = nullptr; t.f8scale = 64.f; t.dst = (bf16*)(ws + WS_MD + (size_t)e * D * FFE + (size_t)(32 * grp) * FFE + 64 * kb); return t; }
    };
    {
        f32x4 va[8], vb[8]; int it = it0; TrDesc ta, tb;
        if (it < itEnd) { ta = desc(it); tr_load(ta, va, F.lane); }
        while (it < itEnd) {
            const int i2 = it + stride; if (i2 < itEnd) { tb = desc(i2); tr_load(tb, vb, F.lane); }
            tr_store(ta, va, scr, F.lane);
            if (i2 >= itEnd) break;
            const int i3 = i2 + stride; if (i3 < itEnd) { ta = desc(i3); tr_load(ta, va, F.lane); }
            tr_store(tb, vb, scr, F.lane);
            it = i3;
        }
    }
}
constexpr int CV_SMALL = 2 * ((NIN / 32) * (D / 64)) + 2 * ((D / 32) * (D / 64)) + (NGUD / 32) * (D / 64) + (D / 32) * (FFD / 64) + 2 * ((D / 32) * (D / 64)) + 2 * ((D / 32) * (PLE / 64));
constexpr int CV_MOE = NE * ((NGUE / 32) * (D / 64)) + NE * ((D / 32) * (FFE / 64));
#ifndef MK_CV_PER_WAVE
#define MK_CV_PER_WAVE 14
#endif
constexpr int CV_SLOTS = 3, CV_BLOCKS = 128, CV_PER_WAVE = MK_CV_PER_WAVE, CV_INSLOTS = CV_SLOTS * CV_BLOCKS * NWAVES * CV_PER_WAVE;
static_assert(CV_INSLOTS <= CV_MOE, "expert weight items: the first CV_INSLOTS in the slots, the rest in the prologue");
__device__ __forceinline__ void convert_slot(Frame& F, int slot, int bid) {
    if (bid < 256 - CV_BLOCKS) return;
    const int first = CV_SMALL + ((slot * CV_BLOCKS + (bid - (256 - CV_BLOCKS))) * NWAVES + F.wave) * CV_PER_WAVE;
    convert_items(F, first, 1, first + CV_PER_WAVE);
    __syncthreads();
}
__device__ __forceinline__ void p0_prologue(Frame& F, const Args& a) {
    const int gw = F.vcu * NWAVES + F.wave, NGW = F.G * NWAVES;
    unsigned char* ws = F.ws;
#ifdef MK_CONV_IN_PROLOGUE
    convert_items(F, gw, NGW, CV_SMALL + CV_MOE);
#else
    convert_items(F, gw, NGW, CV_SMALL);
    convert_items(F, CV_SMALL + (F.G == 256 ? CV_INSLOTS : 0) + gw, NGW, CV_SMALL + CV_MOE);
#endif
    for (int i = gw * 64 + F.lane; i < SEQ * 32; i += NGW * 64) { const int pos = i >> 5, d = i & 31;
        const double inv = exp2((double)d * (-13.287712379549449 / 32.0)); double ang = (double)pos * inv; ang -= 6.283185307179586 * rint(ang * 0.15915494309189535);
        ((float*)(ws + WS_RCOS))[i] = __cosf((float)ang); ((float*)(ws + WS_RSIN))[i] = __sinf((float)ang); }
    { const float* p = in_ptr(F, 1); const size_t n8 = (size_t)DEPTH * NTOK * PLE / 8, half8 = (size_t)NTOK * PLE / 8;
      for (size_t i = (size_t)gw * 64 + F.lane; i < n8; i += (size_t)NGW * 64) { const f32x4 v0 = ((const f32x4*)p)[2 * i], v1 = ((const f32x4*)p)[2 * i + 1];
          v4u o; o.x = pk2(v0[0], v0[1]); o.y = pk2(v0[2], v0[3]); o.z = pk2(v1[0], v1[1]); o.w = pk2(v1[2], v1[3]);
          if (i < half8) ((v4u*)(ws + WS_P0))[i] = o; else ((v4u*)(ws + WS_P1))[i - half8] = o; } }
    { const float* x = in_ptr(F, 0); bf16* hb = (bf16*)(ws + WS_HB); float* st = (float*)(ws + WS_STATS0);
      for (int m0 = gw; m0 < NTOK; m0 += 2 * NGW) {
          f32x4 xv[2][4];
#pragma unroll
          for (int u = 0; u < 2; ++u) { if (m0 + u * NGW >= NTOK) continue; const GAS f32x4* xr = (const GAS f32x4*)(x + (size_t)(m0 + u * NGW) * D) + F.lane;
#pragma unroll
              for (int j = 0; j < 4; ++j) xv[u][j] = xr[64 * j]; }
#pragma unroll
          for (int u = 0; u < 2; ++u) { const int m = m0 + u * NGW; if (m >= NTOK) continue; GAS unsigned long long* o8 = (GAS unsigned long long*)(hb + (size_t)m * D) + F.lane; float s = 0.f;
#pragma unroll
              for (int j = 0; j < 4; ++j) { const f32x4 v = xv[u][j]; const unsigned w0 = pk2(v[0], v[1]), w1 = pk2(v[2], v[3]);
                  const float q0 = bf_lo(w0), q1 = bf_hi(w0), q2 = bf_lo(w1), q3 = bf_hi(w1); s += (q0 * q0 + q1 * q1) + (q2 * q2 + q3 * q3);
                  o8[64 * j] = (unsigned long long)w0 | ((unsigned long long)w1 << 32); }
              s = wave_sum(s); if (F.lane < 4) st[(size_t)m * 4 + F.lane] = (F.lane == 0) ? s : 0.f; } } }
}

namespace ret {
constexpr int QP = 72, VP = 136;
constexpr int OFF_Q = 0, OFF_K = OFF_Q + 128 * QP * 2, OFF_VT = OFF_K + 128 * QP * 2, OFF_KD = OFF_VT + 64 * VP * 2, OFF_AS = OFF_KD + 64 * VP * 2, OFF_ST = OFF_AS + 128 * VP * 2, BYTES = OFF_ST + 2 * 64 * QP * 2;
static_assert(BYTES <= RING_BYTES, "retention LDS");
typedef LAS unsigned short lbf;
__device__ __forceinline__ bf16x8 ld8(const lbf* p) { return *(const LAS bf16x8*)p; }
__device__ __forceinline__ void unit(Frame& F, const int tid, int b, int h, int seg, const bf16* proj, bf16* ocat, const float* ret_gn) {
    const int lane = tid & 63, w = __builtin_amdgcn_readfirstlane(tid >> 6), l15 = lane & 15, q4 = lane >> 4;
    lbf* Qs = (lbf*)(F.lds + OFF_Q); lbf* Ks = (lbf*)(F.lds + OFF_K); lbf* Vt = (lbf*)(F.lds + OFF_VT); lbf* Kd = (lbf*)(F.lds + OFF_KD); lbf* As = (lbf*)(F.lds + OFF_AS); lbf* St = (lbf*)(F.lds + OFF_ST);
    const float l2g = log2f(1.f - exp2f(-5.f - (float)h));
    const float cdec = exp2f(128.f * l2g);
    const size_t rowb = (size_t)b * SEQ;
    const bf16* qg = proj + C_QC + 64 * h; const bf16* kg = proj + C_KC + 64 * h; const bf16* vg = proj + C_VC + 64 * h; const bf16* gg = proj + C_GC + 64 * h;
    v4u rq[2], rk[2], rv[2];
#define RET_LOAD(c) do { _Pragma("unroll") for (int i = 0; i < 2; ++i) { const int p = tid + 512 * i, row = p >> 3, c8 = p & 7; const size_t go = (rowb + (size_t)(c) * 128 + row) * PROJ_P + 8 * c8; \
        if ((c) >= c0) rq[i] = *(const GAS v4u*)(qg + go); rk[i] = *(const GAS v4u*)(kg + go); rv[i] = *(const GAS v4u*)(vg + go); } } while (0)
    const int c0 = 16 * seg, c1 = c0 + 16;
    rq[0] = rq[1] = (v4u){0u, 0u, 0u, 0u};
    RET_LOAD(0);
    f32x4 st[2];
    st[0] = (f32x4){0.f, 0.f, 0.f, 0.f}; st[1] = st[0];
    for (int i = tid; i < 64 * QP / 2; i += 512) ((LAS unsigned*)St)[i] = 0u;
#pragma unroll 1
    for (int c = 0; c < c1; ++c) {
        const bool full = c >= c0;
        __syncthreads();
#pragma unroll
        for (int i = 0; i < 2; ++i) { const int p = tid + 512 * i, row = p >> 3, c8 = p & 7;
            if (full) { *(LAS v4u*)(Qs + row * QP + 8 * c8) = rq[i]; *(LAS v4u*)(Ks + row * QP + 8 * c8) = rk[i]; }
            const float kd = __builtin_amdgcn_exp2f((float)(127 - row) * l2g);
            const unsigned kw[4] = {rk[i].x, rk[i].y, rk[i].z, rk[i].w}, vw[4] = {rv[i].x, rv[i].y, rv[i].z, rv[i].w};
#pragma unroll
            for (int e = 0; e < 4; ++e) { Vt[(8 * c8 + 2 * e) * VP + row] = (unsigned short)(vw[e] & 0xffffu); Vt[(8 * c8 + 2 * e + 1) * VP + row] = (unsigned short)(vw[e] >> 16);
                Kd[(8 * c8 + 2 * e) * VP + row] = (unsigned short)f2bf(bf_lo(kw[e]) * kd); Kd[(8 * c8 + 2 * e + 1) * VP + row] = (unsigned short)f2bf(bf_hi(kw[e]) * kd); } }
        if (c + 1 < c1) RET_LOAD(c + 1);
        __syncthreads();
        const lbf* Stc = St + (c & 1) * 64 * QP; lbf* Stn = St + ((c + 1) & 1) * 64 * QP;
        f32x4 o1[4], o2[4];
        if (full) {
        bf16x8 qa[2]; qa[0] = ld8(Qs + (16 * w + l15) * QP + 8 * q4); qa[1] = ld8(Qs + (16 * w + l15) * QP + 32 + 8 * q4);
#pragma unroll 1
        for (int nt = 0; nt <= w; ++nt) {
            f32x4 s = (f32x4){0.f, 0.f, 0.f, 0.f};
            s = __builtin_amdgcn_mfma_f32_16x16x32_bf16(qa[0], ld8(Ks + (16 * nt + l15) * QP + 8 * q4), s, 0, 0, 0);
            s = __builtin_amdgcn_mfma_f32_16x16x32_bf16(qa[1], ld8(Ks + (16 * nt + l15) * QP + 32 + 8 * q4), s, 0, 0, 0);
#pragma unroll
            for (int i = 0; i < 4; ++i) { const int dt = (16 * w + 4 * q4 + i) - (16 * nt + l15); const float v = dt >= 0 ? s[i] * __builtin_amdgcn_exp2f((float)dt * l2g) : 0.f;
                As[(16 * w + 4 * q4 + i) * VP + 16 * nt + l15] = (unsigned short)f2bf(v); } }
        if ((w & 1) == 0) {
#pragma unroll
            for (int i = 0; i < 4; ++i) As[(16 * w + 4 * q4 + i) * VP + 16 * (w + 1) + l15] = 0; }
        LDS_WAIT();
#pragma unroll
        for (int nv = 0; nv < 4; ++nv) { o1[nv] = (f32x4){0.f, 0.f, 0.f, 0.f}; o2[nv] = o1[nv]; }
#pragma unroll 1
        for (int ks = 0; ks <= (w >> 1); ++ks) { const bf16x8 af = ld8(As + (16 * w + l15) * VP + 32 * ks + 8 * q4);
#pragma unroll
            for (int nv = 0; nv < 4; ++nv) o1[nv] = __builtin_amdgcn_mfma_f32_16x16x32_bf16(af, ld8(Vt + (16 * nv + l15) * VP + 32 * ks + 8 * q4), o1[nv], 0, 0, 0); }
#pragma unroll
        for (int ks = 0; ks < 2; ++ks)
#pragma unroll
            for (int nv = 0; nv < 4; ++nv) o2[nv] = __builtin_amdgcn_mfma_f32_16x16x32_bf16(qa[ks], ld8(Stc + (16 * nv + l15) * QP + 32 * ks + 8 * q4), o2[nv], 0, 0, 0);
        }
#pragma unroll
        for (int i = 0; i < 2; ++i) { const int j = 2 * w + i, tv = j >> 2, td = j & 3; f32x4 u = (f32x4){0.f, 0.f, 0.f, 0.f};
#pragma unroll
            for (int ks = 0; ks < 4; ++ks) u = __builtin_amdgcn_mfma_f32_16x16x32_bf16(ld8(Vt + (16 * tv + l15) * VP + 32 * ks + 8 * q4), ld8(Kd + (16 * td + l15) * VP + 32 * ks + 8 * q4), u, 0, 0, 0);
            st[i] = st[i] * cdec + u;
#pragma unroll
            for (int e = 0; e < 4; ++e) Stn[(16 * tv + 4 * q4 + e) * QP + 16 * td + l15] = (unsigned short)f2bf(st[i][e]); }
        if (full) {
#pragma unroll
        for (int i = 0; i < 4; ++i) { const int j = 16 * w + 4 * q4 + i; const float qd = __builtin_amdgcn_exp2f((float)(j + 1) * l2g);
            float v[4], s = 0.f;
#pragma unroll
            for (int nv = 0; nv < 4; ++nv) { v[nv] = o1[nv][i] + qd * o2[nv][i]; s += v[nv]; }
            s += __shfl_xor(s, 1); s += __shfl_xor(s, 2); s += __shfl_xor(s, 4); s += __shfl_xor(s, 8);
            const float mu = s * (1.f / 64.f); float s2 = 0.f;
#pragma unroll
            for (int nv = 0; nv < 4; ++nv) { v[nv] -= mu; s2 += v[nv] * v[nv]; }
            s2 += __shfl_xor(s2, 1); s2 += __shfl_xor(s2, 2); s2 += __shfl_xor(s2, 4); s2 += __shfl_xor(s2, 8);
            const float rs = __builtin_amdgcn_rsqf(s2 * (1.f / 64.f) + EPS);
            const size_t tok = rowb + (size_t)c * 128 + j;
#pragma unroll
            for (int nv = 0; nv < 4; ++nv) { const int ch = 16 * nv + l15; const float g = bf_lo((unsigned)gg[tok * PROJ_P + ch]);
                ocat[tok * D + 768 + 64 * h + ch] = (bf16)f2bf(v[nv] * rs * ret_gn[64 * h + ch] * g * pg8::fast_sigmoid(g)); } }
        }
    }
    __syncthreads();
#undef RET_LOAD
}
}

__device__ __forceinline__ void fox_bias(Frame& F, const float* logf, int b, int h, int n, LAS float* kb) {
    LAS float* red = (LAS float*)(F.lds + LDSCTL_OFF);
    const int t0 = 8 * F.tid; float p[8]; float run = 0.f;
#pragma unroll
    for (int i = 0; i < 8; ++i) { const float v = (t0 + i < n) ? logf[((size_t)b * SEQ + t0 + i) * 4 + h] : 0.f; run += v; p[i] = run; }
    float inc = run;
#pragma unroll
    for (int o = 1; o < 64; o <<= 1) { const float y = __shfl_up(inc, o); if (F.lane >= o) inc += y; }
    if (F.lane == 63) red[F.wave] = inc;
    __syncthreads();
    float woff = 0.f, tot = 0.f;
#pragma unroll
    for (int k = 0; k < 8; ++k) { const float x = red[k]; if (k < F.wave) woff += x; tot += x; }
    const float base = woff + inc - run;
    if (t0 < n) {
#pragma unroll
        for (int i = 0; i < 8; ++i) kb[t0 + i] = (tot - (base + p[i])) * pg8::LOG2E;
    }
    __syncthreads();
}
constexpr int MIX_UNITS = 16 + 16 * 80;
constexpr int KB_OFF = attn_body::ATTN_LDS_BYTES;
static_assert(KB_OFF + 16384 <= RING_BYTES && KB_OFF % 16 == 0, "attention LDS + bias array");
__device__ __forceinline__ int mixer_grab(Frame& F, int word) {
    if (F.tid == 0) F.MISC[0] = __hip_atomic_fetch_add((unsigned*)(F.ctl + word), 1u, __ATOMIC_RELAXED, __HIP_MEMORY_SCOPE_AGENT);
    __syncthreads();
    const int u = __builtin_amdgcn_readfirstlane((int)F.MISC[0]);
    __syncthreads();
    return u;
}
__device__ __forceinline__ void mixer_phase(Frame& F, const Args& a, int layer) {
    unsigned char* ws = F.ws; const bf16* proj = (const bf16*)(ws + WS_PROJ); bf16* oa = (bf16*)(ws + WS_OA); bf16* ocat = (bf16*)(ws + WS_OCAT);
    const float* logf = (const float*)(ws + WS_LOGF); const float* ret_gn = in_ptr(F, 10) + layer * 256;
    char* lds = F.ldsg;
#ifndef MIXSEL
#define MIXSEL 7
#endif
#ifndef MIXDUP
#define MIXDUP 0
#endif
#define LOOP_RET(QW) { asm volatile("" : "+v"(F.tid)); const int t1 = F.tid; for (;;) { const int u = mixer_grab(F, (QW)); if (u >= 32) break; ret::unit(F, t1, (u >> 2) & 3, u & 3, 1 - (u >> 4), proj, ocat, ret_gn); } }
#define LOOP_A(QW) { asm volatile("" : "+v"(F.tid)); const int t2 = F.tid; for (;;) { const int u = mixer_grab(F, (QW)); if (u >= 512) break; \
        const int qb = 15 - (u >> 5), w = u & 31, b = w >> 3, j = w & 7;     \
        attn_body::attn_unit<8, false, true>(b, qb, (const attn_body::bf16*)(proj + C_QA + 64 * j), (const attn_body::bf16*)(proj + C_KA + 64 * j), (const attn_body::bf16*)(proj + C_VA + 128 * (j >> 1)), \
                                       (attn_body::bf16*)(oa + 128 * j), lds, (const LAS float*)nullptr, t2); } }
#define LOOP_B(QW) { asm volatile("" : "+v"(F.tid)); const int t3 = F.tid; for (;;) { const int u = mixer_grab(F, (QW)); if (u >= 256) break; \
        const int qb = 15 - (u >> 4), w = u & 15, b = w >> 2, h = w & 3; \
        LAS float* kb = (LAS float*)(F.lds + KB_OFF); \
        fox_bias(F, logf, b, h, 256 * qb + 256, kb); \
        attn_body::attn_unit<8, true, false>(b, qb, (const attn_body::bf16*)(proj + C_QB + 64 * h), (const attn_body::bf16*)(proj + C_KB + 64 * h), (const attn_body::bf16*)(proj + C_VB + 64 * h), \
                                      (attn_body::bf16*)(ocat + 512 + 64 * h), lds, (const LAS float*)kb, t3); } }
    const int qw = CW_Q + 64 * (3 * layer);
    if (MIXSEL & 1) LOOP_RET(qw)
    if (MIXSEL & 4) LOOP_B(qw + 128)
    if (MIXSEL & 2) LOOP_A(qw + 64)
#if MIXDUP & 1
    LOOP_RET(qw + 64 * 6)
#endif
#if MIXDUP & 2
    LOOP_A(qw + 64 * 7)
#endif
#if MIXDUP & 4
    LOOP_B(qw + 64 * 8)
#endif
#undef LOOP_RET
#undef LOOP_A
#undef LOOP_B
}
__device__ __forceinline__ void combine_phase(Frame& F, const Args& a, int layer) {
    unsigned char* ws = F.ws; const bf16* oa = (const bf16*)(ws + WS_OA); bf16* ocat = (bf16*)(ws + WS_OCAT);
    const int gw = F.vcu * NWAVES + F.wave, NGW = F.G * NWAVES;
    const float lam_init = 0.8f - 0.6f * expf(-0.3f * (float)layer);
    const float lam = expf(wave_sum(in_ptr(F, 5)[layer * 64 + F.lane] * in_ptr(F, 6)[layer * 64 + F.lane])) - expf(wave_sum(in_ptr(F, 7)[layer * 64 + F.lane] * in_ptr(F, 8)[layer * 64 + F.lane])) + lam_init;
    const int hd = F.lane >> 4, i16 = F.lane & 15;
    const float* sg = in_ptr(F, 9) + layer * 128 + 8 * i16; float g[8];
#pragma unroll
    for (int e = 0; e < 8; ++e) g[e] = sg[e] * (1.f - lam_init);
    for (int m0 = gw; m0 < NTOK; m0 += 2 * NGW) {
        v4u w1[2], w2[2];
#pragma unroll
        for (int u = 0; u < 2; ++u) { const int m = m0 + u * NGW; if (m >= NTOK) continue; w1[u] = *(const GAS v4u*)(oa + (size_t)m * D + 256 * hd + 8 * i16); w2[u] = *(const GAS v4u*)(oa + (size_t)m * D + 256 * hd + 128 + 8 * i16); }
#pragma unroll
        for (int u = 0; u < 2; ++u) { const int m = m0 + u * NGW; if (m >= NTOK) continue;
            const unsigned a1[4] = {w1[u].x, w1[u].y, w1[u].z, w1[u].w}, a2[4] = {w2[u].x, w2[u].y, w2[u].z, w2[u].w}; float d[8], ss = 0.f;
#pragma unroll
            for (int e = 0; e < 4; ++e) { d[2 * e] = bf_lo(a1[e]) - lam * bf_lo(a2[e]); d[2 * e + 1] = bf_hi(a1[e]) - lam * bf_hi(a2[e]); ss += d[2 * e] * d[2 * e] + d[2 * e + 1] * d[2 * e + 1]; }
            ss += __shfl_xor(ss, 1); ss += __shfl_xor(ss, 2); ss += __shfl_xor(ss, 4); ss += __shfl_xor(ss, 8);
            const float r = __builtin_amdgcn_rsqf(ss * (1.f / 128.f) + EPS);
            v4u o; o.x = pk2(d[0] * r * g[0], d[1] * r * g[1]); o.y = pk2(d[2] * r * g[2], d[3] * r * g[3]); o.z = pk2(d[4] * r * g[4], d[5] * r * g[5]); o.w = pk2(d[6] * r * g[6], d[7] * r * g[7]);
            *(GAS v4u*)(ocat + (size_t)m * D + 128 * hd + 8 * i16) = o; }
    }
}
__device__ __forceinline__ void router_phase(Frame& F, const Args& a, const bf16* h) {
    unsigned char* ws = F.ws; const float* gain = in_ptr(F, 12) + D; const float* router = in_ptr(F, 16);
    LAS float* R = (LAS float*)(F.lds + RING_OFF);
    LAS int* lcnt = (LAS int*)(F.lds + RING_OFF + 32768); LAS int* gbase = lcnt + 8; LAS int* rowe = lcnt + 16; LAS int* rowp = rowe + 128; LAS float* rowg = (LAS float*)(rowp + 128);
    for (int i = F.tid; i < D * NE; i += 512) R[(i & 7) * D + (i >> 3)] = gain[i >> 3] * router[i];
    const int nblk = NTOK / 64;
    for (int blk = F.vcu; blk < nblk; blk += F.G) {
        if (F.tid < 8) lcnt[F.tid] = 0;
        __syncthreads();
#pragma unroll 1
        for (int rr = 0; rr < 8; ++rr) { const int lr = F.wave * 8 + rr, m = blk * 64 + lr;
            const GAS unsigned long long* xr = (const GAS unsigned long long*)(h + (size_t)m * D) + F.lane; float lg[8]; float ss = 0.f;
#pragma unroll
            for (int e = 0; e < 8; ++e) lg[e] = 0.f;
#pragma unroll
            for (int j = 0; j < 4; ++j) { const unsigned long long pw = xr[64 * j]; const f32x4 v = (f32x4){bf_lo((unsigned)pw), bf_hi((unsigned)pw), bf_lo((unsigned)(pw >> 32)), bf_hi((unsigned)(pw >> 32))}; ss += (v[0] * v[0] + v[1] * v[1]) + (v[2] * v[2] + v[3] * v[3]);
#pragma unroll
                for (int e = 0; e < 8; ++e) { const f32x4 rr = *(const LAS f32x4*)(R + e * D + 256 * j + 4 * F.lane); lg[e] += (v[0] * rr[0] + v[1] * rr[1]) + (v[2] * rr[2] + v[3] * rr[3]); } }
            ss = wave_sum(ss); const float rs = 1.f / sqrtf(ss * (1.f / D) + EPS);
#pragma unroll
            for (int e = 0; e < 8; ++e) lg[e] = wave_sum(lg[e]) * rs;
            int i1 = 0; float v1 = lg[0];
#pragma unroll
            for (int e = 1; e < 8; ++e) if (lg[e] > v1) { v1 = lg[e]; i1 = e; }
            int i2 = -1; float v2 = -INFINITY;
#pragma unroll
            for (int e = 0; e < 8; ++e) if (e != i1 && lg[e] > v2) { v2 = lg[e]; i2 = e; }
            const float g2 = 1.f / (1.f + expf(v1 - v2)), g1 = 1.f - g2;
            if (F.lane == 0) { rowe[2 * lr] = i1; rowe[2 * lr + 1] = i2; rowg[2 * lr] = g1; rowg[2 * lr + 1] = g2;
                rowp[2 * lr] = __hip_atomic_fetch_add(lcnt + i1, 1, __ATOMIC_RELAXED, __HIP_MEMORY_SCOPE_WORKGROUP); rowp[2 * lr + 1] = __hip_atomic_fetch_add(lcnt + i2, 1, __ATOMIC_RELAXED, __HIP_MEMORY_SCOPE_WORKGROUP); }
        }
        __syncthreads();
        if (F.tid < 8) gbase[F.tid] = (int)__hip_atomic_fetch_add((unsigned*)(F.ctl + CW_CNT + 64 * F.tid), (unsigned)lcnt[F.tid], __ATOMIC_RELAXED, __HIP_MEMORY_SCOPE_AGENT);
        __syncthreads();
        if (F.tid < 128) { const int m2 = blk * 128 + F.tid; const int e = rowe[F.tid];
            ((int*)(ws + WS_E12))[m2] = e; ((float*)(ws + WS_G12))[m2] = rowg[F.tid]; ((int*)(ws + WS_POS))[m2] = gbase[e] + rowp[F.tid]; }
        __syncthreads();
    }
}
__device__ __forceinline__ void moe_tiles(Frame& F, int (&tb)[9]) {
    int acc = 0;
#pragma unroll
    for (int e = 0; e < 8; ++e) { tb[e] = acc; const int c = __builtin_amdgcn_readfirstlane((int)__hip_atomic_load((unsigned*)(F.ctl + CW_CNT + 64 * e), __ATOMIC_RELAXED, __HIP_MEMORY_SCOPE_AGENT)); acc += (c + 255) >> 8; }
    tb[8] = acc;
}
__device__ __forceinline__ void gather_phase(Frame& F, const Args& a, const bf16* h) {
    unsigned char* ws = F.ws; const float* gain = in_ptr(F, 12) + D;
    bf16* xs = (bf16*)(ws + WS_XS); int* dst = (int*)(ws + WS_DST); float* gsort = (float*)(ws + WS_GSORT);
    const int* e12 = (const int*)(ws + WS_E12); const float* g12 = (const float*)(ws + WS_G12); const int* pos = (const int*)(ws + WS_POS);
    int tb[9]; moe_tiles(F, tb);
    const int gw = F.vcu * NWAVES + F.wave, NGW = F.G * NWAVES;
#pragma unroll
    for (int e = 0; e < 8; ++e) { const int c = (int)__hip_atomic_load((unsigned*)(F.ctl + CW_CNT + 64 * e), __ATOMIC_RELAXED, __HIP_MEMORY_SCOPE_AGENT);
        const int lo = tb[e] * 256 + c, hi = tb[e + 1] * 256; for (int r = lo + gw * 64 + F.lane; r < hi; r += NGW * 64) { dst[r] = -1; gsort[r] = 0.f; } }
    f32x4 gv[4];
#pragma unroll
    for (int j = 0; j < 4; ++j) gv[j] = ((const GAS f32x4*)gain)[F.lane + 64 * j];
    for (int m = gw; m < NTOK; m += NGW) {
        const GAS unsigned long long* xr = (const GAS unsigned long long*)(h + (size_t)m * D) + F.lane; f32x4 v[4]; float ss = 0.f;
#pragma unroll
        for (int j = 0; j < 4; ++j) { const unsigned long long pw = xr[64 * j]; v[j] = (f32x4){bf_lo((unsigned)pw), bf_hi((unsigned)pw), bf_lo((unsigned)(pw >> 32)), bf_hi((unsigned)(pw >> 32))}; ss += (v[j][0] * v[j][0] + v[j][1] * v[j][1]) + (v[j][2] * v[j][2] + v[j][3] * v[j][3]); }
        ss = wave_sum(ss); const float rs = 1.f / sqrtf(ss * (1.f / D) + EPS);
        const int e1 = e12[2 * m], e2 = e12[2 * m + 1];
        int r1 = 0, r2 = 0;
#pragma unroll
        for (int e = 0; e < 8; ++e) { if (e == e1) r1 = tb[e] * 256; if (e == e2) r2 = tb[e] * 256; }
        r1 += pos[2 * m]; r2 += pos[2 * m + 1];
        GAS unsigned* o1 = (GAS unsigned*)((unsigned char*)xs + (size_t)r1 * D) + F.lane; GAS unsigned* o2 = (GAS unsigned*)((unsigned char*)xs + (size_t)r2 * D) + F.lane;
#pragma unroll
        for (int j = 0; j < 4; ++j) { const f32x4 y = v[j] * rs * gv[j]; unsigned pk = 0; pk = __builtin_amdgcn_cvt_pk_fp8_f32(y[0], y[1], pk, false); pk = __builtin_amdgcn_cvt_pk_fp8_f32(y[2], y[3], pk, true); o1[64 * j] = pk; o2[64 * j] = pk; }
        if (F.lane == 0) { dst[r1] = 2 * m; dst[r2] = 2 * m + 1; gsort[r1] = g12[2 * m]; gsort[r2] = g12[2 * m + 1]; }
    }
}
__device__ __forceinline__ void moe_combine_phase(Frame& F, const Args& a, float* stats_out, bf16* hb) {
    unsigned char* ws = F.ws; const bf16* y = (const bf16*)(ws + WS_XS);
    const int gw = F.vcu * NWAVES + F.wave, NGW = F.G * NWAVES;
    for (int m0 = gw; m0 < NTOK; m0 += 2 * NGW) {
        unsigned long long p0[2][4], p1[2][4], p2[2][4];
#pragma unroll
        for (int u = 0; u < 2; ++u) { const int m = m0 + u * NGW; if (m >= NTOK) continue; const GAS unsigned long long* y1 = (const GAS unsigned long long*)(y + (size_t)(2 * m) * D) + F.lane; const GAS unsigned long long* y2 = y1 + D / 4;
            const GAS unsigned long long* h8 = (const GAS unsigned long long*)(hb + (size_t)m * D) + F.lane;
#pragma unroll
            for (int j = 0; j < 4; ++j) { p0[u][j] = h8[64 * j]; p1[u][j] = y1[64 * j]; p2[u][j] = y2[64 * j]; } }
#pragma unroll
        for (int u = 0; u < 2; ++u) { const int m = m0 + u * NGW; if (m >= NTOK) continue; GAS unsigned long long* o8 = (GAS unsigned long long*)(hb + (size_t)m * D) + F.lane; float s = 0.f;
#pragma unroll
            for (int j = 0; j < 4; ++j) { const unsigned long long q0_ = p0[u][j], q1_ = p1[u][j], q2_ = p2[u][j]; f32x4 v;
                v[0] = bf_lo((unsigned)q0_) + (bf_lo((unsigned)q1_) + bf_lo((unsigned)q2_)); v[1] = bf_hi((unsigned)q0_) + (bf_hi((unsigned)q1_) + bf_hi((unsigned)q2_));
                v[2] = bf_lo((unsigned)(q0_ >> 32)) + (bf_lo((unsigned)(q1_ >> 32)) + bf_lo((unsigned)(q2_ >> 32))); v[3] = bf_hi((unsigned)(q0_ >> 32)) + (bf_hi((unsigned)(q1_ >> 32)) + bf_hi((unsigned)(q2_ >> 32)));
                const unsigned w0 = pk2(v[0], v[1]), w1 = pk2(v[2], v[3]); const float q0 = bf_lo(w0), q1 = bf_hi(w0), q2 = bf_lo(w1), q3 = bf_hi(w1);
                s += (q0 * q0 + q1 * q1) + (q2 * q2 + q3 * q3);
                o8[64 * j] = (unsigned long long)w0 | ((unsigned long long)w1 << 32); }
            s = wave_sum(s); if (F.lane < 4) stats_out[(size_t)m * 4 + F.lane] = (F.lane == 0) ? s : 0.f; }
    }
}
__device__ __forceinline__ void final_phase(Frame& F, const Args& a) {
    float* h = F.out; const bf16* hbp = (const bf16*)(F.ws + WS_HB); const float* gain = in_ptr(F, 23);
    const int gw = F.vcu * NWAVES + F.wave, NGW = F.G * NWAVES;
    float dscale = 1.f;
#ifdef TSDIAG
    { const unsigned long long* ts = (const unsigned long long*)(F.ctl + CW_TS); dscale = 1.f + (float)(ts[TS_A1] - ts[TS_A0]) * (0.01f / 3000.f); }
#endif
    f32x4 gv[4];
#pragma unroll
    for (int j = 0; j < 4; ++j) gv[j] = ((const GAS f32x4*)gain)[F.lane + 64 * j];
    for (int m0 = gw; m0 < NTOK; m0 += 2 * NGW) {
        unsigned long long pw[2][4];
#pragma unroll
        for (int u = 0; u < 2; ++u) { if (m0 + u * NGW >= NTOK) continue; const GAS unsigned long long* xr = (const GAS unsigned long long*)(hbp + (size_t)(m0 + u * NGW) * D) + F.lane;
#pragma unroll
            for (int j = 0; j < 4; ++j) pw[u][j] = xr[64 * j]; }
#pragma unroll
        for (int u = 0; u < 2; ++u) { if (m0 + u * NGW >= NTOK) continue; GAS f32x4* hr = (GAS f32x4*)(h + (size_t)(m0 + u * NGW) * D) + F.lane; f32x4 v[4]; float ss = 0.f;
#pragma unroll
            for (int j = 0; j < 4; ++j) { const unsigned long long q = pw[u][j]; v[j] = (f32x4){bf_lo((unsigned)q), bf_hi((unsigned)q), bf_lo((unsigned)(q >> 32)), bf_hi((unsigned)(q >> 32))}; ss += (v[j][0] * v[j][0] + v[j][1] * v[j][1]) + (v[j][2] * v[j][2] + v[j][3] * v[j][3]); }
            ss = wave_sum(ss); const float rs = 1.f / sqrtf(ss * (1.f / D) + EPS);
#pragma unroll
            for (int j = 0; j < 4; ++j) hr[64 * j] = v[j] * rs * gv[j] * dscale; }
    }
#ifdef TSDIAG
    if (gw == 0 && F.lane == 0) { const unsigned long long* ts = (const unsigned long long*)(F.ctl + CW_TS); h[0] = (float)(ts[TS_B1] - ts[TS_B0]) * (0.01f / 30.f); }
#endif
}

__device__ __forceinline__ int launder2() { int n = 2; asm volatile("" : "+s"(n)); return n; }
constexpr int N_PHASES = 26;
__global__ void __launch_bounds__(NWAVES * 64, 2) mega_fwd(Args args) {
    extern __shared__ __attribute__((aligned(16))) unsigned char lds[];
    Frame F;
    F.lds = (LAS unsigned char*)lds; F.ldsg = (char*)lds;
    F.MISC = (volatile LAS unsigned*)(F.lds + MISC_OFF);
    F.tid = threadIdx.x; F.lane = F.tid & 63; F.wave = __builtin_amdgcn_readfirstlane(F.tid >> 6);
    F.G = gridDim.x; { const int bx = blockIdx.x; F.vcu = (F.G % 8 == 0) ? (bx % 8) * (F.G / 8) + bx / 8 : bx; }
    F.ws = args.ws; F.out = F.out;
    F.ctl = (gu32*)(F.ws + WS_CTL);
    for (int u = F.tid; u < (LDS_BYTES - LDSCTL_OFF) / 4; u += NWAVES * 64) ((LAS unsigned*)(F.lds + LDSCTL_OFF))[u] = 0u;
    __syncthreads();
    if (F.tid == 0) {
#pragma unroll
        for (int i = 0; i < 24; ++i) ((LAS unsigned long long*)(F.lds + PT_OFF))[i] = (unsigned long long)args.in[i]; }
    __syncthreads();
    int lo = args.ph_lo, hi = args.ph_hi, bid = (int)blockIdx.x; size_t zoff = 0; int nst = 0;
#define one (lo == 0 && hi == N_PHASES)
    XcdBarrier bar; bar.bar = (unsigned*)(F.ctl + CW_BAR); bar.x = 0; bar.st = nullptr;
    if (one) bar = xcd_barrier_post((unsigned*)(F.ctl + CW_BAR), F.MISC + 8);
#define IN(k) (lo <= (k) && (k) < hi)
#ifndef MK_PHMASK
#define MK_PHMASK 0xffffffffu
#endif
#define EN(n) (((MK_PHMASK) >> (n)) & 1u)
#ifndef DUPK
#define DUPK -1
#endif
#define NREP(k) ((DUPK) == (k) ? launder2() : 1)
#ifndef DUPBAR
#define DUPBAR 1
#endif
#ifdef TSDIAG
#define STAMP() do { if (bid == 0 && F.tid == 0) ((unsigned long long*)(F.ctl + CW_TS))[nst] = __builtin_amdgcn_s_memrealtime(); ++nst; } while (0)
#else
#define STAMP() do {} while (0)
#endif
#define SEAM() do { if (one) { for (int b_ = 0; b_ < DUPBAR; ++b_) xcd_barrier(bar, F.tid); } STAMP(); } while (0)
#define FRESH() do { asm volatile("" : "+v"(F.tid)); asm volatile("" : "+s"(zoff), "+s"(lo), "+s"(hi), "+s"(bid), "+s"(F.G), "+s"(F.vcu)); F.ws = args.ws + zoff; F.out = (float*)((char*)args.out + zoff); F.lane = F.tid & 63; F.wave = __builtin_amdgcn_readfirstlane(F.tid >> 6); F.ctl = (gu32*)(F.ws + WS_CTL); } while (0)
#define hb ((bf16*)(L == 0 ? (void*)(F.ws + WS_HB) : (void*)F.out))
#define hbn ((bf16*)(L == 0 ? (void*)F.out : (void*)(F.ws + WS_HB)))
#define st0 ((float*)(F.ws + WS_STATS0))
#define st1 ((float*)(F.ws + WS_STATS1))
#define ST_CUR (sb ? st1 : st0)
#define ST_NXT (sb ? st0 : st1)

    STAMP();
    FRESH(); if (EN(0) && IN(0)) { for (int r_ = 0; r_ < NREP(0); ++r_) p0_prologue(F, args); SEAM(); }
    int sb = 0;
#pragma unroll
    for (int L = 0; L < DEPTH; ++L) {
        const int pb = 1 + 12 * L;
        FRESH(); if (EN(1) && IN(pb + 0)) {
            pg8::Gemm g{hb, (const pg8::bf16_t*)(F.ws + (L ? WS_WIN1 : WS_WIN0)), NTOK, NIN, D, 0}; pg8::StaticOrder S; S.init(NTOK, NIN, F.G, bid);
            pg8::EpiIn E{(pg8::bf16_t*)(F.ws + WS_PROJ), (float*)(F.ws + WS_LOGF), ST_CUR, (const float*)(F.ws + WS_RCOS), (const float*)(F.ws + WS_RSIN), in_ptr(F, 4) + 4 * L, attn_body::C2};
            if (DUPK == 1) { pg8::EpiBf16<0> EJ{(pg8::bf16_t*)(F.ws + WS_PROJ), PROJ_P, nullptr, 0, 0, 1.f}; pg8::gemm_phase<pg8::EpiBf16<0>, pg8::StaticOrder, true, true>(F.lds + RING_OFF, g, S, EJ, F.tid); }
            pg8::gemm_phase<pg8::EpiIn, pg8::StaticOrder, true, true>(F.lds + RING_OFF, g, S, E, F.tid);
#ifndef MK_CONV_IN_PROLOGUE
            if (F.G == 256) convert_slot(F, L == 0 ? 0 : 2, bid);
#endif
            SEAM(); }
        FRESH(); if (EN(2) && IN(pb + 1)) { mixer_phase(F, args, L); SEAM(); }
        FRESH(); if (EN(3) && IN(pb + 2)) { for (int r_ = 0; r_ < NREP(3); ++r_) combine_phase(F, args, L); SEAM(); }
        FRESH(); if (EN(4) && IN(pb + 3)) {
            pg8::Gemm g{(const pg8::bf16_t*)(F.ws + WS_OCAT), (const pg8::bf16_t*)(F.ws + (L ? WS_WOUT1 : WS_WOUT0)), NTOK, D, D, 0}; pg8::StaticOrder S; S.init(NTOK, D, F.G, bid);
            pg8::EpiRes<0> E{hb, hb, ST_NXT, nullptr, nullptr, nullptr, 1.f, (LAS float*)(F.lds + RED_OFF)};
            pg8::gemm_phase<pg8::EpiRes<0>, pg8::StaticOrder, true, true>(F.lds + RING_OFF, g, S, E, F.tid);
            if (DUPK == 4) { pg8::EpiBf16<0> EJ{(pg8::bf16_t*)(F.ws + WS_OA), D, nullptr, 0, 0, 1.f}; pg8::gemm_phase<pg8::EpiBf16<0>, pg8::StaticOrder, false, true>(F.lds + RING_OFF, g, S, EJ, F.tid); }
            SEAM(); }
        sb ^= 1;
        if (L == 0) {
            FRESH(); if (EN(5) && IN(pb + 4)) {
                pg8::Gemm g{hb, (const pg8::bf16_t*)(F.ws + WS_DGU), NTOK, NGUD, D, 0}; pg8::StaticOrder S; S.init(NTOK, NGUD, F.G, bid);
                pg8::EpiGU<true> E{(pg8::bf16_t*)(F.ws + WS_ACTD), FFD, ST_CUR, 1.f, 1.f};
                for (int r_ = 0; r_ < NREP(5); ++r_) pg8::gemm_phase<pg8::EpiGU<true>, pg8::StaticOrder, true, true>(F.lds + RING_OFF, g, S, E, F.tid);
#ifndef MK_CONV_IN_PROLOGUE
                if (F.G == 256) convert_slot(F, 1, bid);
#endif
                SEAM(); }
            FRESH(); if (EN(6) && IN(pb + 5)) {
                pg8::Gemm g{(const pg8::bf16_t*)(F.ws + WS_ACTD), (const pg8::bf16_t*)(F.ws + WS_DD), NTOK, D, FFD, 0}; pg8::StaticOrder S; S.init(NTOK, D, F.G, bid);
                pg8::EpiRes<0> E{hb, hb, ST_NXT, nullptr, nullptr, nullptr, 1.f, (LAS float*)(F.lds + RED_OFF)};
                pg8::gemm_phase<pg8::EpiRes<0>, pg8::StaticOrder, true, true>(F.lds + RING_OFF, g, S, E, F.tid);
                if (DUPK == 6) { pg8::EpiBf16<0> EJ{(pg8::bf16_t*)(F.ws + WS_OA), D, nullptr, 0, 0, 1.f}; pg8::gemm_phase<pg8::EpiBf16<0>, pg8::StaticOrder, false, true>(F.lds + RING_OFF, g, S, EJ, F.tid); }
                SEAM(); }
        } else {
            FRESH(); if (EN(7) && IN(pb + 4)) { router_phase(F, args, hb); SEAM(); }
            FRESH(); if (EN(8) && IN(pb + 5)) { for (int r_ = 0; r_ < NREP(8); ++r_) gather_phase(F, args, hb); SEAM(); }
            FRESH(); if (EN(9) && IN(pb + 6)) {
                pg8::MoeOrder S; moe_tiles(F, S.tb); S.nM = S.tb[8]; S.nN = NGUE / 256; S.nwg = S.nM * S.nN; S.G = F.G; S.c = bid;
                pg8::Gemm g{(const pg8::bf16_t*)(F.ws + WS_XS), (const pg8::bf16_t*)(F.ws + WS_MGU), MP_MAX, NGUE, D, (size_t)NGUE * D};
                pg8::EpiGU<false, true> E{(pg8::bf16_t*)(F.ws + WS_ACTE), FFE, nullptr, 1.f / 32.f, 4.f};
                if (DUPK == 9) { pg8::gemm_phase<pg8::EpiGU<false, true>, pg8::MoeOrder, true, true, true>(F.lds + RING_OFF, g, S, E, F.tid); SEAM(); }
                pg8::gemm_phase<pg8::EpiGU<false, true>, pg8::MoeOrder, true, true, true>(F.lds + RING_OFF, g, S, E, F.tid);
                SEAM(); }
            FRESH(); if (EN(10) && IN(pb + 7)) {
                pg8::MoeOrder S; moe_tiles(F, S.tb); S.nM = S.tb[8]; S.nN = D / 256; S.nwg = S.nM * S.nN; S.G = F.G; S.c = bid;
                pg8::Gemm g{(const pg8::bf16_t*)(F.ws + WS_ACTE), (const pg8::bf16_t*)(F.ws + WS_MD), MP_MAX, D, FFE, (size_t)D * FFE};
                pg8::EpiMoeDown E{(pg8::bf16_t*)(F.ws + WS_XS), (const int*)(F.ws + WS_DST), (const float*)(F.ws + WS_GSORT), 1.f / 256.f};
                for (int r_ = 0; r_ < NREP(10); ++r_) pg8::gemm_phase<pg8::EpiMoeDown, pg8::MoeOrder, true, true, true>(F.lds + RING_OFF, g, S, E, F.tid);
                SEAM(); }
            FRESH(); if (EN(11) && IN(pb + 8)) { moe_combine_phase(F, args, ST_NXT, hb); SEAM(); }
        }
        sb ^= 1;
        FRESH(); if (EN(12) && IN(pb + 9)) {
            pg8::Gemm g{(const pg8::bf16_t*)(F.ws + (L ? WS_P1 : WS_P0)), (const pg8::bf16_t*)(F.ws + (L ? WS_PPW1 : WS_PPW0)), NTOK, D, PLE, 0}; pg8::StaticOrder S; S.init(NTOK, D, F.G, bid);
            pg8::EpiBf16<0> E{(pg8::bf16_t*)(F.ws + WS_PP), D, nullptr, 0, 0, 1.f};
            for (int r_ = 0; r_ < NREP(12); ++r_) pg8::gemm_phase<pg8::EpiBf16<0>, pg8::StaticOrder, true, true>(F.lds + RING_OFF, g, S, E, F.tid);
            if (!one) {   } }
        FRESH(); if (EN(13) && IN(pb + 10)) {
            pg8::Gemm g{hb, (const pg8::bf16_t*)(F.ws + (L ? WS_PG1 : WS_PG0)), NTOK, D, D, 0}; pg8::StaticOrder S; S.init(NTOK, D, F.G, bid);
            pg8::EpiRes<1> E{hb, hbn, ST_NXT, ST_CUR, (const pg8::bf16_t*)(F.ws + WS_PP), nullptr, 1.f, (LAS float*)(F.lds + RED_OFF)};
            pg8::gemm_phase<pg8::EpiRes<1>, pg8::StaticOrder, true, true>(F.lds + RING_OFF, g, S, E, F.tid);
            if (DUPK == 13) { pg8::EpiBf16<0> EJ{(pg8::bf16_t*)(F.ws + WS_OCAT), D, nullptr, 0, 0, 1.f}; pg8::gemm_phase<pg8::EpiBf16<0>, pg8::StaticOrder, false, true>(F.lds + RING_OFF, g, S, EJ, F.tid); }
            SEAM(); }
        sb ^= 1;
    }
    FRESH(); if (EN(14) && IN(25)) final_phase(F, args);
#undef IN
#undef SEAM
#undef FRESH
#undef one
#undef hb
#undef hbn
#undef st0
#undef st1
}

#ifndef MK_PER_PHASE
#define MK_PER_PHASE 0
#endif
extern "C" void kernel_launch(void* const* d_in, const int* in_sizes, int n_in, void* d_out, int out_size, void* d_ws, size_t ws_size, hipStream_t stream) {
    static int grid = 0;
    if (grid == 0) {
        if (n_in != 24 || in_sizes[0] != NTOK * D || out_size != NTOK * D || ws_size < WS_END) { fprintf(stderr, "kernel_launch: unexpected shapes or workspace (%zu < %zu)\n", ws_size, (size_t)WS_END); grid = -1; return; }
        int dev = 0, cus = 0, per_cu = 0;
        if (hipGetDevice(&dev) != hipSuccess || hipDeviceGetAttribute(&cus, hipDeviceAttributeMultiprocessorCount, dev) != hipSuccess) { grid = -1; return; }
        if (hipFuncSetAttribute((const void*)mega_fwd, hipFuncAttributeMaxDynamicSharedMemorySize, LDS_BYTES) != hipSuccess) { fprintf(stderr, "kernel_launch: hipFuncSetAttribute failed\n"); grid = -1; return; }
        if (hipOccupancyMaxActiveBlocksPerMultiprocessor(&per_cu, (const void*)mega_fwd, NWAVES * 64, LDS_BYTES) != hipSuccess || per_cu < 1) { fprintf(stderr, "kernel_launch: occupancy query says %d\n", per_cu); }
        (void)hipGetLastError();
        grid = cus;
    }
    if (grid < 0) return;
    if (hipMemsetAsync((char*)d_ws + WS_CTL, 0, CTL_ZERO_BYTES, stream) != hipSuccess) return;
    Args a{};
    for (int i = 0; i < 24; ++i) a.in[i] = (const float*)d_in[i];
    a.out = (float*)d_out; a.ws = (unsigned char*)d_ws;
#if MK_PER_PHASE
    for (int p = 0; p < N_PHASES; ++p) { a.ph_lo = p; a.ph_hi = p + 1; hipLaunchKernelGGL(mega_fwd, dim3(grid), dim3(NWAVES * 64), LDS_BYTES, stream, a); }
#else
    a.ph_lo = 0; a.ph_hi = N_PHASES; hipLaunchKernelGGL(mega_fwd, dim3(grid), dim3(NWAVES * 64), LDS_BYTES, stream, a);
#endif
}
```

```cpp
#include <hip/hip_runtime.h>
#include <cstdio>
#include <cstdint>
namespace pg8 {
#define PG8_LAS __attribute__((address_space(3)))
typedef unsigned short bf16_t;
typedef short bf16x8 __attribute__((ext_vector_type(8)));
typedef float f32x4 __attribute__((ext_vector_type(4)));
typedef unsigned u32x4 __attribute__((ext_vector_type(4)));
constexpr int BM = 256, BK = 64, HALF = 128, HTB = HALF * BK * 2  , STAGE_BYTES = 8 * HTB, NXCD = 8, WGM = 8;

__host__ __device__ __forceinline__ int lds_byte(int r, int c) { const int st = (r >> 4) * 2 + (c >> 5), rr = r & 15, cc = c & 31, ob = rr * 64 + cc * 2; return st * 1024 + (ob ^ (((ob >> 9) & 1) << 5)); }
__host__ __device__ __forceinline__ void stage_rc(int b, int& R, int& C) { const int st = b / 1024, sb = b % 1024, swz = sb ^ (((sb >> 9) & 1) << 5); R = (st >> 1) * 16 + swz / 64; C = (st & 1) * 32 + (swz % 64) / 2; }
__host__ __device__ __forceinline__ int perm32(int rho) { const int n = rho >> 4, i = rho & 15; return 8 * (i >> 2) + 4 * n + (i & 3); }

struct Unit { int pm, pn, pe; };
struct Gemm { const bf16_t* A; const bf16_t* Bt; int M, N, K; size_t bstride; };

struct StaticOrder {
    int nM, nN, nwg, G, c;
    __host__ __device__ void init(int M, int N, int G_, int c_) { nM = M / BM; nN = N / BM; nwg = nM * nN; G = G_; c = c_; }
    __host__ __device__ bool next(int i, Unit& u) const {
        const long L = (long)i * G + c; if (L >= nwg) return false;
        int wgid = (int)L; { const int q = nwg / NXCD, r = nwg % NXCD, xcd = wgid % NXCD, off = wgid / NXCD; wgid = (xcd < r ? xcd * (q + 1) : r * (q + 1) + (xcd - r) * q) + off; }
        const int nig = WGM * nN, gid = wgid / nig, fm = gid * WGM, gsz = (nM - fm) < WGM ? (nM - fm) : WGM;
        u.pm = fm + ((wgid % nig) % gsz); u.pn = (wgid % nig) / gsz; u.pe = 0; return true;
    }
    __device__ __forceinline__ void a_ready(const Unit&) const {}
    __device__ __forceinline__ void done(const Unit&) const {}
};

__device__ __forceinline__ unsigned cvt_pk_bf16(float lo, float hi) { unsigned r; asm volatile("v_cvt_pk_bf16_f32 %0, %1, %2" : "=v"(r) : "v"(lo), "v"(hi)); return r; }
typedef float f32x2 __attribute__((ext_vector_type(2)));
__device__ __forceinline__ f32x2 gelu_pk(f32x2 v) {
    const f32x2 av = __builtin_elementwise_abs(v), d = av * 0.2316418882f + 1.0f;
    f32x2 t; t.x = __builtin_amdgcn_rcpf(d.x); t.y = __builtin_amdgcn_rcpf(d.y);
    f32x2 q = t * 0.5307027145f + (-0.7265760135f); q = q * t + 0.7107068705f; q = q * t + (-0.142248368f); q = q * t + 0.127414796f; q = q * t;
    const f32x2 s = (v * v) * (-0.72134752044f);
    f32x2 e; e.x = __builtin_amdgcn_exp2f(s.x); e.y = __builtin_amdgcn_exp2f(s.y);
    const f32x2 m = v * (q * e), r = v - m;
    f32x2 o; o.x = v.x < 0.f ? m.x : r.x; o.y = v.y < 0.f ? m.y : r.y; return o;
}

template <int ACT  > struct EpiBf16 {
    static constexpr bool PERM = true, AFTER_DRAIN = false; static_assert(ACT == 0 || ACT == 1, "EpiBf16: ACT is 0 (none) or 1 (gelu_pk)");
    bf16_t* O; int ldc; const float* bias; int split_cols; size_t split_stride; float scale0;
    __device__ __forceinline__ void operator()(const f32x4 (&acc)[2][2][4][2], const Unit& u, int wr, int wc, int fr, int fq) const {
        const int row0 = u.pm * BM + wr * 64 + fr; int colt = u.pn * BM; bf16_t* base = O;
        float sc = 1.f; if (split_cols) { const int t = colt / split_cols; base += (size_t)t * split_stride; colt -= t * split_cols; if (t == 0) sc = scale0; }
        const int col0 = colt + wc * 32 + 8 * fq, bcol0 = u.pn * BM + wc * 32 + 8 * fq;
        f32x4 bv[2][2];
#pragma unroll
        for (int bj = 0; bj < 2; ++bj)
#pragma unroll
            for (int n = 0; n < 2; ++n) bv[bj][n] = bias ? *(const f32x4*)(bias + bcol0 + bj * HALF + 4 * n) : (f32x4){0.f, 0.f, 0.f, 0.f};
#pragma unroll
        for (int ai = 0; ai < 2; ++ai)
#pragma unroll
            for (int m = 0; m < 4; ++m) { bf16_t* rowp = base + (size_t)(row0 + ai * HALF + m * 16) * ldc + col0;
#pragma unroll
                for (int bj = 0; bj < 2; ++bj) { f32x4 v0 = acc[ai][bj][m][0] + bv[bj][0], v1 = acc[ai][bj][m][1] + bv[bj][1];
                    if (ACT == 1) { f32x2 a = gelu_pk((f32x2){v0[0], v0[1]}), b = gelu_pk((f32x2){v0[2], v0[3]}), c = gelu_pk((f32x2){v1[0], v1[1]}), d = gelu_pk((f32x2){v1[2], v1[3]});
                        v0 = (f32x4){a.x, a.y, b.x, b.y}; v1 = (f32x4){c.x, c.y, d.x, d.y}; }
                    v0 = v0 * sc; v1 = v1 * sc; u32x4 w; w.x = cvt_pk_bf16(v0[0], v0[1]); w.y = cvt_pk_bf16(v0[2], v0[3]); w.z = cvt_pk_bf16(v1[0], v1[1]); w.w = cvt_pk_bf16(v1[2], v1[3]);
                    *(u32x4*)(rowp + bj * HALF) = w; } }
    }
};

typedef int v8i32 __attribute__((ext_vector_type(8))); typedef short s16x16 __attribute__((ext_vector_type(16)));
__device__ __forceinline__ v8i32 cat8(bf16x8 lo, bf16x8 hi) { return __builtin_bit_cast(v8i32, __builtin_shufflevector(lo, hi, 0, 1, 2, 3, 4, 5, 6, 7, 8, 9, 10, 11, 12, 13, 14, 15)); }
__device__ __forceinline__ unsigned long long pack8_fp8(const f32x4 v0, const f32x4 v1) {
    unsigned lo = 0, hi = 0; lo = __builtin_amdgcn_cvt_pk_fp8_f32(v0[0], v0[1], lo, false); lo = __builtin_amdgcn_cvt_pk_fp8_f32(v0[2], v0[3], lo, true);
    hi = __builtin_amdgcn_cvt_pk_fp8_f32(v1[0], v1[1], hi, false); hi = __builtin_amdgcn_cvt_pk_fp8_f32(v1[2], v1[3], hi, true); return (unsigned long long)lo | ((unsigned long long)hi << 32); }
constexpr float RMS_EPS = 1e-6f;
constexpr float LOG2E = 1.4426950408889634f;
__device__ __forceinline__ float fast_sigmoid(float x) { return __builtin_amdgcn_rcpf(1.f + __builtin_amdgcn_exp2f(-x * LOG2E)); }
__device__ __forceinline__ float row_rstd(const float* st, int row) {
    const f32x4 a = *(const f32x4*)(st + (size_t)row * 4);
    return __builtin_amdgcn_rsqf(((a[0] + a[1]) + (a[2] + a[3])) * (1.f / 1024.f) + RMS_EPS);
}
__device__ __forceinline__ u32x4 pack8(const f32x4 v0, const f32x4 v1) { u32x4 w; w.x = cvt_pk_bf16(v0[0], v0[1]); w.y = cvt_pk_bf16(v0[2], v0[3]); w.z = cvt_pk_bf16(v1[0], v1[1]); w.w = cvt_pk_bf16(v1[2], v1[3]); return w; }
__device__ __forceinline__ float bf_lo(unsigned w) { return __builtin_bit_cast(float, w << 16); }
__device__ __forceinline__ float bf_hi(unsigned w) { return __builtin_bit_cast(float, w & 0xffff0000u); }

struct EpiIn {
    static constexpr bool PERM = true, AFTER_DRAIN = false;
    bf16_t* proj; float* logf; const float* stats; const float* rcos; const float* rsin; const float* bfg; float c2;
    __device__ __forceinline__ void operator()(const f32x4 (&acc)[2][2][4][2], const Unit& u, int wr, int wc, int fr, int fq) const {
        const int pn = u.pn; const int row0 = u.pm * BM + wr * 64 + fr;
        float rr[8];
#pragma unroll
        for (int k = 0; k < 8; ++k) rr[k] = row_rstd(stats, row0 + (k >> 2) * HALF + (k & 3) * 16);
        if (pn == 9 || pn == 10) {
            const float s0 = (pn == 10) ? 0.125f : 1.f;
#pragma unroll
            for (int ai = 0; ai < 2; ++ai) {
                f32x4 cv[4][2], sv[4][2];
#pragma unroll
                for (int m = 0; m < 4; ++m) { const int pos = (row0 + ai * HALF + m * 16) & 4095; const f32x4* cp = (const f32x4*)(rcos + pos * 32 + 8 * fq); const f32x4* sp = (const f32x4*)(rsin + pos * 32 + 8 * fq);
                    cv[m][0] = cp[0]; cv[m][1] = cp[1]; sv[m][0] = sp[0]; sv[m][1] = sp[1]; }
#pragma unroll
                for (int m = 0; m < 4; ++m) { const int row = row0 + ai * HALF + m * 16; const float sc = s0 * rr[ai * 4 + m];
                    f32x4 o1[2], o2[2];
#pragma unroll
                    for (int n = 0; n < 2; ++n) { const f32x4 c = cv[m][n], s = sv[m][n], x1 = acc[ai][0][m][n] * sc, x2 = acc[ai][1][m][n] * sc; o1[n] = x1 * c - x2 * s; o2[n] = x1 * s + x2 * c; }
                    bf16_t* dst = proj + (size_t)row * 3328 + 256 * pn + 64 * wc + 8 * fq;
                    *(u32x4*)dst = pack8(o1[0], o1[1]); *(u32x4*)(dst + 32) = pack8(o2[0], o2[1]); }
            }
            return;
        }
#pragma unroll
        for (int ai = 0; ai < 2; ++ai)
#pragma unroll
            for (int m = 0; m < 4; ++m) {
                const int row = row0 + ai * HALF + m * 16; const float r = rr[ai * 4 + m];
                if (pn == 13) {
                    if (wc == 0 && fq == 0) { const f32x4 b = *(const f32x4*)bfg; f32x4 x = acc[ai][0][m][0] * r + b, o;
#pragma unroll
                        for (int i = 0; i < 4; ++i) o[i] = fminf(x[i], 0.f) - log1pf(__expf(-fabsf(x[i])));
                        *(f32x4*)(logf + (size_t)row * 4) = o; }
                } else {
                    const float sc = (pn <= 1 || pn == 6) ? r * c2 : r;
                    bf16_t* dst = proj + (size_t)row * 3328 + 256 * pn + 32 * wc + 8 * fq;
#pragma unroll
                    for (int bj = 0; bj < 2; ++bj) *(u32x4*)(dst + bj * HALF) = pack8(acc[ai][bj][m][0] * sc, acc[ai][bj][m][1] * sc);
                }
            }
    }
};

template <int MODE> struct EpiRes {
    static constexpr bool PERM = true, AFTER_DRAIN = false;
    const bf16_t* hin; bf16_t* hb; float* stats_out; const float* stats_in; const bf16_t* pp; unsigned char* h8; float asc; PG8_LAS float* red;
    __device__ __forceinline__ void operator()(const f32x4 (&acc)[2][2][4][2], const Unit& u, int wr, int wc, int fr, int fq) const {
        const int row0 = u.pm * BM + wr * 64 + fr; const int col0 = u.pn * BM + wc * 32 + 8 * fq;
#pragma unroll
        for (int ai = 0; ai < 2; ++ai)
#pragma unroll
        for (int mp = 0; mp < 4; mp += 2) {
            u32x4 hw[4][2], pw[4][2]; float rr[4];
#pragma unroll
            for (int m = mp; m < mp + 2; ++m) { const int row = row0 + ai * HALF + m * 16;
#pragma unroll
                for (int bj = 0; bj < 2; ++bj) { hw[m][bj] = *(const u32x4*)(hin + (size_t)row * 1024 + col0 + bj * HALF); if (MODE == 1) pw[m][bj] = *(const u32x4*)(pp + (size_t)row * 1024 + col0 + bj * HALF); }
                rr[m] = (MODE == 1) ? row_rstd(stats_in, row) : 1.f; }
#pragma unroll
            for (int m = mp; m < mp + 2; ++m) {
                const int row = row0 + ai * HALF + m * 16; const float r = rr[m];
                float ss = 0.f;
#pragma unroll
                for (int bj = 0; bj < 2; ++bj) {
                    bf16_t* hp = hb + (size_t)row * 1024 + col0 + bj * HALF; const u32x4 hwv = hw[m][bj];
                    f32x4 h0 = (f32x4){bf_lo(hwv.x), bf_hi(hwv.x), bf_lo(hwv.y), bf_hi(hwv.y)}, h1 = (f32x4){bf_lo(hwv.z), bf_hi(hwv.z), bf_lo(hwv.w), bf_hi(hwv.w)};
                    f32x4 a0 = acc[ai][bj][m][0] * asc, a1 = acc[ai][bj][m][1] * asc;
                    if (MODE == 1) { const u32x4 pwv = pw[m][bj];
                        a0[0] = fast_sigmoid(a0[0] * r) * bf_lo(pwv.x); a0[1] = fast_sigmoid(a0[1] * r) * bf_hi(pwv.x); a0[2] = fast_sigmoid(a0[2] * r) * bf_lo(pwv.y); a0[3] = fast_sigmoid(a0[3] * r) * bf_hi(pwv.y);
                        a1[0] = fast_sigmoid(a1[0] * r) * bf_lo(pwv.z); a1[1] = fast_sigmoid(a1[1] * r) * bf_hi(pwv.z); a1[2] = fast_sigmoid(a1[2] * r) * bf_lo(pwv.w); a1[3] = fast_sigmoid(a1[3] * r) * bf_hi(pwv.w); }
                    h0 = h0 + a0; h1 = h1 + a1;
                    const u32x4 ow = pack8(h0, h1); *(u32x4*)hp = ow;
                    if (h8) *(unsigned long long*)(h8 + (size_t)row * 1024 + col0 + bj * HALF) = pack8_fp8(h0, h1);
                    const float q0 = bf_lo(ow.x), q1 = bf_hi(ow.x), q2 = bf_lo(ow.y), q3 = bf_hi(ow.y), q4 = bf_lo(ow.z), q5 = bf_hi(ow.z), q6 = bf_lo(ow.w), q7 = bf_hi(ow.w);
                    ss += ((q0 * q0 + q1 * q1) + (q2 * q2 + q3 * q3)) + ((q4 * q4 + q5 * q5) + (q6 * q6 + q7 * q7));
                }
                ss += __shfl_xor(ss, 16); ss += __shfl_xor(ss, 32);
                if (fq == 0) red[(wr * 64 + ai * HALF + m * 16 + fr) * 4 + wc] = ss;
            }
        }
        asm volatile("s_waitcnt lgkmcnt(0)" ::: "memory"); __builtin_amdgcn_s_barrier();
        { const int t = (wr * 4 + wc) * 64 + fq * 16 + fr; if (t < 256) { const f32x4 v = *(const PG8_LAS f32x4*)(red + 4 * t); stats_out[(size_t)(u.pm * BM + t) * 4 + u.pn] = (v[0] + v[1]) + (v[2] + v[3]); } }
        asm volatile("s_waitcnt lgkmcnt(0)" ::: "memory"); __builtin_amdgcn_s_barrier();
    }
};

template <bool SCALED, bool F8 = false> struct EpiGU {
    static constexpr bool PERM = true, AFTER_DRAIN = false;
    bf16_t* act; int ldact; const float* stats; float isc, osc;
    __device__ __forceinline__ void operator()(const f32x4 (&acc)[2][2][4][2], const Unit& u, int wr, int wc, int fr, int fq) const {
        const int row0 = u.pm * BM + wr * 64 + fr; const int col0 = u.pn * HALF + wc * 32 + 8 * fq;
        float rr[8];
#pragma unroll
        for (int k = 0; k < 8; ++k) rr[k] = SCALED ? row_rstd(stats, row0 + (k >> 2) * HALF + (k & 3) * 16) : 1.f;
#pragma unroll
        for (int ai = 0; ai < 2; ++ai)
#pragma unroll
            for (int m = 0; m < 4; ++m) {
                const int row = row0 + ai * HALF + m * 16; float r = F8 ? isc : 1.f; if (SCALED) r *= rr[ai * 4 + m];
                f32x4 o[2];
#pragma unroll
                for (int n = 0; n < 2; ++n) { const f32x4 g = acc[ai][0][m][n] * r, up = acc[ai][1][m][n] * r;
#pragma unroll
                    for (int i = 0; i < 4; ++i) o[n][i] = g[i] * fast_sigmoid(g[i]) * up[i]; }
                if (F8) *(unsigned long long*)((unsigned char*)act + (size_t)row * ldact + col0) = pack8_fp8(o[0] * osc, o[1] * osc);
                else *(u32x4*)(act + (size_t)row * ldact + col0) = pack8(o[0], o[1]);
            }
    }
};

struct EpiMoeDown {
    static constexpr bool PERM = true, AFTER_DRAIN = false;
    bf16_t* y; const int* dst; const float* gsort; float sc;
    __device__ __forceinline__ void operator()(const f32x4 (&acc)[2][2][4][2], const Unit& u, int wr, int wc, int fr, int fq) const {
        const int row0 = u.pm * BM + wr * 64 + fr; const int col0 = u.pn * BM + wc * 32 + 8 * fq;
        int dd[8]; float gg[8];
#pragma unroll
        for (int k = 0; k < 8; ++k) { const int row = row0 + (k >> 2) * HALF + (k & 3) * 16; dd[k] = dst[row]; gg[k] = gsort[row]; }
#pragma unroll
        for (int ai = 0; ai < 2; ++ai)
#pragma unroll
            for (int m = 0; m < 4; ++m) {
                const int d = dd[ai * 4 + m]; if (d < 0) continue; const float g = gg[ai * 4 + m] * sc;
#pragma unroll
                for (int bj = 0; bj < 2; ++bj) *(u32x4*)(y + (size_t)d * 1024 + col0 + bj * HALF) = pack8(acc[ai][bj][m][0] * g, acc[ai][bj][m][1] * g);
            }
    }
};

struct MoeOrder {
    int nM, nN, nwg, G, c; int tb[9];
    __device__ __forceinline__ bool next(int i, Unit& u) const {
        const long L = (long)i * G + c; if (L >= nwg) return false;
        int wgid = (int)L; { const int q = nwg / NXCD, r = nwg % NXCD, xcd = wgid % NXCD, off = wgid / NXCD; wgid = (xcd < r ? xcd * (q + 1) : r * (q + 1) + (xcd - r) * q) + off; }
        const int nig = WGM * nN, gid = wgid / nig, fm = gid * WGM, gsz = (nM - fm) < WGM ? (nM - fm) : WGM;
        u.pm = fm + ((wgid % nig) % gsz); u.pn = (wgid % nig) / gsz;
        int e = 0;
#pragma unroll
        for (int k = 1; k < 8; ++k) e += (u.pm >= tb[k]) ? 1 : 0;
        u.pe = e; return true;
    }
    __device__ __forceinline__ void a_ready(const Unit&) const {}
    __device__ __forceinline__ void done(const Unit&) const {}
};
template <class Epi, class Sched, bool ALIGN_EPI = false, bool SP2 = false, bool FP8 = false>
__device__ __forceinline__ void gemm_phase(PG8_LAS unsigned char* lds, const Gemm g, const Sched& S, const Epi& E, const int tid) {
    const int wid = __builtin_amdgcn_readfirstlane(tid >> 6), lane = tid & 63, wr = wid >> 2, wc = wid & 3, fr = lane & 15, fq = lane >> 4;
    const int K = g.K, KB = FP8 ? K : 2 * K  , nt = KB / (2 * BK);
    unsigned voffA[2], voffB[2];
#pragma unroll
    for (int i = 0; i < 2; ++i) { int R, C; stage_rc(tid * 16 + i * 8192, R, C); const int Rb = Epi::PERM ? ((R & ~31) + perm32(R & 31)) : R;
        voffA[i] = (unsigned)(R * KB + 2 * C); voffB[i] = (unsigned)(Rb * KB + 2 * C); }
    const size_t kstep = (size_t)(BK * 2);
    const size_t hstep = (size_t)HALF * KB;
    const size_t tstep = 2 * hstep;
    const unsigned ldsw = (unsigned)wid * 1024u;
    const int aoff = lds_byte(wr * 64 + fr, FP8 ? fq * 16 : fq * 8), boff = lds_byte(wc * 32 + fr, FP8 ? fq * 16 : fq * 8); constexpr int KPIECE = FP8 ? 16 : 1024;
#define PG8_SA(b, h) (((b) * 2 + (h)) * HTB)
#define PG8_SB(b, h) ((4 + (b) * 2 + (h)) * HTB)
#define PG8_STAGE(bufoff, gbase, voff) do { _Pragma("unroll") for (int _i = 0; _i < 2; ++_i) \
        __builtin_amdgcn_global_load_lds((const unsigned*)((const char*)(gbase) + (voff)[_i]), (PG8_LAS unsigned*)(lds + (bufoff) + ldsw + _i * 8192), 16, 0, 0); } while (0)
#define PG8_LDA(dst, b, h) do { if constexpr (FP8) { _Pragma("unroll") for (int m = 0; m < 4; ++m) dst##8[m] = *(const PG8_LAS v8i32*)(lds + PG8_SA(b, h) + aoff + m * 2048); } else _Pragma("unroll") for (int m = 0; m < 4; ++m) _Pragma("unroll") for (int k = 0; k < 2; ++k) dst[m][k] = *(const PG8_LAS bf16x8*)(lds + PG8_SA(b, h) + aoff + m * 2048 + k * 1024); } while (0)
#define PG8_LDB(dst, b, h) do { if constexpr (FP8) { _Pragma("unroll") for (int n = 0; n < 2; ++n) dst##8[n] = *(const PG8_LAS v8i32*)(lds + PG8_SB(b, h) + boff + n * 2048); } else _Pragma("unroll") for (int n = 0; n < 2; ++n) _Pragma("unroll") for (int k = 0; k < 2; ++k) dst[n][k] = *(const PG8_LAS bf16x8*)(lds + PG8_SB(b, h) + boff + n * 2048 + k * 1024); } while (0)
#define PG8_MMA(ai, bj, At, Bt) do { __builtin_amdgcn_s_setprio(1); _Pragma("unroll") for (int m = 0; m < 4; ++m) _Pragma("unroll") for (int n = 0; n < 2; ++n) { \
        if constexpr (FP8) { asm volatile("v_mfma_scale_f32_16x16x128_f8f6f4 %0, %1, %2, %0, %3, %3 op_sel_hi:[0,0,0]" : "+v"(acc[ai][bj][m][n]) : "v"(Bt##8[n]), "v"(At##8[m]), "v"(f8one)); } \
        else { _Pragma("unroll") for (int k = 0; k < 2; ++k) acc[ai][bj][m][n] = __builtin_amdgcn_mfma_f32_16x16x32_bf16(Bt[n][k], At[m][k], acc[ai][bj][m][n], 0, 0, 0); } } __builtin_amdgcn_s_setprio(0); } while (0)
#define PG8_WAIT_V(n) asm volatile("s_waitcnt vmcnt(" #n ")" ::: "memory")
#define PG8_WAIT_L(n) asm volatile("s_waitcnt lgkmcnt(" #n ")" ::: "memory")
#define PG8_BAR __builtin_amdgcn_s_barrier()
#define PG8_SCHED __builtin_amdgcn_sched_barrier(0)
    Unit cur, nxt; int ui = 0;
    if (!S.next(0, cur)) return;
    f32x4 acc[2][2][4][2];
#pragma unroll
    for (int a = 0; a < 2; ++a)
#pragma unroll
        for (int b = 0; b < 2; ++b)
#pragma unroll
            for (int m = 0; m < 4; ++m)
#pragma unroll
                for (int n = 0; n < 2; ++n) acc[a][b][m][n] = (f32x4){0.f, 0.f, 0.f, 0.f};
    bf16x8 At[4][2], B0[2][2], B1[2][2]; v8i32 At8[4], B08[2], B18[2]; const int f8one = 0x7f7f7f7f;
    const char* cA = (const char*)g.A + (size_t)cur.pm * tstep; const char* cB = (const char*)g.Bt + (size_t)cur.pn * tstep + (size_t)cur.pe * g.bstride;
    S.a_ready(cur);
    if constexpr (SP2) {
        PG8_STAGE(PG8_SB(0, 0), cB, voffB); PG8_STAGE(PG8_SB(0, 1), cB + hstep, voffB); PG8_STAGE(PG8_SA(0, 0), cA, voffA); PG8_STAGE(PG8_SA(0, 1), cA + hstep, voffA);
        if (wr == 1) PG8_BAR;
        PG8_WAIT_V(2); PG8_BAR;
        PG8_STAGE(PG8_SB(1, 0), cB + kstep, voffB); PG8_STAGE(PG8_SA(1, 0), cA + kstep, voffA); PG8_STAGE(PG8_SB(1, 1), cB + hstep + kstep, voffB);
        PG8_WAIT_V(6); PG8_BAR;
    } else {
        PG8_STAGE(PG8_SB(0, 0), cB, voffB); PG8_STAGE(PG8_SA(0, 0), cA, voffA); PG8_STAGE(PG8_SB(0, 1), cB + hstep, voffB); PG8_STAGE(PG8_SA(0, 1), cA + hstep, voffA);
        if (wr == 1) PG8_BAR;
        PG8_WAIT_V(4); PG8_BAR;
        PG8_STAGE(PG8_SB(1, 0), cB + kstep, voffB); PG8_STAGE(PG8_SA(1, 0), cA + kstep, voffA); PG8_STAGE(PG8_SB(1, 1), cB + hstep + kstep, voffB);
        PG8_WAIT_V(6); PG8_BAR;
    }
    for (;;) {
        const bool has_next = S.next(ui + 1, nxt);
        const char* nA = has_next ? (const char*)g.A + (size_t)nxt.pm * tstep : cA; const char* nB = has_next ? (const char*)g.Bt + (size_t)nxt.pn * tstep + (size_t)nxt.pe * g.bstride : cB;
#pragma unroll 1
        for (int t = 0; t < nt; t += 2) {
            const bool last = (t == nt - 2);
            const char* a1 = cA + (size_t)(t + 1) * kstep;
            const char* a2 = last ? nA : cA + (size_t)(t + 2) * kstep; const char* b2 = last ? nB : cB + (size_t)(t + 2) * kstep;
            const char* a3 = a2 + kstep; const char* b3 = b2 + kstep;
            if (last && has_next) S.a_ready(nxt);
            if constexpr (SP2) {
            PG8_LDB(B0, 0, 0); PG8_LDB(B1, 0, 1); PG8_SCHED; PG8_LDA(At, 0, 0); PG8_STAGE(PG8_SA(1, 1), a1 + hstep, voffA);
            PG8_WAIT_V(8); PG8_WAIT_L(0); PG8_BAR; PG8_MMA(0, 0, At, B0); PG8_MMA(0, 1, At, B1); PG8_BAR; PG8_SCHED;
            PG8_LDA(At, 0, 1); PG8_STAGE(PG8_SB(0, 0), b2, voffB); PG8_STAGE(PG8_SB(0, 1), b2 + hstep, voffB); PG8_STAGE(PG8_SA(0, 0), a2, voffA);
            PG8_WAIT_V(8); PG8_WAIT_L(0); PG8_BAR; PG8_MMA(1, 0, At, B0); PG8_MMA(1, 1, At, B1); PG8_BAR; PG8_SCHED;
            PG8_LDB(B0, 1, 0); PG8_LDB(B1, 1, 1); PG8_SCHED; PG8_LDA(At, 1, 0); PG8_STAGE(PG8_SA(0, 1), a2 + hstep, voffA);
            PG8_WAIT_V(8); PG8_WAIT_L(0); PG8_BAR; PG8_MMA(0, 0, At, B0); PG8_MMA(0, 1, At, B1); PG8_BAR; PG8_SCHED;
            PG8_LDA(At, 1, 1); PG8_STAGE(PG8_SB(1, 0), b3, voffB); PG8_STAGE(PG8_SB(1, 1), b3 + hstep, voffB); PG8_STAGE(PG8_SA(1, 0), a3, voffA);
            PG8_WAIT_V(8); PG8_WAIT_L(0); PG8_BAR; PG8_MMA(1, 0, At, B0); PG8_MMA(1, 1, At, B1); PG8_BAR; PG8_SCHED;
            } else {
            PG8_LDB(B0, 0, 0); PG8_SCHED; PG8_LDA(At, 0, 0); PG8_STAGE(PG8_SA(1, 1), a1 + hstep, voffA);
            PG8_WAIT_L(8); PG8_BAR; PG8_WAIT_L(0); PG8_MMA(0, 0, At, B0); PG8_BAR; PG8_SCHED;
            PG8_LDB(B1, 0, 1); PG8_STAGE(PG8_SB(0, 0), b2, voffB);
            PG8_BAR; PG8_WAIT_L(0); PG8_MMA(0, 1, At, B1); PG8_BAR;
            PG8_LDA(At, 0, 1); PG8_STAGE(PG8_SA(0, 0), a2, voffA);
            PG8_BAR; PG8_WAIT_L(0); PG8_MMA(1, 0, At, B0); PG8_BAR; PG8_SCHED;
            PG8_STAGE(PG8_SB(0, 1), b2 + hstep, voffB);
            PG8_WAIT_V(6); PG8_BAR; PG8_MMA(1, 1, At, B1); PG8_BAR;
            PG8_LDB(B0, 1, 0); PG8_SCHED; PG8_LDA(At, 1, 0); PG8_STAGE(PG8_SA(0, 1), a2 + hstep, voffA);
            PG8_WAIT_L(8); PG8_BAR; PG8_WAIT_L(0); PG8_MMA(0, 0, At, B0); PG8_BAR; PG8_SCHED;
            PG8_LDB(B1, 1, 1); PG8_STAGE(PG8_SB(1, 0), b3, voffB);
            PG8_BAR; PG8_WAIT_L(0); PG8_MMA(0, 1, At, B1); PG8_BAR;
            PG8_LDA(At, 1, 1); PG8_STAGE(PG8_SA(1, 0), a3, voffA);
            PG8_BAR; PG8_WAIT_L(0); PG8_MMA(1, 0, At, B0); PG8_BAR; PG8_SCHED;
            PG8_STAGE(PG8_SB(1, 1), b3 + hstep, voffB);
            PG8_WAIT_V(6); PG8_BAR; PG8_MMA(1, 1, At, B1); PG8_BAR;
            }
        }
        if constexpr (ALIGN_EPI) { if (wr == 0) PG8_BAR; }
        if constexpr (!Epi::AFTER_DRAIN) { if constexpr (FP8) asm volatile("s_nop 15\n\ts_nop 15" ::: "memory"); int t2_ = tid; asm volatile("" : "+v"(t2_)); const int l2_ = t2_ & 63; E(acc, cur, wr, wc, l2_ & 15, l2_ >> 4); S.done(cur); }
        if (!has_next) break;
#pragma unroll
        for (int a = 0; a < 2; ++a)
#pragma unroll
            for (int b = 0; b < 2; ++b)
#pragma unroll
                for (int m = 0; m < 4; ++m)
#pragma unroll
                    for (int n = 0; n < 2; ++n) acc[a][b][m][n] = (f32x4){0.f, 0.f, 0.f, 0.f};
        cur = nxt; cA = nA; cB = nB; ++ui;
        if constexpr (ALIGN_EPI) { if (wr == 1) PG8_BAR; }
    }
    PG8_WAIT_V(0);
    if constexpr (!ALIGN_EPI) { if (wr == 0) PG8_BAR; }
    PG8_BAR;
    if constexpr (Epi::AFTER_DRAIN) { E.fused(acc, cur, wr, wc, fr, fq, lds, wid, lane); S.done(cur); }
#undef PG8_SA
#undef PG8_SB
#undef PG8_STAGE
#undef PG8_LDA
#undef PG8_LDB
#undef PG8_MMA
#undef PG8_WAIT_V
#undef PG8_WAIT_L
#undef PG8_BAR
#undef PG8_SCHED
}
}
#include <hip/hip_bf16.h>
#include <cmath>
namespace attn_body {
using bf16=__hip_bfloat16;
using bf16x8=__attribute__((ext_vector_type(8)))short;
using s16x4=__attribute__((ext_vector_type(4)))short;
using f32x16=__attribute__((ext_vector_type(16)))float;
using u32x4=__attribute__((ext_vector_type(4)))unsigned;
constexpr int BATCH=4,SEQ=4096,D=64,PQ=3328,PKV=3328,PO=1024;
constexpr int NW=8,QBLK=32,QB=QBLK*NW,KVBLK=64,NQB=SEQ/QB;
constexpr int ATTN_UNIT_ROWS=QB; typedef float f32x4_t __attribute__((ext_vector_type(4)));
__device__ __forceinline__ int crow(int r,int hi){return (r&3)+8*(r>>2)+4*hi;}
#define SBAR() __builtin_amdgcn_sched_barrier(0)
__device__ __forceinline__ void cmask(f32x16&p0,f32x16&p1,int jb,int qrel,int hi){
  const float NEG=-INFINITY; int kb=64*jb+4*hi;
  #pragma unroll
  for(int r=0;r<16;++r){int kv=kb+(r&3)+8*(r>>2); if(kv>qrel)p0[r]=NEG; if(kv+32>qrel)p1[r]=NEG;}
}

constexpr int NSLOT=3, SLOTB=8192;
constexpr int VSLOTB=2*SLOTB; constexpr int LDS_K=0, LDS_V=NSLOT*SLOTB, LDS_WS=NSLOT*SLOTB+NSLOT*VSLOTB, LDS_OST=LDS_WS+NW*64*4, LDS_BYTES=LDS_OST+NW*4096;
constexpr float C2=0.125f*1.4426950408889634f;
__device__ __forceinline__ void glds16(const void*gsrc,unsigned lds_dst){unsigned keep;
  asm volatile("s_mov_b32 %0, m0\n\ts_mov_b32 m0, %2\n\ts_nop 0\n\tglobal_load_lds_dwordx4 %1, off\n\ts_mov_b32 m0, %0":"=&s"(keep):"v"(gsrc),"s"(lds_dst):"memory");}
__device__ __forceinline__ float max3f(float a,float b,float c){float r;asm("v_max3_f32 %0, %1, %2, %3":"=v"(r):"v"(a),"v"(b),"v"(c));return r;}
__device__ __forceinline__ float max2f(float a,float b){float r;asm("v_max_f32_e32 %0, %1, %2":"=v"(r):"v"(a),"v"(b));return r;}
__device__ __forceinline__ float fadd_s(float a,float b){float r;asm("v_add_f32_e32 %0, %1, %2":"=v"(r):"v"(a),"v"(b));return r;}
__device__ __forceinline__ float fsub_s(float a,float b){float r;asm("v_sub_f32_e32 %0, %1, %2":"=v"(r):"v"(a),"v"(b));return r;}
typedef float f32x2_t __attribute__((ext_vector_type(2))); typedef __bf16 bf16x2_t __attribute__((ext_vector_type(2)));
__device__ __forceinline__ unsigned cvtpk_s(float lo,float hi){f32x2_t v={lo,hi};bf16x2_t b=__builtin_convertvector(v,bf16x2_t);return __builtin_bit_cast(unsigned,b);}
#define WAIT_BAR(N) asm volatile("s_waitcnt vmcnt(" #N ") lgkmcnt(0)\n\ts_barrier":::"memory")

__device__ __forceinline__ void qkt(f32x16&p0,f32x16&p1,const char*Kslot,const bf16x8*qr,const f32x16&negm,int r32,int hi){
  const char*kb=Kslot+hi*1024+r32*16;
  #pragma unroll
  for(int d0=0;d0<4;++d0){
    const bf16x8 b0=*reinterpret_cast<const bf16x8*>(kb+d0*2048);
    const bf16x8 b1=*reinterpret_cast<const bf16x8*>(kb+d0*2048+512);
    if(d0==0){p0=__builtin_amdgcn_mfma_f32_32x32x16_bf16(b0,qr[0],negm,0,0,0);p1=__builtin_amdgcn_mfma_f32_32x32x16_bf16(b1,qr[0],negm,0,0,0);}
    else{p0=__builtin_amdgcn_mfma_f32_32x32x16_bf16(b0,qr[d0],p0,0,0,0);p1=__builtin_amdgcn_mfma_f32_32x32x16_bf16(b1,qr[d0],p1,0,0,0);}}
}
typedef __attribute__((address_space(3))) const char* lds_cptr;
typedef short v4i16_t __attribute__((ext_vector_type(4)));
__device__ __forceinline__ void kload8(bf16x8*kf,lds_cptr kp){
  kf[0]=*(const __attribute__((address_space(3))) bf16x8*)(kp);      kf[1]=*(const __attribute__((address_space(3))) bf16x8*)(kp+512);
  kf[2]=*(const __attribute__((address_space(3))) bf16x8*)(kp+2048); kf[3]=*(const __attribute__((address_space(3))) bf16x8*)(kp+2560);
  kf[4]=*(const __attribute__((address_space(3))) bf16x8*)(kp+4096); kf[5]=*(const __attribute__((address_space(3))) bf16x8*)(kp+4608);
  kf[6]=*(const __attribute__((address_space(3))) bf16x8*)(kp+6144); kf[7]=*(const __attribute__((address_space(3))) bf16x8*)(kp+6656);
}
__device__ __forceinline__ void kload2(bf16x8*kf,lds_cptr kp,int j){ kf[2*j]=*(const __attribute__((address_space(3))) bf16x8*)(kp+j*2048); kf[2*j+1]=*(const __attribute__((address_space(3))) bf16x8*)(kp+j*2048+512); }
__device__ __forceinline__ s16x4 vtr(lds_cptr p){ return __builtin_bit_cast(s16x4,__builtin_amdgcn_ds_read_tr16_b64_v4i16((__attribute__((address_space(3))) v4i16_t*)p)); }
__device__ __forceinline__ float rowmax(const f32x16&p0,const f32x16&p1){
  float a=max3f(p0[0],p0[1],p1[0]),b=max3f(p0[2],p0[3],p1[1]);a=max3f(a,p1[2],p1[3]);
  #pragma unroll
  for(int r=4;r<16;r+=4){a=max3f(a,p0[r],p0[r+1]);b=max3f(b,p0[r+2],p0[r+3]);a=max3f(a,p1[r],p1[r+1]);b=max3f(b,p1[r+2],p1[r+3]);}
  const float m=max2f(a,b);
  auto rr=__builtin_amdgcn_permlane32_swap(__float_as_uint(m),__float_as_uint(m),false,false);
  return max2f(__uint_as_float(rr[0]),__uint_as_float(rr[1]));
}
__device__ __forceinline__ void pv(f32x16*o,int vb,bf16x8 pa0,bf16x8 pa1,bf16x8 pa2,bf16x8 pa3){
  #pragma unroll
  for(int d0=0;d0<2;++d0){s16x4 lo[4],hi[4];
    #pragma unroll
    for(int ks=0;ks<4;++ks){
      asm volatile("ds_read_b64_tr_b16 %0,%1 offset:%c2":"=&v"(lo[ks]):"v"(vb),"i"(d0*4096+ks*1024):"memory");
      asm volatile("ds_read_b64_tr_b16 %0,%1 offset:%c2":"=&v"(hi[ks]):"v"(vb),"i"(d0*4096+ks*1024+512):"memory");}
    asm volatile("s_waitcnt lgkmcnt(0)":::"memory");SBAR();
    #define PK(k) (bf16x8){lo[k][0],lo[k][1],lo[k][2],lo[k][3],hi[k][0],hi[k][1],hi[k][2],hi[k][3]}
    o[d0]=__builtin_amdgcn_mfma_f32_32x32x16_bf16(pa0,PK(0),o[d0],0,0,0);
    o[d0]=__builtin_amdgcn_mfma_f32_32x32x16_bf16(pa1,PK(1),o[d0],0,0,0);
    o[d0]=__builtin_amdgcn_mfma_f32_32x32x16_bf16(pa2,PK(2),o[d0],0,0,0);
    o[d0]=__builtin_amdgcn_mfma_f32_32x32x16_bf16(pa3,PK(3),o[d0],0,0,0);
    #undef PK
  }
}

#ifndef ATTN_STORE16
#define ATTN_STORE16(p,v) (*(u32x4*)(p)=(v))
#endif
template<int THRL,bool BIAS,bool DV2> __device__ __forceinline__ void attn_unit(int b,int qb,const bf16*Q,const bf16*__restrict__ K,const bf16*__restrict__ V,bf16*O,char*shm,const __attribute__((address_space(3))) float*kbias,const int tid){
  const int lane=tid&63,r32=lane&31,hi=lane>>5; const int wid=__builtin_amdgcn_readfirstlane(tid>>6);
  const long rowbase=(long)b*SEQ; const int q0=qb*QB;
  const bf16*Qw=Q+(rowbase+q0+wid*QBLK)*PQ;
  const bf16*Kh=K+rowbase*PKV,*Vh=V+rowbase*PKV;
  const unsigned lds0=(unsigned)(uintptr_t)shm;
  float*wsf=(float*)(shm+LDS_WS)+wid*64;
  const bf16*ksrc=Kh+(long)lane*PKV+wid*8;
  const bf16*vsrc=Vh+(long)(16*(wid&3)+(lane>>2))*PKV+(wid>>2)*32+(lane&3)*8;
  const unsigned kdst=lds0+LDS_K+wid*1024, vdst=lds0+LDS_V+wid*1024;
  #define DMA_K(t,slot) glds16(ksrc+(long)(t)*KVBLK*PKV,(unsigned)__builtin_amdgcn_readfirstlane(kdst+(slot)))
  #define DMA_V(t,slot) do{ glds16(vsrc+(long)(t)*KVBLK*PKV,(unsigned)__builtin_amdgcn_readfirstlane(vdst+2*(slot))); if(DV2) glds16(vsrc+64+(long)(t)*KVBLK*PKV,(unsigned)__builtin_amdgcn_readfirstlane(vdst+2*(slot)+8192)); }while(0)
  const int vb0=(int)(lds0+LDS_V)+((lane>>4)&1)*32+(lane&3)*8+(4*hi+((lane&15)>>2))*64;
  const char*Kbase=shm+LDS_K; bf16x8 kf[8];
  const lds_cptr shm3=(lds_cptr)shm; const lds_cptr kp0=shm3+LDS_K+hi*1024+r32*16; const lds_cptr vp0=shm3+LDS_V+((lane>>4)&1)*32+(lane&3)*8+(4*hi+((lane&15)>>2))*64;
  const int NT=(q0+QB)/KVBLK;
  DMA_K(0,0);DMA_V(0,0);DMA_K(1,SLOTB);
  bf16x8 qr[4];
  #pragma unroll
  for(int d0=0;d0<4;++d0)qr[d0]=*reinterpret_cast<const bf16x8*>(&Qw[(long)r32*PQ+d0*16+hi*8]);
  const __attribute__((address_space(3))) char* qst_=(const __attribute__((address_space(3))) char*)((lds_cptr)shm+LDS_OST+wid*4096+lane*16);
  constexpr bool QPARK=false;
  if(DV2&&QPARK){ _Pragma("unroll") for(int d0=0;d0<4;++d0)*(__attribute__((address_space(3))) bf16x8*)(qst_+d0*1024)=qr[d0]; }
  #define QF(j) ((DV2&&QPARK)?*(const __attribute__((address_space(3))) bf16x8*)(qst_+(j)*1024):qr[j])
  float mhat=0.f,l_reg=0.f;f32x16 o[4];o[0]=f32x16{};o[1]=f32x16{};o[2]=f32x16{};o[3]=f32x16{};const f32x16 negm=f32x16{}; const float kbq=BIAS?kbias[q0+wid*QBLK+r32]:0.f;
  const int qrel=wid*QBLK+r32;
  #define CMASK(P0,P1,t) do{int jb_=(t)-(NT-4); if(jb_>=0)cmask(P0,P1,jb_,qrel,hi);}while(0)
  bool resc=false;
  #define START(P0,P1) do{ const float rm=rowmax(P0,P1); resc=false; \
    mhat=rm; const float mo_=BIAS?mhat+kbq:mhat; \
    _Pragma("unroll") for(int r=0;r<16;++r)P0[r]=__builtin_amdgcn_exp2f((BIAS?P0[r]+kbias[crow(r,hi)]:P0[r])-mo_); \
    _Pragma("unroll") for(int r=0;r<16;++r)P1[r]=__builtin_amdgcn_exp2f((BIAS?P1[r]+kbias[32+crow(r,hi)]:P1[r])-mo_); }while(0)
  #define RESC() do{ if(resc){ asm volatile("s_waitcnt lgkmcnt(0)":::"memory"); \
      _Pragma("unroll") for(int d_=0;d_<(DV2?4:2);++d_) _Pragma("unroll") for(int r=0;r<16;++r)o[d_][r]*=wsf[crow(r,hi)]; } }while(0)
  f32x16 pA0,pA1,pB0,pB1;
  int sl_prev=0,sl_cur=0,sl_next=SLOTB;
  #define ROT() do{sl_prev=sl_cur;sl_cur=sl_next;sl_next=(sl_next==(NSLOT-1)*SLOTB)?0:sl_next+SLOTB;}while(0)
  DMA_K(2,2*SLOTB);
  if(DV2){WAIT_BAR(4);}else{WAIT_BAR(3);}
  qkt(pA0,pA1,Kbase,qr,negm,r32,hi);asm volatile("s_nop 15\n\ts_nop 7":"+v"(pA0),"+v"(pA1));CMASK(pA0,pA1,0);
  START(pA0,pA1);
  WAIT_BAR(0);
  DMA_K(3,0);DMA_V(1,SLOTB);
  ROT();
  kload8(kf,kp0+sl_cur);
  if(DV2){WAIT_BAR(3);}else{WAIT_BAR(2);}
  s16x4 vlo[8],vhi[8]; u32x4 pw0,pw1,pw2,pw3;
  #define PKW(P,B) cvtpk_s(P[B],P[B+1])
  #define PAF(k) __builtin_bit_cast(bf16x8,pw##k)
  #define VFR(i) (bf16x8){vlo[i][0],vlo[i][1],vlo[i][2],vlo[i][3],vhi[i][0],vhi[i][1],vhi[i][2],vhi[i][3]}
  #define PIN(x) asm volatile("":"+v"(x))
  #define MX3(a,b,c) __builtin_fmaxf(__builtin_fmaxf((a),(b)),(c))
  #define GAPA(MF,A0,A1,A2,A3,W0,W1,PW) do{ MF; sacc+=A0; sacc+=A1; sacc+=A2; sacc+=A3; PIN(sacc); W0; W1; PIN(PW); SBAR(); }while(0)
  #define EX(v) __builtin_amdgcn_exp2f(v)
  #define GAPB(MF,X,B,IDX) do{ f32x4_t bq_; if(BIAS)bq_=bp_[IDX]; MF; if(BIAS){ X[B]=EX((X[B]+bq_[0])-mo_); X[B+1]=EX((X[B+1]+bq_[1])-mo_); X[B+2]=EX((X[B+2]+bq_[2])-mo_); X[B+3]=EX((X[B+3]+bq_[3])-mo_); } else { X[B]=EX(X[B]-mo_); X[B+1]=EX(X[B+1]-mo_); X[B+2]=EX(X[B+2]-mo_); X[B+3]=EX(X[B+3]-mo_); } PIN(X); SBAR(); }while(0)
  #define VRD(i) do{ vlo[i]=vtr(vp_+(((i)>>2)*4096+((i)&3)*1024)); vhi[i]=vtr(vp_+(((i)>>2)*4096+((i)&3)*1024+512)); }while(0)
  #define VRD2(i) do{ if(DV2){ vlo[i]=vtr(vp_+8192+(((i)>>2)*4096+((i)&3)*1024)); vhi[i]=vtr(vp_+8192+(((i)>>2)*4096+((i)&3)*1024+512)); SBAR(); } }while(0)
  #define GAPX(MF,X,B,IDX,I,XE) do{ if(DV2){ MF; XE[2*(I)]=EX(XE[2*(I)]-mo_); XE[2*(I)+1]=EX(XE[2*(I)+1]-mo_); PIN(XE); SBAR(); } else { GAPB(MF,X,B,IDX); } }while(0)
  #define KRD(G,j) do{ if(G){ kload2(kf,kp0+sl_next,j); SBAR(); } }while(0)
  #define STEP(C0,C1,P0,P1,t,GK,GV,GL) do{ SBAR(); \
    const lds_cptr vp_=vp0+2*sl_prev; const __attribute__((address_space(3))) f32x4_t* bp_=(const __attribute__((address_space(3))) f32x4_t*)(kbias+64*(t))+hi; \
    VRD(0); SBAR(); float sacc=(P0[0]+P0[1]); \
    GAPA(C0=__builtin_amdgcn_mfma_f32_32x32x16_bf16(kf[0],QF(0),negm,0,0,0), P0[2],P0[3],P0[4],P0[5],     pw0[0]=PKW(P0,0), pw0[1]=PKW(P0,2), pw0); \
    VRD(4); SBAR(); GAPA(C1=__builtin_amdgcn_mfma_f32_32x32x16_bf16(kf[1],QF(0),negm,0,0,0), P0[6],P0[7],P0[8],P0[9],     pw0[2]=PKW(P0,4), pw0[3]=PKW(P0,6), pw0); \
    VRD(1); SBAR(); GAPA(C0=__builtin_amdgcn_mfma_f32_32x32x16_bf16(kf[2],QF(1),C0,0,0,0),   P0[10],P0[11],P0[12],P0[13], pw1[0]=PKW(P0,8), pw1[1]=PKW(P0,10), pw1); \
    VRD(5); SBAR(); GAPA(C1=__builtin_amdgcn_mfma_f32_32x32x16_bf16(kf[3],QF(1),C1,0,0,0),   P0[14],P0[15],P1[0],P1[1],   pw1[2]=PKW(P0,12),pw1[3]=PKW(P0,14), pw1); \
    VRD(2); SBAR(); GAPA(C0=__builtin_amdgcn_mfma_f32_32x32x16_bf16(kf[4],QF(2),C0,0,0,0),   P1[2],P1[3],P1[4],P1[5],     pw2[0]=PKW(P1,0), pw2[1]=PKW(P1,2), pw2); \
    VRD(6); SBAR(); GAPA(C1=__builtin_amdgcn_mfma_f32_32x32x16_bf16(kf[5],QF(2),C1,0,0,0),   P1[6],P1[7],P1[8],P1[9],     pw2[2]=PKW(P1,4), pw2[3]=PKW(P1,6), pw2); \
    VRD(3); SBAR(); GAPA(C0=__builtin_amdgcn_mfma_f32_32x32x16_bf16(kf[6],QF(3),C0,0,0,0),   P1[10],P1[11],P1[12],P1[13], pw3[0]=PKW(P1,8), pw3[1]=PKW(P1,10), pw3); \
    VRD(7); SBAR(); GAPA(C1=__builtin_amdgcn_mfma_f32_32x32x16_bf16(kf[7],QF(3),C1,0,0,0),   P1[14],P1[15],0.f,0.f,       pw3[2]=PKW(P1,12),pw3[3]=PKW(P1,14), pw3); \
    l_reg+=sacc; \
    if(GK){DMA_K((t)+3,sl_cur);} if(GV){DMA_V((t)+1,sl_next);} \
    CMASK(C0,C1,t); \
    { float a=MX3(C0[0],C0[1],C1[0]),b=MX3(C0[2],C0[3],C1[1]); a=MX3(a,C1[2],C1[3]); \
      _Pragma("unroll") for(int r=4;r<16;r+=4){a=MX3(a,C0[r],C0[r+1]);b=MX3(b,C0[r+2],C0[r+3]);a=MX3(a,C1[r],C1[r+1]);b=MX3(b,C1[r+2],C1[r+3]);} \
      float rm=__builtin_fmaxf(a,b); { auto rr=__builtin_amdgcn_permlane32_swap(__float_as_uint(rm),__float_as_uint(rm),false,false); rm=__builtin_fmaxf(__uint_as_float(rr[0]),__uint_as_float(rr[1])); } rm-=mhat; \
      resc=false; \
      if(__builtin_expect(__any(rm>(float)THRL),0)){ const float dl=__builtin_fmaxf(rm,0.f); mhat+=dl; \
        const float f=__builtin_amdgcn_exp2f(-dl); l_reg*=f; if(hi==0)wsf[r32]=f; resc=true; } } const float mo_=BIAS?mhat+kbq:mhat; \
    SBAR(); \
    GAPX(o[0]=__builtin_amdgcn_mfma_f32_32x32x16_bf16(PAF(0),VFR(0),o[0],0,0,0), C0,0,0,0,C0); VRD2(0); \
    GAPX(o[1]=__builtin_amdgcn_mfma_f32_32x32x16_bf16(PAF(0),VFR(4),o[1],0,0,0), C0,4,2,1,C0); VRD2(4); \
    KRD(GL,0); GAPX(o[0]=__builtin_amdgcn_mfma_f32_32x32x16_bf16(PAF(1),VFR(1),o[0],0,0,0), C0,8,4,2,C0); VRD2(1); \
    KRD(GL,1); GAPX(o[1]=__builtin_amdgcn_mfma_f32_32x32x16_bf16(PAF(1),VFR(5),o[1],0,0,0), C0,12,6,3,C0); VRD2(5); \
    KRD(GL,2); GAPX(o[0]=__builtin_amdgcn_mfma_f32_32x32x16_bf16(PAF(2),VFR(2),o[0],0,0,0), C1,0,8,4,C0); VRD2(2); \
    KRD(GL,3); GAPX(o[1]=__builtin_amdgcn_mfma_f32_32x32x16_bf16(PAF(2),VFR(6),o[1],0,0,0), C1,4,10,5,C0); VRD2(6); \
    GAPX(o[0]=__builtin_amdgcn_mfma_f32_32x32x16_bf16(PAF(3),VFR(3),o[0],0,0,0), C1,8,12,6,C0); VRD2(3); \
    GAPX(o[1]=__builtin_amdgcn_mfma_f32_32x32x16_bf16(PAF(3),VFR(7),o[1],0,0,0), C1,12,14,7,C0); VRD2(7); \
    if(DV2){ o[2]=__builtin_amdgcn_mfma_f32_32x32x16_bf16(PAF(0),VFR(0),o[2],0,0,0); C1[0]=EX(C1[0]-mo_); C1[1]=EX(C1[1]-mo_); PIN(C1); SBAR(); o[3]=__builtin_amdgcn_mfma_f32_32x32x16_bf16(PAF(0),VFR(4),o[3],0,0,0); C1[2]=EX(C1[2]-mo_); C1[3]=EX(C1[3]-mo_); PIN(C1); SBAR(); o[2]=__builtin_amdgcn_mfma_f32_32x32x16_bf16(PAF(1),VFR(1),o[2],0,0,0); C1[4]=EX(C1[4]-mo_); C1[5]=EX(C1[5]-mo_); PIN(C1); SBAR(); o[3]=__builtin_amdgcn_mfma_f32_32x32x16_bf16(PAF(1),VFR(5),o[3],0,0,0); C1[6]=EX(C1[6]-mo_); C1[7]=EX(C1[7]-mo_); PIN(C1); SBAR(); \
      o[2]=__builtin_amdgcn_mfma_f32_32x32x16_bf16(PAF(2),VFR(2),o[2],0,0,0); C1[8]=EX(C1[8]-mo_); C1[9]=EX(C1[9]-mo_); PIN(C1); SBAR(); o[3]=__builtin_amdgcn_mfma_f32_32x32x16_bf16(PAF(2),VFR(6),o[3],0,0,0); C1[10]=EX(C1[10]-mo_); C1[11]=EX(C1[11]-mo_); PIN(C1); SBAR(); o[2]=__builtin_amdgcn_mfma_f32_32x32x16_bf16(PAF(3),VFR(3),o[2],0,0,0); C1[12]=EX(C1[12]-mo_); C1[13]=EX(C1[13]-mo_); PIN(C1); SBAR(); o[3]=__builtin_amdgcn_mfma_f32_32x32x16_bf16(PAF(3),VFR(7),o[3],0,0,0); C1[14]=EX(C1[14]-mo_); C1[15]=EX(C1[15]-mo_); PIN(C1); SBAR(); } \
    }while(0)
  int t=1;
  #undef CMASK
  #define CMASK(P0,P1,t) do{}while(0)
  for(;t+5<NT;t+=2){
    STEP(pB0,pB1,pA0,pA1,t,true,true,true);     if(DV2){WAIT_BAR(3);}else{WAIT_BAR(2);} RESC(); ROT();
    STEP(pA0,pA1,pB0,pB1,t+1,true,true,true);   if(DV2){WAIT_BAR(3);}else{WAIT_BAR(2);} RESC(); ROT();
  }
  #undef CMASK
  #define CMASK(P0,P1,t) do{int jb_=(t)-(NT-4); if(jb_>=0)cmask(P0,P1,jb_,qrel,hi);}while(0)
  #define ENDW(tt) do{ if((tt)+3<NT){ if(DV2){WAIT_BAR(3);}else{WAIT_BAR(2);} } else if((tt)+2<NT){ if(DV2){WAIT_BAR(2);}else{WAIT_BAR(1);} } else {WAIT_BAR(0);} }while(0)
  for(;t+1<NT;t+=2){
    STEP(pB0,pB1,pA0,pA1,t,(t+3<NT),(t+1<NT),(t+1<NT));       ENDW(t);   RESC(); ROT();
    STEP(pA0,pA1,pB0,pB1,t+1,(t+4<NT),(t+2<NT),(t+2<NT));     ENDW(t+1); RESC(); ROT();
  }
  STEP(pB0,pB1,pA0,pA1,NT-1,false,false,false); RESC();
  { float sacc=pB0[0]+pB0[1]; _Pragma("unroll") for(int r=2;r<16;++r)sacc+=pB0[r]; _Pragma("unroll") for(int r=0;r<16;++r)sacc+=pB1[r]; l_reg+=sacc;
    pw0=(u32x4){PKW(pB0,0),PKW(pB0,2),PKW(pB0,4),PKW(pB0,6)};pw1=(u32x4){PKW(pB0,8),PKW(pB0,10),PKW(pB0,12),PKW(pB0,14)};pw2=(u32x4){PKW(pB1,0),PKW(pB1,2),PKW(pB1,4),PKW(pB1,6)};pw3=(u32x4){PKW(pB1,8),PKW(pB1,10),PKW(pB1,12),PKW(pB1,14)};
    SBAR(); pv(o,vb0+2*sl_cur,PAF(0),PAF(1),PAF(2),PAF(3)); if(DV2){ SBAR(); pv(o+2,vb0+2*sl_cur+8192,PAF(0),PAF(1),PAF(2),PAF(3)); } }
  #undef PKW
  #undef PAF
  #undef VFR
  #undef PIN
  #undef MX3
  #undef GAPA
  #undef GAPB
  #undef EX
  #undef VRD
  #undef KRD
  #undef VRD2
  #undef GAPX
  #undef STEP
  #undef ENDW
  {auto rr=__builtin_amdgcn_permlane32_swap(__float_as_uint(l_reg),__float_as_uint(l_reg),false,false);l_reg=__uint_as_float(rr[0])+__uint_as_float(rr[1]);}
  if(hi==0)wsf[32+r32]=l_reg;asm volatile("s_waitcnt lgkmcnt(0)":::"memory");
  float rli[16];
  #pragma unroll
  for(int r=0;r<16;++r)rli[r]=__builtin_amdgcn_rcpf(wsf[32+crow(r,hi)]);
  bf16*Ow=O+(rowbase+q0+wid*QBLK)*PO;
  { bf16*stg=(bf16*)(shm+LDS_OST)+wid*2048;
    #pragma unroll
    for(int h2=0;h2<(DV2?2:1);++h2){
    #pragma unroll
    for(int r=0;r<16;++r){const int orow=crow(r,hi);
      #pragma unroll
      for(int d0=0;d0<2;++d0)stg[orow*64+d0*32+r32]=__float2bfloat16(o[2*h2+d0][r]*rli[r]);}
    asm volatile("s_waitcnt lgkmcnt(0)":::"memory");
    #pragma unroll
    for(int i=0;i<4;++i){const int row=i*8+(lane>>3),ch=lane&7; const u32x4 v=*(const u32x4*)(stg+row*64+ch*8); ATTN_STORE16(Ow+(long)row*PO+64*h2+ch*8,v);}
    asm volatile("s_waitcnt lgkmcnt(0)":::"memory"); } }
  asm volatile("s_waitcnt lgkmcnt(0)\n\ts_barrier":::"memory");
  #undef DMA_K
  #undef QF
  #undef DMA_V
  #undef CMASK
  #undef START
  #undef RESC
  #undef ROT
}
constexpr int ATTN_LDS_BYTES=LDS_BYTES;
#undef SBAR
#undef WAIT_BAR
}

constexpr int NWAVES = 8;
constexpr int BATCH = 4, SEQ = 4096, NTOK = BATCH * SEQ, D = 1024, DEPTH = 2;
constexpr int INC = 3332, PROJ_P = 3328, NIN = 3584;
constexpr int FFD = 2816, NGUD = 2 * FFD, NE = 8, FFE = 3584, NGUE = 2 * FFE, PLE = 256;
constexpr int MP_MAX = 2 * NTOK + NE * 256;
constexpr float EPS = 1e-6f;
constexpr int C_QA = 0, C_KA = 512, C_VA = 1024, C_QB = 1536, C_KB = 1792, C_VB = 2048, C_QC = 2304, C_KC = 2560, C_VC = 2816, C_GC = 3072;

constexpr size_t MiB = 1u << 20, KiB = 1u << 10;
constexpr size_t WS_CTL = 0, CTL_ZERO_BYTES = 32 * KiB;
constexpr size_t WS_STATS0 = 1 * MiB, WS_STATS1 = 2 * MiB;
constexpr size_t WS_LOGF = 3 * MiB;
constexpr size_t WS_RCOS = 3 * MiB + 256 * KiB, WS_RSIN = 3 * MiB + 768 * KiB;
constexpr size_t WS_E12 = 4 * MiB + 256 * KiB, WS_G12 = WS_E12 + 128 * KiB, WS_POS = WS_G12 + 128 * KiB;
constexpr size_t WS_DST = WS_POS + 128 * KiB, WS_GSORT = WS_DST + 256 * KiB;
static_assert(WS_GSORT + 256 * KiB <= 6 * MiB, "small region");
constexpr size_t WS_WIN1 = 6 * MiB, WS_WOUT1 = WS_WIN1 + 7 * MiB, WS_PG1 = WS_WOUT1 + 2 * MiB, WS_PPW1 = WS_PG1 + 2 * MiB, WS_P1 = WS_PPW1 + 512 * KiB;
constexpr size_t WS_MGU = WS_P1 + 8 * MiB, WS_MD = WS_MGU + 112 * MiB, WS_HB = WS_MD + 56 * MiB;
constexpr size_t WS_PROJ = WS_HB + 32 * MiB, WS_OA = WS_PROJ + 104 * MiB, WS_OCAT = WS_OA + 32 * MiB;
constexpr size_t WS_ACTD = WS_PROJ, WS_PP = WS_OA;
constexpr size_t WS_WIN0 = WS_OCAT + 32 * MiB, WS_WOUT0 = WS_WIN0 + 7 * MiB, WS_DGU = WS_WOUT0 + 2 * MiB, WS_DD = WS_DGU + 11 * MiB, WS_PG0 = WS_DD + 5632 * KiB, WS_PPW0 = WS_PG0 + 2 * MiB, WS_P0 = WS_PPW0 + 512 * KiB;
constexpr size_t WS_H8 = WS_MD + 28 * MiB;
constexpr size_t WS_ACTE = WS_HB;
constexpr size_t WS_XS = WS_ACTE + (size_t)MP_MAX * FFE * 2;
constexpr size_t WS_END = WS_XS + (size_t)MP_MAX * D * 2;
static_assert(WS_P0 + 8 * MiB <= WS_XS && WS_MD + 56 * MiB == WS_HB && (size_t)NTOK * PROJ_P * 2 == 104 * MiB && (size_t)NIN * D * 2 == 7 * MiB, "d_ws map");
static_assert((size_t)NGUD * D * 2 == 11 * MiB && (size_t)D * FFD * 2 == 5632 * KiB && (size_t)NE * NGUE * D * 2 == 112 * MiB && (size_t)NE * D * FFE * 2 == 56 * MiB, "d_ws map 2");
static_assert((4096 + 3456) * 4 <= (int)CTL_ZERO_BYTES, "barrier words inside the per-call memset");
constexpr int CW_TMO = 0, CW_Q = 64  , CW_CNT = 1024  , CW_BAR = 4096, CW_TS = 2048  ;

constexpr int RING_OFF = 0, RING_BYTES = 131072;
constexpr int LDSCTL_OFF = RING_BYTES, MISC_OFF = LDSCTL_OFF + 320, PT_OFF = LDSCTL_OFF + 512, RED_OFF = LDSCTL_OFF + 1024  ;
constexpr int LDS_BYTES = 147456;
static_assert(MISC_OFF + 128 <= LDS_BYTES, "LDS map");
#define GAS __attribute__((address_space(1)))
#define LAS __attribute__((address_space(3)))
typedef unsigned short bf16;
typedef unsigned v4u __attribute__((ext_vector_type(4)));
typedef float f32x4 __attribute__((ext_vector_type(4)));
typedef short bf16x8 __attribute__((ext_vector_type(8)));
typedef GAS unsigned gu32;
typedef GAS unsigned long long gu64;
#define RLX_AGENT __ATOMIC_RELAXED, __HIP_MEMORY_SCOPE_AGENT
#define LDS_WAIT() asm volatile("s_waitcnt lgkmcnt(0)" ::: "memory")
#define VM_WAIT() asm volatile("s_waitcnt vmcnt(0)" ::: "memory")
__device__ __forceinline__ unsigned long long rt() { return __builtin_amdgcn_s_memrealtime(); }
__device__ __forceinline__ unsigned f2bf(float f) { unsigned u = __builtin_bit_cast(unsigned, f); return (u + 0x7fffu + ((u >> 16) & 1u)) >> 16; }
__device__ __forceinline__ unsigned pk2(float lo, float hi) { return f2bf(lo) | (f2bf(hi) << 16); }

#define XB_TMO      128
#define XB_XCNT(j)  (256  + 64 * (j))
#define XB_XSUB(j)  (1280 + 64 * (j))
#define XB_XGEN(j)  (2304 + 64 * (j))
#define XB_TOP      3328
#define XB_TOPGEN   3392
#define XCD_BAR_WORDS 3456
#define XB_SPIN_CAP (1u << 18)

__device__ __forceinline__ unsigned xb_ld(unsigned* p)              { return __hip_atomic_load(p, __ATOMIC_RELAXED, __HIP_MEMORY_SCOPE_AGENT); }
__device__ __forceinline__ unsigned xb_add(unsigned* p, unsigned v) { return __hip_atomic_fetch_add(p, v, __ATOMIC_RELAXED, __HIP_MEMORY_SCOPE_AGENT); }
__device__ __forceinline__ unsigned xb_xcc_id() { return (unsigned)__builtin_amdgcn_s_getreg((3 << 11) | 20) & 0xFu; }
#define XB_SPIN(cond, bar) do { unsigned _sp = 0; while (cond) { __builtin_amdgcn_s_sleep(1); \
    if ((++_sp & 255u) == 0u) { if (xb_ld(&(bar)[XB_TMO])) break; if (_sp > XB_SPIN_CAP) { atomicAdd(&(bar)[XB_TMO], 1u); break; } } } } while (0)

struct XcdBarrier {
    unsigned* bar; unsigned x;
    volatile LAS unsigned* st;
};

__device__ __forceinline__ XcdBarrier xcd_barrier_post(unsigned* bar, volatile LAS unsigned* st) {
    XcdBarrier b; b.bar = bar; b.x = xb_xcc_id(); b.st = st;
    if (threadIdx.x == 0) (void)xb_add(&bar[XB_XCNT(b.x)], 1u);
    return b;
}
__device__ __forceinline__ void xcd_barrier_complete(unsigned* bar, unsigned x, unsigned& nloc, unsigned& nx) {
    const unsigned G = gridDim.x * gridDim.y * gridDim.z;
    unsigned sum, cnt, mine, sp = 0u;
    for (;;) {
        sum = 0u; cnt = 0u; mine = 0u;
#pragma unroll 1
        for (unsigned j = 0; j < 16; ++j) { const unsigned c = xb_ld(&bar[XB_XCNT(j)]); sum += c; cnt += (c > 0u) ? 1u : 0u; mine = (j == x) ? c : mine; }
        if (sum == G) break;
        __builtin_amdgcn_s_sleep(1);
        if ((++sp & 255u) == 0u) { if (xb_ld(&bar[XB_TMO])) break; if (sp > XB_SPIN_CAP) { atomicAdd(&bar[XB_TMO], 1u); break; } }
    }
    nloc = mine > 0u ? mine : 1u; nx = cnt > 0u ? cnt : 1u;
}

__device__ __attribute__((noinline)) void xcd_barrier(const XcdBarrier b, const int tid_) {
    asm volatile("s_waitcnt vmcnt(0)" ::: "memory");
    __syncthreads();
    if (tid_ == 0) {
        unsigned* bar = b.bar;
        __builtin_amdgcn_s_waitcnt(0);
        unsigned nloc = b.st[0], nx = b.st[1];
        if (nloc == 0u) { xcd_barrier_complete(bar, b.x, nloc, nx); b.st[0] = nloc; b.st[1] = nx; }
        const unsigned old = xb_add(&bar[XB_XSUB(b.x)], 1u);
        const unsigned gen = old / nloc;
        if (old + 1u == (gen + 1u) * nloc) {
            __builtin_amdgcn_fence(__ATOMIC_RELEASE, "agent");
            asm volatile("s_waitcnt vmcnt(0)" ::: "memory");
            const unsigned og = xb_add(&bar[XB_TOP], 1u);
            const unsigned tg = og / nx;
            if (og + 1u == (tg + 1u) * nx) xb_add(&bar[XB_TOPGEN], 1u);
            else XB_SPIN(xb_ld(&bar[XB_TOPGEN]) == tg, bar);
            __builtin_amdgcn_fence(__ATOMIC_ACQUIRE, "agent");
            xb_add(&bar[XB_XGEN(b.x)], 1u);
            asm volatile("s_waitcnt vmcnt(0)" ::: "memory");
        } else {
            XB_SPIN(xb_ld(&bar[XB_XGEN(b.x)]) == gen, bar);
            __builtin_amdgcn_fence(__ATOMIC_ACQUIRE, "agent");
            asm volatile("s_waitcnt vmcnt(0)" ::: "memory");
        }
    }
    __syncthreads();
}

using pg8::bf_lo; using pg8::bf_hi;
struct Frame {
    LAS unsigned char* lds; char* ldsg;
    volatile LAS unsigned* MISC;
    gu32* ctl; unsigned char* ws; float* out;
    int tid, lane, wave;
    int vcu, G;
};
__device__ __forceinline__ const float* in_ptr(const Frame& F, int k) {
    const volatile LAS unsigned* pt = (const volatile LAS unsigned*)(F.lds + PT_OFF); const unsigned lo = __builtin_amdgcn_readfirstlane(pt[2 * k]), hi = __builtin_amdgcn_readfirstlane(pt[2 * k + 1]);
    return (const float*)(((unsigned long long)hi << 32) | lo);
}
__device__ __forceinline__ float wave_sum(float v) {
#pragma unroll
    for (int o = 1; o < 64; o <<= 1) v += __shfl_xor(v, o);
    return v;
}
struct TrDesc { const float* src; const float* gain; bf16* dst; int Nsrc, K; float f8scale; };
__device__ __forceinline__ void tr_load(const TrDesc& t, f32x4 (&v)[8], int lane) {
#pragma unroll
    for (int i = 0; i < 8; ++i) v[i] = __builtin_nontemporal_load((const GAS f32x4*)(t.src + (size_t)(8 * i + (lane >> 3)) * t.Nsrc + 4 * (lane & 7)));
}
__device__ __forceinline__ void tr_store(const TrDesc& t, const f32x4 (&v)[8], LAS float* scr, int lane) {
#pragma unroll
    for (int i = 0; i < 8; ++i) { const int kk = 8 * i + (lane >> 3); f32x4 x = v[i]; if (t.gain) x = x * t.gain[kk]; LAS float* s = scr + kk * 33 + 4 * (lane & 7); s[0] = x[0]; s[1] = x[1]; s[2] = x[2]; s[3] = x[3]; }
    LDS_WAIT(); asm volatile("" ::: "memory");
    const int c = lane & 7;
    if (t.f8scale != 0.f) {
#pragma unroll
        for (int j = 0; j < 4; ++j) { const int n = (lane >> 3) + 8 * j; const LAS float* s = scr + (8 * c) * 33 + n; const float q = t.f8scale;
            const f32x4 a0 = (f32x4){s[0 * 33] * q, s[1 * 33] * q, s[2 * 33] * q, s[3 * 33] * q}, a1 = (f32x4){s[4 * 33] * q, s[5 * 33] * q, s[6 * 33] * q, s[7 * 33] * q};
            __builtin_nontemporal_store(pg8::pack8_fp8(a0, a1), (GAS unsigned long long*)((unsigned char*)t.dst + (size_t)n * t.K + 8 * c)); }
    } else {
#pragma unroll
        for (int j = 0; j < 4; ++j) { const int n = (lane >> 3) + 8 * j; const LAS float* s = scr + (8 * c) * 33 + n;
            v4u o; o.x = pk2(s[0 * 33], s[1 * 33]); o.y = pk2(s[2 * 33], s[3 * 33]); o.z = pk2(s[4 * 33], s[5 * 33]); o.w = pk2(s[6 * 33], s[7 * 33]);
            *(GAS v4u*)(t.dst + (size_t)n * t.K + 8 * c) = o; }
    }
    LDS_WAIT(); asm volatile("" ::: "memory");
}
struct Args { const float* in[24]; float* out; unsigned char* ws; int ph_lo, ph_hi; };

__device__ __forceinline__ void convert_items(Frame& F, const int it0, const int stride, const int itEnd) {
    LAS float* scr = (LAS float*)(F.lds + RING_OFF + F.wave * 16384);
    unsigned char* ws = F.ws;
    const float* norm_mix = in_ptr(F, 2); const float* w_in = in_ptr(F, 3); const float* w_out = in_ptr(F, 11); const float* norm_ffn = in_ptr(F, 12);
    const float* dwg = in_ptr(F, 13); const float* dwu = in_ptr(F, 14); const float* dwd = in_ptr(F, 15);
    const float* mwg = in_ptr(F, 17); const float* mwu = in_ptr(F, 18); const float* mwd = in_ptr(F, 19);
    const float* ple_norm = in_ptr(F, 20); const float* ple_gate = in_ptr(F, 21); const float* ple_proj = in_ptr(F, 22);
    constexpr int I_IN = (NIN / 32) * (D / 64), I_OUT = (D / 32) * (D / 64), I_DGU = (NGUD / 32) * (D / 64), I_DD = (D / 32) * (FFD / 64), I_PG = I_OUT, I_PP = (D / 32) * (PLE / 64);
    constexpr int I_MGU1 = (NGUE / 32) * (D / 64), I_MD1 = (D / 32) * (FFE / 64);
    constexpr int NITEMS = 2 * I_IN + 2 * I_OUT + I_DGU + I_DD + 2 * I_PG + 2 * I_PP + NE * I_MGU1 + NE * I_MD1;
    auto desc = [&](int it) -> TrDesc {
        int r = it; TrDesc t; t.f8scale = 0.f;
        if (r < 2 * I_IN) { const int L = r / I_IN; r -= L * I_IN; const int ng = NIN / 32, kb = r / ng, grp = r % ng, pn = grp >> 3, gi = grp & 7;
            int sc; if (pn <= 8) sc = 32 * grp; else if (pn == 9 || pn == 10) sc = (pn == 9 ? 2308 : 2564) + 64 * (gi & 3) + 32 * (gi >> 2); else if (pn <= 12) sc = 32 * grp + 4; else sc = 2304;
            t.Nsrc = INC; t.K = D; t.src = w_in + (size_t)L * D * INC + (size_t)(64 * kb) * INC + sc; t.gain = norm_mix + L * D + 64 * kb; t.dst = (bf16*)(ws + (L ? WS_WIN1 : WS_WIN0)) + (size_t)(32 * grp) * D + 64 * kb; return t; } r -= 2 * I_IN;
        if (r < 2 * I_OUT) { const int L = r / I_OUT; r -= L * I_OUT; const int ng = D / 32, kb = r / ng, grp = r % ng;
            t.Nsrc = D; t.K = D; t.src = w_out + (size_t)L * D * D + (size_t)(64 * kb) * D + 32 * grp; t.gain = nullptr; t.dst = (bf16*)(ws + (L ? WS_WOUT1 : WS_WOUT0)) + (size_t)(32 * grp) * D + 64 * kb; return t; } r -= 2 * I_OUT;
        if (r < I_DGU) { const int ng = NGUD / 32, kb = r / ng, grp = r % ng, pn = grp >> 3, gi = grp & 7;
            t.Nsrc = FFD; t.K = D; t.src = ((gi >> 2) ? dwu : dwg) + (size_t)(64 * kb) * FFD + 128 * pn + 32 * (gi & 3); t.gain = norm_ffn + 64 * kb; t.dst = (bf16*)(ws + WS_DGU) + (size_t)(32 * grp) * D + 64 * kb; return t; } r -= I_DGU;
        if (r < I_DD) { const int ng = D / 32, kb = r / ng, grp = r % ng;
            t.Nsrc = D; t.K = FFD; t.src = dwd + (size_t)(64 * kb) * D + 32 * grp; t.gain = nullptr; t.dst = (bf16*)(ws + WS_DD) + (size_t)(32 * grp) * FFD + 64 * kb; return t; } r -= I_DD;
        if (r < 2 * I_PG) { const int L = r / I_PG; r -= L * I_PG; const int ng = D / 32, kb = r / ng, grp = r % ng;
            t.Nsrc = D; t.K = D; t.src = ple_gate + (size_t)L * D * D + (size_t)(64 * kb) * D + 32 * grp; t.gain = ple_norm + L * D + 64 * kb; t.dst = (bf16*)(ws + (L ? WS_PG1 : WS_PG0)) + (size_t)(32 * grp) * D + 64 * kb; return t; } r -= 2 * I_PG;
        if (r < 2 * I_PP) { const int L = r / I_PP; r -= L * I_PP; const int ng = D / 32, kb = r / ng, grp = r % ng;
            t.Nsrc = D; t.K = PLE; t.src = ple_proj + (size_t)L * PLE * D + (size_t)(64 * kb) * D + 32 * grp; t.gain = nullptr; t.dst = (bf16*)(ws + (L ? WS_PPW1 : WS_PPW0)) + (size_t)(32 * grp) * PLE + 64 * kb; return t; } r -= 2 * I_PP;
        if (r < NE * I_MGU1) { const int e = r / I_MGU1; r -= e * I_MGU1; const int ng = NGUE / 32, kb = r / ng, grp = r % ng, pn = grp >> 3, gi = grp & 7;
            t.Nsrc = FFE; t.K = D; t.src = ((gi >> 2) ? mwu : mwg) + (size_t)e * D * FFE + (size_t)(64 * kb) * FFE + 128 * pn + 32 * (gi & 3); t.gain = nullptr; t.f8scale = 32.f; t.dst = (bf16*)(ws + WS_MGU + (size_t)e * NGUE * D + (size_t)(32 * grp) * D + 64 * kb); return t; } r -= NE * I_MGU1;
        { const int e = r / I_MD1; r -= e * I_MD1; const int ng = D / 32, kb = r / ng, grp = r % ng;
            t.Nsrc = D; t.K = FFE; t.src = mwd + (size_t)e * FFE * D + (size_t)(64 * kb) * D + 32 * grp; t.gain = nullptr; t.f8scale = 64.f; t.dst = (bf16*)(ws + WS_MD + (size_t)e * D * FFE + (size_t)(32 * grp) * FFE + 64 * kb); return t; }
    };
    {
        f32x4 va[8], vb[8]; int it = it0; TrDesc ta, tb;
        if (it < itEnd) { ta = desc(it); tr_load(ta, va, F.lane); }
        while (it < itEnd) {
            const int i2 = it + stride; if (i2 < itEnd) { tb = desc(i2); tr_load(tb, vb, F.lane); }
            tr_store(ta, va, scr, F.lane);
            if (i2 >= itEnd) break;
            const int i3 = i2 + stride; if (i3 < itEnd) { ta = desc(i3); tr_load(ta, va, F.lane); }
            tr_store(tb, vb, scr, F.lane);
            it = i3;
        }
    }
}
constexpr int CV_SMALL = 2 * ((NIN / 32) * (D / 64)) + 2 * ((D / 32) * (D / 64)) + (NGUD / 32) * (D / 64) + (D / 32) * (FFD / 64) + 2 * ((D / 32) * (D / 64)) + 2 * ((D / 32) * (PLE / 64));
constexpr int CV_MOE = NE * ((NGUE / 32) * (D / 64)) + NE * ((D / 32) * (FFE / 64));
#ifndef MK_CV_PER_WAVE
#define MK_CV_PER_WAVE 14
#endif
constexpr int CV_SLOTS = 3, CV_BLOCKS = 128, CV_PER_WAVE = MK_CV_PER_WAVE, CV_INSLOTS = CV_SLOTS * CV_BLOCKS * NWAVES * CV_PER_WAVE;
static_assert(CV_INSLOTS <= CV_MOE, "expert weight items: the first CV_INSLOTS in the slots, the rest in the prologue");
__device__ __forceinline__ void convert_slot(Frame& F, int slot, int bid) {
    if (bid < 256 - CV_BLOCKS) return;
    const int first = CV_SMALL + ((slot * CV_BLOCKS + (bid - (256 - CV_BLOCKS))) * NWAVES + F.wave) * CV_PER_WAVE;
    convert_items(F, first, 1, first + CV_PER_WAVE);
    __syncthreads();
}
__device__ __forceinline__ void p0_prologue(Frame& F, const Args& a) {
    const int gw = F.vcu * NWAVES + F.wave, NGW = F.G * NWAVES;
    unsigned char* ws = F.ws;
#ifdef MK_CONV_IN_PROLOGUE
    convert_items(F, gw, NGW, CV_SMALL + CV_MOE);
#else
    convert_items(F, gw, NGW, CV_SMALL);
    convert_items(F, CV_SMALL + (F.G == 256 ? CV_INSLOTS : 0) + gw, NGW, CV_SMALL + CV_MOE);
#endif
    for (int i = gw * 64 + F.lane; i < SEQ * 32; i += NGW * 64) { const int pos = i >> 5, d = i & 31;
        const double inv = exp2((double)d * (-13.287712379549449 / 32.0)); double ang = (double)pos * inv; ang -= 6.283185307179586 * rint(ang * 0.15915494309189535);
        ((float*)(ws + WS_RCOS))[i] = __cosf((float)ang); ((float*)(ws + WS_RSIN))[i] = __sinf((float)ang); }
    { const float* p = in_ptr(F, 1); const size_t n8 = (size_t)DEPTH * NTOK * PLE / 8, half8 = (size_t)NTOK * PLE / 8;
      for (size_t i = (size_t)gw * 64 + F.lane; i < n8; i += (size_t)NGW * 64) { const f32x4 v0 = __builtin_nontemporal_load((const GAS f32x4*)p + 2 * i), v1 = __builtin_nontemporal_load((const GAS f32x4*)p + 2 * i + 1);
          v4u o; o.x = pk2(v0[0], v0[1]); o.y = pk2(v0[2], v0[3]); o.z = pk2(v1[0], v1[1]); o.w = pk2(v1[2], v1[3]);
          if (i < half8) ((v4u*)(ws + WS_P0))[i] = o; else ((v4u*)(ws + WS_P1))[i - half8] = o; } }
    { const float* x = in_ptr(F, 0); bf16* hb = (bf16*)(ws + WS_HB); float* st = (float*)(ws + WS_STATS0);
      for (int m0 = gw; m0 < NTOK; m0 += 2 * NGW) {
          f32x4 xv[2][4];
#pragma unroll
          for (int u = 0; u < 2; ++u) { if (m0 + u * NGW >= NTOK) continue; const GAS f32x4* xr = (const GAS f32x4*)(x + (size_t)(m0 + u * NGW) * D) + F.lane;
#pragma unroll
              for (int j = 0; j < 4; ++j) xv[u][j] = __builtin_nontemporal_load(xr + 64 * j); }
#pragma unroll
          for (int u = 0; u < 2; ++u) { const int m = m0 + u * NGW; if (m >= NTOK) continue; GAS unsigned long long* o8 = (GAS unsigned long long*)(hb + (size_t)m * D) + F.lane; float s = 0.f;
#pragma unroll
              for (int j = 0; j < 4; ++j) { const f32x4 v = xv[u][j]; const unsigned w0 = pk2(v[0], v[1]), w1 = pk2(v[2], v[3]);
                  const float q0 = bf_lo(w0), q1 = bf_hi(w0), q2 = bf_lo(w1), q3 = bf_hi(w1); s += (q0 * q0 + q1 * q1) + (q2 * q2 + q3 * q3);
                  o8[64 * j] = (unsigned long long)w0 | ((unsigned long long)w1 << 32); }
              s = wave_sum(s); if (F.lane < 4) st[(size_t)m * 4 + F.lane] = (F.lane == 0) ? s : 0.f; } } }
}

namespace ret {
constexpr int QP = 72, VP = 136;
constexpr int OFF_Q = 0, OFF_K = OFF_Q + 128 * QP * 2, OFF_VT = OFF_K + 128 * QP * 2, OFF_KD = OFF_VT + 64 * VP * 2, OFF_AS = OFF_KD + 64 * VP * 2, OFF_ST = OFF_AS + 128 * VP * 2, BYTES = OFF_ST + 2 * 64 * QP * 2;
static_assert(BYTES <= RING_BYTES, "retention LDS");
typedef LAS unsigned short lbf;
__device__ __forceinline__ bf16x8 ld8(const lbf* p) { return *(const LAS bf16x8*)p; }
__device__ __forceinline__ void unit(Frame& F, const int tid, int b, int h, int seg, const bf16* proj, bf16* ocat, const float* ret_gn) {
    const int lane = tid & 63, w = __builtin_amdgcn_readfirstlane(tid >> 6), l15 = lane & 15, q4 = lane >> 4;
    lbf* Qs = (lbf*)(F.lds + OFF_Q); lbf* Ks = (lbf*)(F.lds + OFF_K); lbf* Vt = (lbf*)(F.lds + OFF_VT); lbf* Kd = (lbf*)(F.lds + OFF_KD); lbf* As = (lbf*)(F.lds + OFF_AS); lbf* St = (lbf*)(F.lds + OFF_ST);
    const float l2g = log2f(1.f - exp2f(-5.f - (float)h));
    const float cdec = exp2f(128.f * l2g);
    const size_t rowb = (size_t)b * SEQ;
    const bf16* qg = proj + C_QC + 64 * h; const bf16* kg = proj + C_KC + 64 * h; const bf16* vg = proj + C_VC + 64 * h; const bf16* gg = proj + C_GC + 64 * h;
    v4u rq[2], rk[2], rv[2];
#define RET_LOAD(c) do { _Pragma("unroll") for (int i = 0; i < 2; ++i) { const int p = tid + 512 * i, row = p >> 3, c8 = p & 7; const size_t go = (rowb + (size_t)(c) * 128 + row) * PROJ_P + 8 * c8; \
        if ((c) >= c0) rq[i] = *(const GAS v4u*)(qg + go); rk[i] = *(const GAS v4u*)(kg + go); rv[i] = *(const GAS v4u*)(vg + go); } } while (0)
    const int c0 = 16 * seg, c1 = c0 + 16;
    rq[0] = rq[1] = (v4u){0u, 0u, 0u, 0u};
    RET_LOAD(0);
    f32x4 st[2];
    st[0] = (f32x4){0.f, 0.f, 0.f, 0.f}; st[1] = st[0];
    for (int i = tid; i < 64 * QP / 2; i += 512) ((LAS unsigned*)St)[i] = 0u;
#pragma unroll 1
    for (int c = 0; c < c1; ++c) {
        const bool full = c >= c0;
        __syncthreads();
#pragma unroll
        for (int i = 0; i < 2; ++i) { const int p = tid + 512 * i, row = p >> 3, c8 = p & 7;
            if (full) { *(LAS v4u*)(Qs + row * QP + 8 * c8) = rq[i]; *(LAS v4u*)(Ks + row * QP + 8 * c8) = rk[i]; }
            const float kd = __builtin_amdgcn_exp2f((float)(127 - row) * l2g);
            const unsigned kw[4] = {rk[i].x, rk[i].y, rk[i].z, rk[i].w}, vw[4] = {rv[i].x, rv[i].y, rv[i].z, rv[i].w};
#pragma unroll
            for (int e = 0; e < 4; ++e) { Vt[(8 * c8 + 2 * e) * VP + row] = (unsigned short)(vw[e] & 0xffffu); Vt[(8 * c8 + 2 * e + 1) * VP + row] = (unsigned short)(vw[e] >> 16);
                Kd[(8 * c8 + 2 * e) * VP + row] = (unsigned short)f2bf(bf_lo(kw[e]) * kd); Kd[(8 * c8 + 2 * e + 1) * VP + row] = (unsigned short)f2bf(bf_hi(kw[e]) * kd); } }
        if (c + 1 < c1) RET_LOAD(c + 1);
        __syncthreads();
        const lbf* Stc = St + (c & 1) * 64 * QP; lbf* Stn = St + ((c + 1) & 1) * 64 * QP;
        f32x4 o1[4], o2[4];
        if (full) {
        bf16x8 qa[2]; qa[0] = ld8(Qs + (16 * w + l15) * QP + 8 * q4); qa[1] = ld8(Qs + (16 * w + l15) * QP + 32 + 8 * q4);
#pragma unroll 1
        for (int nt = 0; nt <= w; ++nt) {
            f32x4 s = (f32x4){0.f, 0.f, 0.f, 0.f};
            s = __builtin_amdgcn_mfma_f32_16x16x32_bf16(qa[0], ld8(Ks + (16 * nt + l15) * QP + 8 * q4), s, 0, 0, 0);
            s = __builtin_amdgcn_mfma_f32_16x16x32_bf16(qa[1], ld8(Ks + (16 * nt + l15) * QP + 32 + 8 * q4), s, 0, 0, 0);
#pragma unroll
            for (int i = 0; i < 4; ++i) { const int dt = (16 * w + 4 * q4 + i) - (16 * nt + l15); const float v = dt >= 0 ? s[i] * __builtin_amdgcn_exp2f((float)dt * l2g) : 0.f;
                As[(16 * w + 4 * q4 + i) * VP + 16 * nt + l15] = (unsigned short)f2bf(v); } }
        if ((w & 1) == 0) {
#pragma unroll
            for (int i = 0; i < 4; ++i) As[(16 * w + 4 * q4 + i) * VP + 16 * (w + 1) + l15] = 0; }
        LDS_WAIT();
#pragma unroll
        for (int nv = 0; nv < 4; ++nv) { o1[nv] = (f32x4){0.f, 0.f, 0.f, 0.f}; o2[nv] = o1[nv]; }
#pragma unroll 1
        for (int ks = 0; ks <= (w >> 1); ++ks) { const bf16x8 af = ld8(As + (16 * w + l15) * VP + 32 * ks + 8 * q4);
#pragma unroll
            for (int nv = 0; nv < 4; ++nv) o1[nv] = __builtin_amdgcn_mfma_f32_16x16x32_bf16(af, ld8(Vt + (16 * nv + l15) * VP + 32 * ks + 8 * q4), o1[nv], 0, 0, 0); }
#pragma unroll
        for (int ks = 0; ks < 2; ++ks)
#pragma unroll
            for (int nv = 0; nv < 4; ++nv) o2[nv] = __builtin_amdgcn_mfma_f32_16x16x32_bf16(qa[ks], ld8(Stc + (16 * nv + l15) * QP + 32 * ks + 8 * q4), o2[nv], 0, 0, 0);
        }
#pragma unroll
        for (int i = 0; i < 2; ++i) { const int j = 2 * w + i, tv = j >> 2, td = j & 3; f32x4 u = (f32x4){0.f, 0.f, 0.f, 0.f};
#pragma unroll
            for (int ks = 0; ks < 4; ++ks) u = __builtin_amdgcn_mfma_f32_16x16x32_bf16(ld8(Vt + (16 * tv + l15) * VP + 32 * ks + 8 * q4), ld8(Kd + (16 * td + l15) * VP + 32 * ks + 8 * q4), u, 0, 0, 0);
            st[i] = st[i] * cdec + u;
#pragma unroll
            for (int e = 0; e < 4; ++e) Stn[(16 * tv + 4 * q4 + e) * QP + 16 * td + l15] = (unsigned short)f2bf(st[i][e]); }
        if (full) {
#pragma unroll
        for (int i = 0; i < 4; ++i) { const int j = 16 * w + 4 * q4 + i; const float qd = __builtin_amdgcn_exp2f((float)(j + 1) * l2g);
            float v[4], s = 0.f;
#pragma unroll
            for (int nv = 0; nv < 4; ++nv) { v[nv] = o1[nv][i] + qd * o2[nv][i]; s += v[nv]; }
            s += __shfl_xor(s, 1); s += __shfl_xor(s, 2); s += __shfl_xor(s, 4); s += __shfl_xor(s, 8);
            const float mu = s * (1.f / 64.f); float s2 = 0.f;
#pragma unroll
            for (int nv = 0; nv < 4; ++nv) { v[nv] -= mu; s2 += v[nv] * v[nv]; }
            s2 += __shfl_xor(s2, 1); s2 += __shfl_xor(s2, 2); s2 += __shfl_xor(s2, 4); s2 += __shfl_xor(s2, 8);
            const float rs = __builtin_amdgcn_rsqf(s2 * (1.f / 64.f) + EPS);
            const size_t tok = rowb + (size_t)c * 128 + j;
#pragma unroll
            for (int nv = 0; nv < 4; ++nv) { const int ch = 16 * nv + l15; const float g = bf_lo((unsigned)gg[tok * PROJ_P + ch]);
                ocat[tok * D + 768 + 64 * h + ch] = (bf16)f2bf(v[nv] * rs * ret_gn[64 * h + ch] * g * pg8::fast_sigmoid(g)); } }
        }
    }
    __syncthreads();
#undef RET_LOAD
}
}

__device__ __forceinline__ void fox_bias(Frame& F, const float* logf, int b, int h, int n, LAS float* kb) {
    LAS float* red = (LAS float*)(F.lds + LDSCTL_OFF);
    const int t0 = 8 * F.tid; float p[8]; float run = 0.f;
#pragma unroll
    for (int i = 0; i < 8; ++i) { const float v = (t0 + i < n) ? logf[((size_t)b * SEQ + t0 + i) * 4 + h] : 0.f; run += v; p[i] = run; }
    float inc = run;
#pragma unroll
    for (int o = 1; o < 64; o <<= 1) { const float y = __shfl_up(inc, o); if (F.lane >= o) inc += y; }
    if (F.lane == 63) red[F.wave] = inc;
    __syncthreads();
    float woff = 0.f, tot = 0.f;
#pragma unroll
    for (int k = 0; k < 8; ++k) { const float x = red[k]; if (k < F.wave) woff += x; tot += x; }
    const float base = woff + inc - run;
    if (t0 < n) {
#pragma unroll
        for (int i = 0; i < 8; ++i) kb[t0 + i] = (tot - (base + p[i])) * pg8::LOG2E;
    }
    __syncthreads();
}
constexpr int MIX_UNITS = 16 + 16 * 80;
constexpr int KB_OFF = attn_body::ATTN_LDS_BYTES;
static_assert(KB_OFF + 16384 <= RING_BYTES && KB_OFF % 16 == 0, "attention LDS + bias array");
__device__ __forceinline__ int mixer_grab(Frame& F, int word) {
    if (F.tid == 0) F.MISC[0] = __hip_atomic_fetch_add((unsigned*)(F.ctl + word), 1u, __ATOMIC_RELAXED, __HIP_MEMORY_SCOPE_AGENT);
    __syncthreads();
    const int u = __builtin_amdgcn_readfirstlane((int)F.MISC[0]);
    __syncthreads();
    return u;
}
__device__ __forceinline__ void mixer_phase(Frame& F, const Args& a, int layer) {
    unsigned char* ws = F.ws; const bf16* proj = (const bf16*)(ws + WS_PROJ); bf16* oa = (bf16*)(ws + WS_OA); bf16* ocat = (bf16*)(ws + WS_OCAT);
    const float* logf = (const float*)(ws + WS_LOGF); const float* ret_gn = in_ptr(F, 10) + layer * 256;
    char* lds = F.ldsg;
#ifndef MIXSEL
#define MIXSEL 7
#endif
#ifndef MIXDUP
#define MIXDUP 0
#endif
#define LOOP_RET(QW) { asm volatile("" : "+v"(F.tid)); const int t1 = F.tid; for (;;) { const int u = mixer_grab(F, (QW)); if (u >= 32) break; ret::unit(F, t1, (u >> 2) & 3, u & 3, 1 - (u >> 4), proj, ocat, ret_gn); } }
#define LOOP_A(QW) { asm volatile("" : "+v"(F.tid)); const int t2 = F.tid; for (;;) { const int u = mixer_grab(F, (QW)); if (u >= 512) break; \
        const int qb = 15 - (u >> 5), w = u & 31, b = w >> 3, j = w & 7;     \
        attn_body::attn_unit<8, false, true>(b, qb, (const attn_body::bf16*)(proj + C_QA + 64 * j), (const attn_body::bf16*)(proj + C_KA + 64 * j), (const attn_body::bf16*)(proj + C_VA + 128 * (j >> 1)), \
                                       (attn_body::bf16*)(oa + 128 * j), lds, (const LAS float*)nullptr, t2); } }
#define LOOP_B(QW) { asm volatile("" : "+v"(F.tid)); const int t3 = F.tid; for (;;) { const int u = mixer_grab(F, (QW)); if (u >= 256) break; \
        const int qb = 15 - (u >> 4), w = u & 15, b = w >> 2, h = w & 3; \
        LAS float* kb = (LAS float*)(F.lds + KB_OFF); \
        fox_bias(F, logf, b, h, 256 * qb + 256, kb); \
        attn_body::attn_unit<8, true, false>(b, qb, (const attn_body::bf16*)(proj + C_QB + 64 * h), (const attn_body::bf16*)(proj + C_KB + 64 * h), (const attn_body::bf16*)(proj + C_VB + 64 * h), \
                                      (attn_body::bf16*)(ocat + 512 + 64 * h), lds, (const LAS float*)kb, t3); } }
    const int qw = CW_Q + 64 * (3 * layer);
    if (MIXSEL & 1) LOOP_RET(qw)
    if (MIXSEL & 4) LOOP_B(qw + 128)
    if (MIXSEL & 2) LOOP_A(qw + 64)
#if MIXDUP & 1
    LOOP_RET(qw + 64 * 6)
#endif
#if MIXDUP & 2
    LOOP_A(qw + 64 * 7)
#endif
#if MIXDUP & 4
    LOOP_B(qw + 64 * 8)
#endif
#undef LOOP_RET
#undef LOOP_A
#undef LOOP_B
}
__device__ __forceinline__ void combine_phase(Frame& F, const Args& a, int layer) {
    unsigned char* ws = F.ws; const bf16* oa = (const bf16*)(ws + WS_OA); bf16* ocat = (bf16*)(ws + WS_OCAT);
    const int gw = F.vcu * NWAVES + F.wave, NGW = F.G * NWAVES;
    const float lam_init = 0.8f - 0.6f * expf(-0.3f * (float)layer);
    const float lam = expf(wave_sum(in_ptr(F, 5)[layer * 64 + F.lane] * in_ptr(F, 6)[layer * 64 + F.lane])) - expf(wave_sum(in_ptr(F, 7)[layer * 64 + F.lane] * in_ptr(F, 8)[layer * 64 + F.lane])) + lam_init;
    const int hd = F.lane >> 4, i16 = F.lane & 15;
    const float* sg = in_ptr(F, 9) + layer * 128 + 8 * i16; float g[8];
#pragma unroll
    for (int e = 0; e < 8; ++e) g[e] = sg[e] * (1.f - lam_init);
    for (int m0 = gw; m0 < NTOK; m0 += 2 * NGW) {
        v4u w1[2], w2[2];
#pragma unroll
        for (int u = 0; u < 2; ++u) { const int m = m0 + u * NGW; if (m >= NTOK) continue; w1[u] = __builtin_nontemporal_load((const GAS v4u*)(oa + (size_t)m * D + 256 * hd + 8 * i16)); w2[u] = __builtin_nontemporal_load((const GAS v4u*)(oa + (size_t)m * D + 256 * hd + 128 + 8 * i16)); }
#pragma unroll
        for (int u = 0; u < 2; ++u) { const int m = m0 + u * NGW; if (m >= NTOK) continue;
            const unsigned a1[4] = {w1[u].x, w1[u].y, w1[u].z, w1[u].w}, a2[4] = {w2[u].x, w2[u].y, w2[u].z, w2[u].w}; float d[8], ss = 0.f;
#pragma unroll
            for (int e = 0; e < 4; ++e) { d[2 * e] = bf_lo(a1[e]) - lam * bf_lo(a2[e]); d[2 * e + 1] = bf_hi(a1[e]) - lam * bf_hi(a2[e]); ss += d[2 * e] * d[2 * e] + d[2 * e + 1] * d[2 * e + 1]; }
            ss += __shfl_xor(ss, 1); ss += __shfl_xor(ss, 2); ss += __shfl_xor(ss, 4); ss += __shfl_xor(ss, 8);
            const float r = __builtin_amdgcn_rsqf(ss * (1.f / 128.f) + EPS);
            v4u o; o.x = pk2(d[0] * r * g[0], d[1] * r * g[1]); o.y = pk2(d[2] * r * g[2], d[3] * r * g[3]); o.z = pk2(d[4] * r * g[4], d[5] * r * g[5]); o.w = pk2(d[6] * r * g[6], d[7] * r * g[7]);
            *(GAS v4u*)(ocat + (size_t)m * D + 128 * hd + 8 * i16) = o; }
    }
}
__device__ __forceinline__ void router_phase(Frame& F, const Args& a, const bf16* h) {
    unsigned char* ws = F.ws; const float* gain = in_ptr(F, 12) + D; const float* router = in_ptr(F, 16);
    LAS float* R = (LAS float*)(F.lds + RING_OFF);
    LAS int* lcnt = (LAS int*)(F.lds + RING_OFF + 32768); LAS int* gbase = lcnt + 8; LAS int* rowe = lcnt + 16; LAS int* rowp = rowe + 128; LAS float* rowg = (LAS float*)(rowp + 128);
    for (int i = F.tid; i < D * NE; i += 512) R[(i & 7) * D + (i >> 3)] = gain[i >> 3] * router[i];
    const int nblk = NTOK / 64;
    for (int blk = F.vcu; blk < nblk; blk += F.G) {
        if (F.tid < 8) lcnt[F.tid] = 0;
        __syncthreads();
#pragma unroll 1
        for (int rr = 0; rr < 8; ++rr) { const int lr = F.wave * 8 + rr, m = blk * 64 + lr;
            const GAS unsigned long long* xr = (const GAS unsigned long long*)(h + (size_t)m * D) + F.lane; float lg[8]; float ss = 0.f;
#pragma unroll
            for (int e = 0; e < 8; ++e) lg[e] = 0.f;
#pragma unroll
            for (int j = 0; j < 4; ++j) { const unsigned long long pw = xr[64 * j]; const f32x4 v = (f32x4){bf_lo((unsigned)pw), bf_hi((unsigned)pw), bf_lo((unsigned)(pw >> 32)), bf_hi((unsigned)(pw >> 32))}; ss += (v[0] * v[0] + v[1] * v[1]) + (v[2] * v[2] + v[3] * v[3]);
#pragma unroll
                for (int e = 0; e < 8; ++e) { const f32x4 rr = *(const LAS f32x4*)(R + e * D + 256 * j + 4 * F.lane); lg[e] += (v[0] * rr[0] + v[1] * rr[1]) + (v[2] * rr[2] + v[3] * rr[3]); } }
            ss = wave_sum(ss); const float rs = 1.f / sqrtf(ss * (1.f / D) + EPS);
#pragma unroll
            for (int e = 0; e < 8; ++e) lg[e] = wave_sum(lg[e]) * rs;
            int i1 = 0; float v1 = lg[0];
#pragma unroll
            for (int e = 1; e < 8; ++e) if (lg[e] > v1) { v1 = lg[e]; i1 = e; }
            int i2 = -1; float v2 = -INFINITY;
#pragma unroll
            for (int e = 0; e < 8; ++e) if (e != i1 && lg[e] > v2) { v2 = lg[e]; i2 = e; }
            const float g2 = 1.f / (1.f + expf(v1 - v2)), g1 = 1.f - g2;
            if (F.lane == 0) { rowe[2 * lr] = i1; rowe[2 * lr + 1] = i2; rowg[2 * lr] = g1; rowg[2 * lr + 1] = g2;
                rowp[2 * lr] = __hip_atomic_fetch_add(lcnt + i1, 1, __ATOMIC_RELAXED, __HIP_MEMORY_SCOPE_WORKGROUP); rowp[2 * lr + 1] = __hip_atomic_fetch_add(lcnt + i2, 1, __ATOMIC_RELAXED, __HIP_MEMORY_SCOPE_WORKGROUP); }
        }
        __syncthreads();
        if (F.tid < 8) gbase[F.tid] = (int)__hip_atomic_fetch_add((unsigned*)(F.ctl + CW_CNT + 64 * F.tid), (unsigned)lcnt[F.tid], __ATOMIC_RELAXED, __HIP_MEMORY_SCOPE_AGENT);
        __syncthreads();
        if (F.tid < 128) { const int m2 = blk * 128 + F.tid; const int e = rowe[F.tid];
            ((int*)(ws + WS_E12))[m2] = e; ((float*)(ws + WS_G12))[m2] = rowg[F.tid]; ((int*)(ws + WS_POS))[m2] = gbase[e] + rowp[F.tid]; }
        __syncthreads();
    }
}
__device__ __forceinline__ void moe_tiles(Frame& F, int (&tb)[9]) {
    int acc = 0;
#pragma unroll
    for (int e = 0; e < 8; ++e) { tb[e] = acc; const int c = __builtin_amdgcn_readfirstlane((int)__hip_atomic_load((unsigned*)(F.ctl + CW_CNT + 64 * e), __ATOMIC_RELAXED, __HIP_MEMORY_SCOPE_AGENT)); acc += (c + 255) >> 8; }
    tb[8] = acc;
}
__device__ __forceinline__ void gather_phase(Frame& F, const Args& a, const bf16* h) {
    unsigned char* ws = F.ws; const float* gain = in_ptr(F, 12) + D;
    bf16* xs = (bf16*)(ws + WS_XS); int* dst = (int*)(ws + WS_DST); float* gsort = (float*)(ws + WS_GSORT);
    const int* e12 = (const int*)(ws + WS_E12); const float* g12 = (const float*)(ws + WS_G12); const int* pos = (const int*)(ws + WS_POS);
    int tb[9]; moe_tiles(F, tb);
    const int gw = F.vcu * NWAVES + F.wave, NGW = F.G * NWAVES;
#pragma unroll
    for (int e = 0; e < 8; ++e) { const int c = (int)__hip_atomic_load((unsigned*)(F.ctl + CW_CNT + 64 * e), __ATOMIC_RELAXED, __HIP_MEMORY_SCOPE_AGENT);
        const int lo = tb[e] * 256 + c, hi = tb[e + 1] * 256; for (int r = lo + gw * 64 + F.lane; r < hi; r += NGW * 64) { dst[r] = -1; gsort[r] = 0.f; } }
    f32x4 gv[4];
#pragma unroll
    for (int j = 0; j < 4; ++j) gv[j] = ((const GAS f32x4*)gain)[F.lane + 64 * j];
    for (int m = gw; m < NTOK; m += NGW) {
        const GAS unsigned long long* xr = (const GAS unsigned long long*)(h + (size_t)m * D) + F.lane; f32x4 v[4]; float ss = 0.f;
#pragma unroll
        for (int j = 0; j < 4; ++j) { const unsigned long long pw = xr[64 * j]; v[j] = (f32x4){bf_lo((unsigned)pw), bf_hi((unsigned)pw), bf_lo((unsigned)(pw >> 32)), bf_hi((unsigned)(pw >> 32))}; ss += (v[j][0] * v[j][0] + v[j][1] * v[j][1]) + (v[j][2] * v[j][2] + v[j][3] * v[j][3]); }
        ss = wave_sum(ss); const float rs = 1.f / sqrtf(ss * (1.f / D) + EPS);
        const int e1 = e12[2 * m], e2 = e12[2 * m + 1];
        int r1 = 0, r2 = 0;
#pragma unroll
        for (int e = 0; e < 8; ++e) { if (e == e1) r1 = tb[e] * 256; if (e == e2) r2 = tb[e] * 256; }
        r1 += pos[2 * m]; r2 += pos[2 * m + 1];
        GAS unsigned* o1 = (GAS unsigned*)((unsigned char*)xs + (size_t)r1 * D) + F.lane; GAS unsigned* o2 = (GAS unsigned*)((unsigned char*)xs + (size_t)r2 * D) + F.lane;
#pragma unroll
        for (int j = 0; j < 4; ++j) { const f32x4 y = v[j] * rs * gv[j]; unsigned pk = 0; pk = __builtin_amdgcn_cvt_pk_fp8_f32(y[0], y[1], pk, false); pk = __builtin_amdgcn_cvt_pk_fp8_f32(y[2], y[3], pk, true); o1[64 * j] = pk; o2[64 * j] = pk; }
        if (F.lane == 0) { dst[r1] = 2 * m; dst[r2] = 2 * m + 1; gsort[r1] = g12[2 * m]; gsort[r2] = g12[2 * m + 1]; }
    }
}
__device__ __forceinline__ void moe_combine_phase(Frame& F, const Args& a, float* stats_out, bf16* hb) {
    unsigned char* ws = F.ws; const bf16* y = (const bf16*)(ws + WS_XS);
    const int gw = F.vcu * NWAVES + F.wave, NGW = F.G * NWAVES;
    for (int m0 = gw; m0 < NTOK; m0 += 2 * NGW) {
        unsigned long long p0[2][4], p1[2][4], p2[2][4];
#pragma unroll
        for (int u = 0; u < 2; ++u) { const int m = m0 + u * NGW; if (m >= NTOK) continue; const GAS unsigned long long* y1 = (const GAS unsigned long long*)(y + (size_t)(2 * m) * D) + F.lane; const GAS unsigned long long* y2 = y1 + D / 4;
            const GAS unsigned long long* h8 = (const GAS unsigned long long*)(hb + (size_t)m * D) + F.lane;
#pragma unroll
            for (int j = 0; j < 4; ++j) { p0[u][j] = h8[64 * j]; p1[u][j] = __builtin_nontemporal_load(y1 + 64 * j); p2[u][j] = __builtin_nontemporal_load(y2 + 64 * j); } }
#pragma unroll
        for (int u = 0; u < 2; ++u) { const int m = m0 + u * NGW; if (m >= NTOK) continue; GAS unsigned long long* o8 = (GAS unsigned long long*)(hb + (size_t)m * D) + F.lane; float s = 0.f;
#pragma unroll
            for (int j = 0; j < 4; ++j) { const unsigned long long q0_ = p0[u][j], q1_ = p1[u][j], q2_ = p2[u][j]; f32x4 v;
                v[0] = bf_lo((unsigned)q0_) + (bf_lo((unsigned)q1_) + bf_lo((unsigned)q2_)); v[1] = bf_hi((unsigned)q0_) + (bf_hi((unsigned)q1_) + bf_hi((unsigned)q2_));
                v[2] = bf_lo((unsigned)(q0_ >> 32)) + (bf_lo((unsigned)(q1_ >> 32)) + bf_lo((unsigned)(q2_ >> 32))); v[3] = bf_hi((unsigned)(q0_ >> 32)) + (bf_hi((unsigned)(q1_ >> 32)) + bf_hi((unsigned)(q2_ >> 32)));
                const unsigned w0 = pk2(v[0], v[1]), w1 = pk2(v[2], v[3]); const float q0 = bf_lo(w0), q1 = bf_hi(w0), q2 = bf_lo(w1), q3 = bf_hi(w1);
                s += (q0 * q0 + q1 * q1) + (q2 * q2 + q3 * q3);
                o8[64 * j] = (unsigned long long)w0 | ((unsigned long long)w1 << 32); }
            s = wave_sum(s); if (F.lane < 4) stats_out[(size_t)m * 4 + F.lane] = (F.lane == 0) ? s : 0.f; }
    }
}
__device__ __forceinline__ void final_phase(Frame& F, const Args& a) {
    float* h = F.out; const bf16* hbp = (const bf16*)(F.ws + WS_HB); const float* gain = in_ptr(F, 23);
    const int gw = F.vcu * NWAVES + F.wave, NGW = F.G * NWAVES;
    float dscale = 1.f;
#ifdef TSDIAG
    { const unsigned long long* ts = (const unsigned long long*)(F.ctl + CW_TS); dscale = 1.f + (float)(ts[TS_A1] - ts[TS_A0]) * (0.01f / 3000.f); }
#endif
    f32x4 gv[4];
#pragma unroll
    for (int j = 0; j < 4; ++j) gv[j] = ((const GAS f32x4*)gain)[F.lane + 64 * j];
    for (int m0 = gw; m0 < NTOK; m0 += 2 * NGW) {
        unsigned long long pw[2][4];
#pragma unroll
        for (int u = 0; u < 2; ++u) { if (m0 + u * NGW >= NTOK) continue; const GAS unsigned long long* xr = (const GAS unsigned long long*)(hbp + (size_t)(m0 + u * NGW) * D) + F.lane;
#pragma unroll
            for (int j = 0; j < 4; ++j) pw[u][j] = __builtin_nontemporal_load(xr + 64 * j); }
#pragma unroll
        for (int u = 0; u < 2; ++u) { if (m0 + u * NGW >= NTOK) continue; GAS f32x4* hr = (GAS f32x4*)(h + (size_t)(m0 + u * NGW) * D) + F.lane; f32x4 v[4]; float ss = 0.f;
#pragma unroll
            for (int j = 0; j < 4; ++j) { const unsigned long long q = pw[u][j]; v[j] = (f32x4){bf_lo((unsigned)q), bf_hi((unsigned)q), bf_lo((unsigned)(q >> 32)), bf_hi((unsigned)(q >> 32))}; ss += (v[j][0] * v[j][0] + v[j][1] * v[j][1]) + (v[j][2] * v[j][2] + v[j][3] * v[j][3]); }
            ss = wave_sum(ss); const float rs = 1.f / sqrtf(ss * (1.f / D) + EPS);
#pragma unroll
            for (int j = 0; j < 4; ++j) __builtin_nontemporal_store(v[j] * rs * gv[j] * dscale, hr + 64 * j); }
    }
#ifdef TSDIAG
    if (gw == 0 && F.lane == 0) { const unsigned long long* ts = (const unsigned long long*)(F.ctl + CW_TS); h[0] = (float)(ts[TS_B1] - ts[TS_B0]) * (0.01f / 30.f); }
#endif
}

__device__ __forceinline__ int launder2() { int n = 2; asm volatile("" : "+s"(n)); return n; }
constexpr int N_PHASES = 26;
__global__ void __launch_bounds__(NWAVES * 64, 2) mega_fwd(Args args) {
    extern __shared__ __attribute__((aligned(16))) unsigned char lds[];
    Frame F;
    F.lds = (LAS unsigned char*)lds; F.ldsg = (char*)lds;
    F.MISC = (volatile LAS unsigned*)(F.lds + MISC_OFF);
    F.tid = threadIdx.x; F.lane = F.tid & 63; F.wave = __builtin_amdgcn_readfirstlane(F.tid >> 6);
    F.G = gridDim.x; { const int bx = blockIdx.x; F.vcu = (F.G % 8 == 0) ? (bx % 8) * (F.G / 8) + bx / 8 : bx; }
    F.ws = args.ws; F.out = F.out;
    F.ctl = (gu32*)(F.ws + WS_CTL);
    for (int u = F.tid; u < (LDS_BYTES - LDSCTL_OFF) / 4; u += NWAVES * 64) ((LAS unsigned*)(F.lds + LDSCTL_OFF))[u] = 0u;
    __syncthreads();
    if (F.tid == 0) {
#pragma unroll
        for (int i = 0; i < 24; ++i) ((LAS unsigned long long*)(F.lds + PT_OFF))[i] = (unsigned long long)args.in[i]; }
    __syncthreads();
    int lo = args.ph_lo, hi = args.ph_hi, bid = (int)blockIdx.x; size_t zoff = 0; int nst = 0;
#define one (lo == 0 && hi == N_PHASES)
    XcdBarrier bar; bar.bar = (unsigned*)(F.ctl + CW_BAR); bar.x = 0; bar.st = nullptr;
    if (one) bar = xcd_barrier_post((unsigned*)(F.ctl + CW_BAR), F.MISC + 8);
#define IN(k) (lo <= (k) && (k) < hi)
#ifndef MK_PHMASK
#define MK_PHMASK 0xffffffffu
#endif
#define EN(n) (((MK_PHMASK) >> (n)) & 1u)
#ifndef DUPK
#define DUPK -1
#endif
#define NREP(k) ((DUPK) == (k) ? launder2() : 1)
#ifndef DUPBAR
#define DUPBAR 1
#endif
#ifdef TSDIAG
#define STAMP() do { if (bid == 0 && F.tid == 0) ((unsigned long long*)(F.ctl + CW_TS))[nst] = __builtin_amdgcn_s_memrealtime(); ++nst; } while (0)
#else
#define STAMP() do {} while (0)
#endif
#define SEAM() do { if (one) { for (int b_ = 0; b_ < DUPBAR; ++b_) xcd_barrier(bar, F.tid); } STAMP(); } while (0)
#define FRESH() do { asm volatile("" : "+v"(F.tid)); asm volatile("" : "+s"(zoff), "+s"(lo), "+s"(hi), "+s"(bid), "+s"(F.G), "+s"(F.vcu)); F.ws = args.ws + zoff; F.out = (float*)((char*)args.out + zoff); F.lane = F.tid & 63; F.wave = __builtin_amdgcn_readfirstlane(F.tid >> 6); F.ctl = (gu32*)(F.ws + WS_CTL); } while (0)
#define hb ((bf16*)(L == 0 ? (void*)(F.ws + WS_HB) : (void*)F.out))
#define hbn ((bf16*)(L == 0 ? (void*)F.out : (void*)(F.ws + WS_HB)))
#define st0 ((float*)(F.ws + WS_STATS0))
#define st1 ((float*)(F.ws + WS_STATS1))
#define ST_CUR (sb ? st1 : st0)
#define ST_NXT (sb ? st0 : st1)

    STAMP();
    FRESH(); if (EN(0) && IN(0)) { for (int r_ = 0; r_ < NREP(0); ++r_) p0_prologue(F, args); SEAM(); }
    int sb = 0;
#pragma unroll
    for (int L = 0; L < DEPTH; ++L) {
        const int pb = 1 + 12 * L;
        FRESH(); if (EN(1) && IN(pb + 0)) {
            pg8::Gemm g{hb, (const pg8::bf16_t*)(F.ws + (L ? WS_WIN1 : WS_WIN0)), NTOK, NIN, D, 0}; pg8::StaticOrder S; S.init(NTOK, NIN, F.G, bid);
            pg8::EpiIn E{(pg8::bf16_t*)(F.ws + WS_PROJ), (float*)(F.ws + WS_LOGF), ST_CUR, (const float*)(F.ws + WS_RCOS), (const float*)(F.ws + WS_RSIN), in_ptr(F, 4) + 4 * L, attn_body::C2};
            if (DUPK == 1) { pg8::EpiBf16<0> EJ{(pg8::bf16_t*)(F.ws + WS_PROJ), PROJ_P, nullptr, 0, 0, 1.f}; pg8::gemm_phase<pg8::EpiBf16<0>, pg8::StaticOrder, true, true>(F.lds + RING_OFF, g, S, EJ, F.tid); }
            pg8::gemm_phase<pg8::EpiIn, pg8::StaticOrder, true, true>(F.lds + RING_OFF, g, S, E, F.tid);
#ifndef MK_CONV_IN_PROLOGUE
            if (F.G == 256) convert_slot(F, L == 0 ? 0 : 2, bid);
#endif
            SEAM(); }
        FRESH(); if (EN(2) && IN(pb + 1)) { mixer_phase(F, args, L); SEAM(); }
        FRESH(); if (EN(3) && IN(pb + 2)) { for (int r_ = 0; r_ < NREP(3); ++r_) combine_phase(F, args, L); SEAM(); }
        FRESH(); if (EN(4) && IN(pb + 3)) {
            pg8::Gemm g{(const pg8::bf16_t*)(F.ws + WS_OCAT), (const pg8::bf16_t*)(F.ws + (L ? WS_WOUT1 : WS_WOUT0)), NTOK, D, D, 0}; pg8::StaticOrder S; S.init(NTOK, D, F.G, bid);
            pg8::EpiRes<0> E{hb, hb, ST_NXT, nullptr, nullptr, nullptr, 1.f, (LAS float*)(F.lds + RED_OFF)};
            pg8::gemm_phase<pg8::EpiRes<0>, pg8::StaticOrder, true, true>(F.lds + RING_OFF, g, S, E, F.tid);
            if (DUPK == 4) { pg8::EpiBf16<0> EJ{(pg8::bf16_t*)(F.ws + WS_OA), D, nullptr, 0, 0, 1.f}; pg8::gemm_phase<pg8::EpiBf16<0>, pg8::StaticOrder, false, true>(F.lds + RING_OFF, g, S, EJ, F.tid); }
            SEAM(); }
        sb ^= 1;
        if (L == 0) {
            FRESH(); if (EN(5) && IN(pb + 4)) {
                pg8::Gemm g{hb, (const pg8::bf16_t*)(F.ws + WS_DGU), NTOK, NGUD, D, 0}; pg8::StaticOrder S; S.init(NTOK, NGUD, F.G, bid);
                pg8::EpiGU<true> E{(pg8::bf16_t*)(F.ws + WS_ACTD), FFD, ST_CUR, 1.f, 1.f};
                for (int r_ = 0; r_ < NREP(5); ++r_) pg8::gemm_phase<pg8::EpiGU<true>, pg8::StaticOrder, true, true>(F.lds + RING_OFF, g, S, E, F.tid);
#ifndef MK_CONV_IN_PROLOGUE
                if (F.G == 256) convert_slot(F, 1, bid);
#endif
                SEAM(); }
            FRESH(); if (EN(6) && IN(pb + 5)) {
                pg8::Gemm g{(const pg8::bf16_t*)(F.ws + WS_ACTD), (const pg8::bf16_t*)(F.ws + WS_DD), NTOK, D, FFD, 0}; pg8::StaticOrder S; S.init(NTOK, D, F.G, bid);
                pg8::EpiRes<0> E{hb, hb, ST_NXT, nullptr, nullptr, nullptr, 1.f, (LAS float*)(F.lds + RED_OFF)};
                pg8::gemm_phase<pg8::EpiRes<0>, pg8::StaticOrder, true, true>(F.lds + RING_OFF, g, S, E, F.tid);
                if (DUPK == 6) { pg8::EpiBf16<0> EJ{(pg8::bf16_t*)(F.ws + WS_OA), D, nullptr, 0, 0, 1.f}; pg8::gemm_phase<pg8::EpiBf16<0>, pg8::StaticOrder, false, true>(F.lds + RING_OFF, g, S, EJ, F.tid); }
                SEAM(); }
        } else {
            FRESH(); if (EN(7) && IN(pb + 4)) { router_phase(F, args, hb); SEAM(); }
            FRESH(); if (EN(8) && IN(pb + 5)) { for (int r_ = 0; r_ < NREP(8); ++r_) gather_phase(F, args, hb); SEAM(); }
            FRESH(); if (EN(9) && IN(pb + 6)) {
                pg8::MoeOrder S; moe_tiles(F, S.tb); S.nM = S.tb[8]; S.nN = NGUE / 256; S.nwg = S.nM * S.nN; S.G = F.G; S.c = bid;
                pg8::Gemm g{(const pg8::bf16_t*)(F.ws + WS_XS), (const pg8::bf16_t*)(F.ws + WS_MGU), MP_MAX, NGUE, D, (size_t)NGUE * D};
                pg8::EpiGU<false, true> E{(pg8::bf16_t*)(F.ws + WS_ACTE), FFE, nullptr, 1.f / 32.f, 4.f};
                if (DUPK == 9) { pg8::gemm_phase<pg8::EpiGU<false, true>, pg8::MoeOrder, true, true, true>(F.lds + RING_OFF, g, S, E, F.tid); SEAM(); }
                pg8::gemm_phase<pg8::EpiGU<false, true>, pg8::MoeOrder, true, true, true>(F.lds + RING_OFF, g, S, E, F.tid);
                SEAM(); }
            FRESH(); if (EN(10) && IN(pb + 7)) {
                pg8::MoeOrder S; moe_tiles(F, S.tb); S.nM = S.tb[8]; S.nN = D / 256; S.nwg = S.nM * S.nN; S.G = F.G; S.c = bid;
                pg8::Gemm g{(const pg8::bf16_t*)(F.ws + WS_ACTE), (const pg8::bf16_t*)(F.ws + WS_MD), MP_MAX, D, FFE, (size_t)D * FFE};
                pg8::EpiMoeDown E{(pg8::bf16_t*)(F.ws + WS_XS), (const int*)(F.ws + WS_DST), (const float*)(F.ws + WS_GSORT), 1.f / 256.f};
                for (int r_ = 0; r_ < NREP(10); ++r_) pg8::gemm_phase<pg8::EpiMoeDown, pg8::MoeOrder, true, true, true>(F.lds + RING_OFF, g, S, E, F.tid);
                SEAM(); }
            FRESH(); if (EN(11) && IN(pb + 8)) { moe_combine_phase(F, args, ST_NXT, hb); SEAM(); }
        }
        sb ^= 1;
        FRESH(); if (EN(12) && IN(pb + 9)) {
            pg8::Gemm g{(const pg8::bf16_t*)(F.ws + (L ? WS_P1 : WS_P0)), (const pg8::bf16_t*)(F.ws + (L ? WS_PPW1 : WS_PPW0)), NTOK, D, PLE, 0}; pg8::StaticOrder S; S.init(NTOK, D, F.G, bid);
            pg8::EpiBf16<0> E{(pg8::bf16_t*)(F.ws + WS_PP), D, nullptr, 0, 0, 1.f};
            for (int r_ = 0; r_ < NREP(12); ++r_) pg8::gemm_phase<pg8::EpiBf16<0>, pg8::StaticOrder, true, true>(F.lds + RING_OFF, g, S, E, F.tid);
            if (!one) {   } }
        FRESH(); if (EN(13) && IN(pb + 10)) {
            pg8::Gemm g{hb, (const pg8::bf16_t*)(F.ws + (L ? WS_PG1 : WS_PG0)), NTOK, D, D, 0}; pg8::StaticOrder S; S.init(NTOK, D, F.G, bid);
            pg8::EpiRes<1> E{hb, hbn, ST_NXT, ST_CUR, (const pg8::bf16_t*)(F.ws + WS_PP), nullptr, 1.f, (LAS float*)(F.lds + RED_OFF)};
            pg8::gemm_phase<pg8::EpiRes<1>, pg8::StaticOrder, true, true>(F.lds + RING_OFF, g, S, E, F.tid);
            if (DUPK == 13) { pg8::EpiBf16<0> EJ{(pg8::bf16_t*)(F.ws + WS_OCAT), D, nullptr, 0, 0, 1.f}; pg8::gemm_phase<pg8::EpiBf16<0>, pg8::StaticOrder, false, true>(F.lds + RING_OFF, g, S, EJ, F.tid); }
            SEAM(); }
        sb ^= 1;
    }
    FRESH(); if (EN(14) && IN(25)) final_phase(F, args);
#undef IN
#undef SEAM
#undef FRESH
#undef one
#undef hb
#undef hbn
#undef st0
#undef st1
}

#ifndef MK_PER_PHASE
#define MK_PER_PHASE 0
#endif
extern "C" void kernel_launch(void* const* d_in, const int* in_sizes, int n_in, void* d_out, int out_size, void* d_ws, size_t ws_size, hipStream_t stream) {
    static int grid = 0;
    if (grid == 0) {
        if (n_in != 24 || in_sizes[0] != NTOK * D || out_size != NTOK * D || ws_size < WS_END) { fprintf(stderr, "kernel_launch: unexpected shapes or workspace (%zu < %zu)\n", ws_size, (size_t)WS_END); grid = -1; return; }
        int dev = 0, cus = 0, per_cu = 0;
        if (hipGetDevice(&dev) != hipSuccess || hipDeviceGetAttribute(&cus, hipDeviceAttributeMultiprocessorCount, dev) != hipSuccess) { grid = -1; return; }
        if (hipFuncSetAttribute((const void*)mega_fwd, hipFuncAttributeMaxDynamicSharedMemorySize, LDS_BYTES) != hipSuccess) { fprintf(stderr, "kernel_launch: hipFuncSetAttribute failed\n"); grid = -1; return; }
        if (hipOccupancyMaxActiveBlocksPerMultiprocessor(&per_cu, (const void*)mega_fwd, NWAVES * 64, LDS_BYTES) != hipSuccess || per_cu < 1) { fprintf(stderr, "kernel_launch: occupancy query says %d\n", per_cu); }
        (void)hipGetLastError();
        grid = cus;
    }
    if (grid < 0) return;
    if (hipMemsetAsync((char*)d_ws + WS_CTL, 0, CTL_ZERO_BYTES, stream) != hipSuccess) return;
    Args a{};
    for (int i = 0; i < 24; ++i) a.in[i] = (const float*)d_in[i];
    a.out = (float*)d_out; a.ws = (unsigned char*)d_ws;
#if MK_PER_PHASE
    for (int p = 0; p < N_PHASES; ++p) { a.ph_lo = p; a.ph_hi = p + 1; hipLaunchKernelGGL(mega_fwd, dim3(grid), dim3(NWAVES * 64), LDS_BYTES, stream, a); }
#else
    a.ph_lo = 0; a.ph_hi = N_PHASES; hipLaunchKernelGGL(mega_fwd, dim3(grid), dim3(NWAVES * 64), LDS_BYTES, stream, a);
#endif
}
```
